# Optimizing an MI355X kernel written in HIP

```python
import jax, jax.numpy as jnp
from jax import lax
import numpy as np

D_MODEL = 2048
BATCH = 2
SEQ = 8192
DEPTH = 4

CHUNK = 64
N_BRANCH = 4
W_BRANCH = 1024
NORM_EPS = 1e-6
CONV_WIDTH = 3
RWKV_HEAD = 64
RWKV_HEADS = W_BRANCH // RWKV_HEAD
DECAY_LORA = 64
AAA_LORA = 64
RWKV_LN_EPS = 64e-5
FOX_HEAD = 64
FOX_HEADS = W_BRANCH // FOX_HEAD
Q_BLOCK = 128
POOL_WINDOWS = (2, 4, 8, 16)
POOL_GROUPS = len(POOL_WINDOWS)
POOL_GROUP_W = W_BRANCH // POOL_GROUPS

SHIFT_W = 3 * W_BRANCH + DECAY_LORA + AAA_LORA
IN_SIZES = (
    4 * W_BRANCH,
    SHIFT_W, W_BRANCH,
    3 * W_BRANCH, FOX_HEADS, W_BRANCH,
    W_BRANCH, W_BRANCH,
    N_BRANCH * D_MODEL,
)
N_IN = sum(IN_SIZES)

kernel_name = 'hybrid_gated_stream_encoder'


def _rms_norm(x, g):
    xf = x.astype(jnp.float32)
    y = xf * lax.rsqrt(jnp.mean(xf * xf, axis=-1, keepdims=True) + NORM_EPS)
    return (y * g.astype(jnp.float32)).astype(x.dtype)


def _split(u, sizes):
    idx = [int(i) for i in np.cumsum(sizes)[:-1]]
    return jnp.split(u, idx, axis=-1)


def _short_conv_branch(u, conv_w):
    b_gate, c_gate, xv, g = _split(u, (W_BRANCH,) * 4)
    z = lax.conv_general_dilated(
        c_gate * xv, conv_w[:, None, :].astype(u.dtype), window_strides=(1,),
        padding=[(CONV_WIDTH - 1, 0)], dimension_numbers=('NWC', 'WIO', 'NWC'),
        feature_group_count=W_BRANCH)
    return b_gate * z * jax.nn.silu(g)


def _rwkv7_scan(r, decay, k, v, a, b):
    bsz, _, nh, n = r.shape
    xs = tuple(jnp.moveaxis(t, 1, 0) for t in (r, decay, k, v, a, b))

    def step(state, inp):
        r_t, w_t, k_t, v_t, a_t, b_t = inp
        sa = jnp.einsum('bhvk,bhk->bhv', state, a_t)
        state = (state * w_t[:, :, None, :] + sa[..., None] * b_t[:, :, None, :]
                 + v_t[..., None] * k_t[:, :, None, :])
        return state, jnp.einsum('bhvk,bhk->bhv', state, r_t)

    s0 = jnp.zeros((bsz, nh, n, n), jnp.float32)
    _, y = lax.scan(step, s0, xs)
    return jnp.moveaxis(y, 0, 1)


def _rwkv7_branch(u, g, mu, w0, w2, a0, a2, k_k, k_a, r_k, ln_g, ln_b):
    bsz, s, _ = u.shape
    uf = u.astype(jnp.float32)
    prev = jnp.pad(uf, ((0, 0), (1, 0), (0, 0)))[:, :-1]
    xm = uf + (prev - uf) * mu.astype(jnp.float32)
    r, k, v, wl, al = _split(xm, (W_BRANCH, W_BRANCH, W_BRANCH, DECAY_LORA, AAA_LORA))
    log_w = -jax.nn.softplus(-(w0 + jnp.einsum('bsr,rc->bsc', jnp.tanh(wl), w2))) - 0.5
    decay = jnp.exp(-jnp.exp(log_w))
    a = jax.nn.sigmoid(a0 + jnp.einsum('bsr,rc->bsc', al, a2))
    heads = lambda t: t.reshape(bsz, s, RWKV_HEADS, RWKV_HEAD)
    kk = heads(k * k_k)
    kk = kk / jnp.maximum(jnp.linalg.norm(kk, axis=-1, keepdims=True), 1e-12)
    k = k * (1.0 + (a - 1.0) * k_a)
    r, decay, k, v, a = map(heads, (r, decay, k, v, a))
    y = _rwkv7_scan(r, decay, k, v, -kk, kk * a)
    mean = jnp.mean(y, axis=-1, keepdims=True)
    var = jnp.mean(jnp.square(y - mean), axis=-1, keepdims=True)
    y = ((y - mean) * lax.rsqrt(var + RWKV_LN_EPS)).reshape(bsz, s, W_BRANCH) * ln_g + ln_b
    bonus = jnp.sum(r * k * r_k, axis=-1, keepdims=True) * v
    y = y + bonus.reshape(bsz, s, W_BRANCH)
    return y.astype(u.dtype) * jax.nn.silu(g)


def _fox_branch(qkv, f_logit, g, b_f):
    bsz, s, _ = qkv.shape
    q, k, v = [t.reshape(bsz, s, FOX_HEADS, FOX_HEAD).transpose(0, 2, 1, 3)
               for t in _split(qkv, (W_BRANCH,) * 3)]
    log_f = jax.nn.log_sigmoid(f_logit.astype(jnp.float32) + b_f.astype(jnp.float32))
    c = jnp.cumsum(log_f, axis=1).transpose(0, 2, 1)
    scale = FOX_HEAD ** -0.5
    outs = []
    for i in range(s // Q_BLOCK):
        q0, q1 = i * Q_BLOCK, (i + 1) * Q_BLOCK
        logits = jnp.einsum('bhqd,bhkd->bhqk', q[:, :, q0:q1], k[:, :, :q1]).astype(jnp.float32) * scale
        logits = logits + c[:, :, q0:q1, None] - c[:, :, None, :q1]
        causal = (q0 + jnp.arange(Q_BLOCK))[:, None] >= jnp.arange(q1)[None, :]
        p = jax.nn.softmax(jnp.where(causal, logits, -jnp.inf), axis=-1)
        outs.append(jnp.einsum('bhqk,bhkd->bhqd', p.astype(v.dtype), v[:, :, :q1]))
    o = jnp.concatenate(outs, axis=2).transpose(0, 2, 1, 3).reshape(bsz, s, W_BRANCH)
    return o * jax.nn.silu(g)


def _pool_branch(u, g, pool_w, pool_scale):
    bsz, s, _ = u.shape
    xg = u.astype(jnp.float32).reshape(bsz, s, POOL_GROUPS, POOL_GROUP_W)
    pos = jnp.arange(s)
    pooled = []
    for gi, win in enumerate(POOL_WINDOWS):
        xi = xg[:, :, gi]
        cs = jnp.cumsum(xi, axis=1)
        cs_prev = jnp.pad(cs, ((0, 0), (win, 0), (0, 0)))[:, :s]
        count = jnp.minimum(pos + 1, win).astype(jnp.float32)[None, :, None]
        pooled.append((cs - cs_prev) / count - xi)
    p = jnp.stack(pooled, axis=2)
    y = jnp.einsum('bsgc,gce->bsge', p, pool_w.astype(jnp.float32)).reshape(bsz, s, W_BRANCH) * pool_scale
    return y.astype(u.dtype) * jax.nn.silu(g)


def _hybrid_layer(x, norm_g, w_in, b_merge, conv_w, rwkv_mu, rwkv_w0, rwkv_w2, rwkv_a0, rwkv_a2,
                  rwkv_kk, rwkv_ka, rwkv_rk, rwkv_ln_g, rwkv_ln_b, fox_bf, pool_w, pool_scale,
                  w_branch, w_out):
    bsz, s, d = x.shape
    h = _rms_norm(x, norm_g)
    u = jnp.einsum('bsd,dn->bsn', h, w_in)
    a_in, b_in, b_gate, c_qkv, c_f, c_gate, d_in, d_gate, m_logit = _split(u, IN_SIZES)
    y_a = _short_conv_branch(a_in, conv_w)
    y_b = _rwkv7_branch(b_in, b_gate, rwkv_mu, rwkv_w0, rwkv_w2, rwkv_a0, rwkv_a2,
                        rwkv_kk, rwkv_ka, rwkv_rk, rwkv_ln_g, rwkv_ln_b)
    y_c = _fox_branch(c_qkv, c_f, c_gate, fox_bf)
    y_d = _pool_branch(d_in, d_gate, pool_w, pool_scale)
    ys = jnp.stack([y_a, y_b, y_c, y_d], axis=2)
    proj = jnp.einsum('bskc,kcd->bskd', ys, w_branch)
    gates = jax.nn.sigmoid(m_logit.reshape(bsz, s, N_BRANCH, d) + b_merge)
    merged = jnp.sum(gates * proj, axis=2)
    return x + jnp.einsum('bsd,de->bse', merged, w_out)


def setup_inputs(seed: int = 0) -> dict:
    key = jax.random.key(seed)
    ks = jax.random.split(key, 21)
    f32 = jnp.float32
    nrm = lambda k, shape, sc: sc * jax.random.normal(k, shape, f32)
    L, D, W = DEPTH, D_MODEL, W_BRANCH
    return {
        'x': nrm(ks[0], (BATCH, SEQ, D), 1.0),
        'norm_g': 1.0 + nrm(ks[1], (L, D), 0.02),
        'w_in': nrm(ks[2], (L, D, N_IN), D ** -0.5),
        'b_merge': nrm(ks[3], (L, N_BRANCH, D), 0.02),
        'conv_w': nrm(ks[4], (L, CONV_WIDTH, W), CONV_WIDTH ** -0.5),
        'rwkv_mu': jax.random.uniform(ks[5], (L, SHIFT_W), f32),
        'rwkv_w0': jax.random.uniform(ks[6], (L, W), f32, -3.0, 0.5),
        'rwkv_w2': nrm(ks[7], (L, DECAY_LORA, W), 0.1),
        'rwkv_a0': nrm(ks[8], (L, W), 0.1),
        'rwkv_a2': nrm(ks[9], (L, AAA_LORA, W), 0.1),
        'rwkv_kk': 0.85 + nrm(ks[10], (L, W), 0.05),
        'rwkv_ka': 1.0 + nrm(ks[11], (L, W), 0.05),
        'rwkv_rk': nrm(ks[12], (L, RWKV_HEADS, RWKV_HEAD), 0.1),
        'rwkv_ln_g': 1.0 + nrm(ks[13], (L, W), 0.02),
        'rwkv_ln_b': nrm(ks[14], (L, W), 0.02),
        'fox_bf': jax.random.uniform(ks[15], (L, FOX_HEADS), f32, 1.0, 5.0),
        'pool_w': nrm(ks[16], (L, POOL_GROUPS, POOL_GROUP_W, POOL_GROUP_W), POOL_GROUP_W ** -0.5),
        'pool_scale': 1.0 + nrm(ks[17], (L, W), 0.1),
        'w_branch': nrm(ks[18], (L, N_BRANCH, W, D), W ** -0.5),
        'w_out': nrm(ks[19], (L, D, D), D ** -0.5),
        'final_g': 1.0 + nrm(ks[20], (D,), 0.02),
    }


def reference(x, norm_g, w_in, b_merge, conv_w, rwkv_mu, rwkv_w0, rwkv_w2, rwkv_a0, rwkv_a2,
              rwkv_kk, rwkv_ka, rwkv_rk, rwkv_ln_g, rwkv_ln_b, fox_bf, pool_w, pool_scale,
              w_branch, w_out, final_g):
    for l in range(DEPTH):
        x = _hybrid_layer(x, norm_g[l], w_in[l], b_merge[l], conv_w[l], rwkv_mu[l], rwkv_w0[l],
                          rwkv_w2[l], rwkv_a0[l], rwkv_a2[l], rwkv_kk[l], rwkv_ka[l], rwkv_rk[l],
                          rwkv_ln_g[l], rwkv_ln_b[l], fox_bf[l], pool_w[l], pool_scale[l],
                          w_branch[l], w_out[l])
    return _rms_norm(x, final_g)
```

```cpp
#include <hip/hip_runtime.h>
#include <hip/hip_bf16.h>
#include <cstdio>
#include <cstdint>
#include <cmath>

__device__ __forceinline__ int lane_opaque() { int r; asm volatile("v_mbcnt_lo_u32_b32 %0, -1, 0\n\tv_mbcnt_hi_u32_b32 %0, -1, %0" : "=v"(r)); return r; }
constexpr int D = 2048, BATCH = 2, SEQ = 8192, T = BATCH * SEQ, DEPTH = 4, W = 1024, NB = 4;
constexpr int NIN = 22672;
constexpr int NP = 22784;
constexpr int OA = 0, OB = 4096, OWL = 7168, OAL = 7232, OBG = 7296, OCQ = 8320, OCF = 11392, OCG = 11408, ODI = 12432, ODG = 13456, OML = 14480;
constexpr int PA = 0, PB = 4096, PGB = 7168, PQ = 8192, PK = 9216, PV = 10240, PGC = 11264, PUD = 12288, PGD = 13312, PS = 14336, PML = 14592;
constexpr float C2 = 0.125f * 1.4426950408889634f;
constexpr float LOG2E = 1.4426950408889634f;

constexpr size_t MiB = 1u << 20;
constexpr size_t O_CTL = 0;
constexpr size_t O_WTIN = 1 * MiB;
constexpr size_t O_WTBR = O_WTIN + 356 * MiB;
constexpr size_t O_WTOUT = O_WTBR + 64 * MiB;
constexpr size_t O_WTLORA = O_WTOUT + 32 * MiB;
constexpr size_t O_WD = O_WTLORA + 4 * MiB;
constexpr size_t O_H = O_WD + 32 * MiB;
constexpr size_t O_UA = O_H + 64 * MiB;
constexpr size_t O_UB = O_UA + 128 * MiB;
constexpr size_t O_GB = O_UB + 96 * MiB;
constexpr size_t O_Q = O_GB + 32 * MiB;
constexpr size_t O_K = O_Q + 32 * MiB;
constexpr size_t O_V = O_K + 32 * MiB;
constexpr size_t O_GC = O_V + 32 * MiB;
constexpr size_t O_UD = O_GC + 32 * MiB;
constexpr size_t O_GD = O_UD + 32 * MiB;
constexpr size_t O_ML = O_GD + 32 * MiB;
constexpr size_t O_S = O_ML + 256 * MiB;
constexpr size_t O_LA = O_S + 16 * MiB;
constexpr size_t O_LF = O_LA + 8 * MiB;
constexpr size_t O_CB = O_LF + 1 * MiB;
constexpr size_t O_BON = O_CB + 1 * MiB;
constexpr size_t O_WDEC = O_BON + 1 * MiB;
constexpr size_t O_ASIG = O_WDEC + 64 * MiB;
constexpr size_t O_SCN = O_ASIG + 64 * MiB;
constexpr size_t O_VS = O_SCN + 320 * MiB;
constexpr size_t O_YS = O_VS + 64 * MiB;
constexpr size_t O_Y = O_YS + 64 * MiB;
constexpr size_t O_MG = O_Y + 128 * MiB;
constexpr size_t O_MACC = O_MG + 64 * MiB;
constexpr size_t O_X = O_MACC + 64 * MiB;
constexpr size_t O_GP = O_X + 128 * MiB;
constexpr size_t O_PG = O_GP + 256 * MiB;
constexpr size_t WS_END = O_PG + 32 * MiB;

struct Params { const float* in[21]; float* out; unsigned char* ws; int ph_lo, ph_hi, li, pad; };
enum { I_X = 0, I_NG, I_WIN, I_BM, I_CW, I_MU, I_W0, I_W2, I_A0, I_A2, I_KK, I_KA, I_RK, I_LG, I_LB, I_BF, I_PW, I_PS, I_WB, I_WO, I_FG };

namespace pg8 {
#define PG8_LAS __attribute__((address_space(3)))
typedef unsigned short bf16_t;
typedef short bf16x8 __attribute__((ext_vector_type(8)));
typedef float f32x4 __attribute__((ext_vector_type(4)));
typedef unsigned u32x4 __attribute__((ext_vector_type(4)));
constexpr int BM = 256, BK = 64, HALF = 128, HTB = HALF * BK * 2  , STAGE_BYTES = 8 * HTB, NXCD = 8, WGM = 8;

__host__ __device__ __forceinline__ int lds_byte(int r, int c) { const int st = (r >> 4) * 2 + (c >> 5), rr = r & 15, cc = c & 31, ob = rr * 64 + cc * 2; return st * 1024 + (ob ^ (((ob >> 9) & 1) << 5)); }
__host__ __device__ __forceinline__ void stage_rc(int b, int& R, int& C) { const int st = b / 1024, sb = b % 1024, swz = sb ^ (((sb >> 9) & 1) << 5); R = (st >> 1) * 16 + swz / 64; C = (st & 1) * 32 + (swz % 64) / 2; }
__host__ __device__ __forceinline__ int perm32(int rho) { const int n = rho >> 4, i = rho & 15; return 8 * (i >> 2) + 4 * n + (i & 3); }

struct Unit { int pm, pn; };
struct Gemm { const bf16_t* A; const bf16_t* Bt; int M, N, K; };

struct StaticOrder {
    int nM, nN, nwg, G, c;
    __host__ __device__ void init(int M, int N, int G_, int c_) { nM = M / BM; nN = N / BM; nwg = nM * nN; G = G_; c = c_; }
    __host__ __device__ bool next(int i, Unit& u) const {
        const long L = (long)i * G + c; if (L >= nwg) return false;
        int wgid = (int)L; { const int q = nwg / NXCD, r = nwg % NXCD, xcd = wgid % NXCD, off = wgid / NXCD; wgid = (xcd < r ? xcd * (q + 1) : r * (q + 1) + (xcd - r) * q) + off; }
        const int nig = WGM * nN, gid = wgid / nig, fm = gid * WGM, gsz = (nM - fm) < WGM ? (nM - fm) : WGM;
        u.pm = fm + ((wgid % nig) % gsz); u.pn = (wgid % nig) / gsz; return true;
    }
    __device__ __forceinline__ void a_ready(const Unit&) const {}
    __device__ __forceinline__ void done(const Unit&) const {}
};

__device__ __forceinline__ unsigned cvt_pk_bf16(float lo, float hi) { unsigned r; asm volatile("v_cvt_pk_bf16_f32 %0, %1, %2" : "=v"(r) : "v"(lo), "v"(hi)); return r; }

template <class Epi, class Sched, bool ALIGN_EPI = false, bool SP2 = false>
__device__ __forceinline__ void gemm_phase(PG8_LAS unsigned char* lds, const Gemm g, const Sched& S, const Epi& E, const int wave_k) {
    int wid_o = wave_k; asm volatile("" : "+s"(wid_o));
    const int lane = lane_opaque(), wid = wid_o, tid = wid * 64 + lane,
    wr = wid >> 2, wc = wid & 3, fr = lane & 15, fq = lane >> 4;
    const int K = g.K, nt = K / BK;
    unsigned voffA[2], voffB[2];
#pragma unroll
    for (int i = 0; i < 2; ++i) { int R, C; stage_rc(tid * 16 + i * 8192, R, C); const int Rb = Epi::PERM ? ((R & ~31) + perm32(R & 31)) : R;
        voffA[i] = (unsigned)(R * K + C) * 2u; voffB[i] = (unsigned)(Rb * K + C) * 2u; }
    const size_t kstep = (size_t)(BK * 2);
    const size_t hstep = (size_t)HALF * K * 2;
    const size_t tstep = 2 * hstep;
    const unsigned ldsw = (unsigned)wid * 1024u;
    const int aoff = lds_byte(wr * 64 + fr, fq * 8), boff = lds_byte(wc * 32 + fr, fq * 8);
#define PG8_SA(b, h) (((b) * 2 + (h)) * HTB)
#define PG8_SB(b, h) ((4 + (b) * 2 + (h)) * HTB)
#define PG8_STAGE(bufoff, gbase, voff) do { _Pragma("unroll") for (int _i = 0; _i < 2; ++_i) \
        __builtin_amdgcn_global_load_lds((const unsigned*)((const char*)(gbase) + (voff)[_i]), (PG8_LAS unsigned*)(lds + (bufoff) + ldsw + _i * 8192), 16, 0, 0); } while (0)
#define PG8_LDA(dst, b, h) do { _Pragma("unroll") for (int m = 0; m < 4; ++m) _Pragma("unroll") for (int k = 0; k < 2; ++k) dst[m][k] = *(const PG8_LAS bf16x8*)(lds + PG8_SA(b, h) + aoff + m * 2048 + k * 1024); } while (0)
#define PG8_LDB(dst, b, h) do { _Pragma("unroll") for (int n = 0; n < 2; ++n) _Pragma("unroll") for (int k = 0; k < 2; ++k) dst[n][k] = *(const PG8_LAS bf16x8*)(lds + PG8_SB(b, h) + boff + n * 2048 + k * 1024); } while (0)
#define PG8_MMA(ai, bj, At, Bt) do { __builtin_amdgcn_s_setprio(1); _Pragma("unroll") for (int m = 0; m < 4; ++m) _Pragma("unroll") for (int n = 0; n < 2; ++n) _Pragma("unroll") for (int k = 0; k < 2; ++k) \
        acc[ai][bj][m][n] = __builtin_amdgcn_mfma_f32_16x16x32_bf16(Bt[n][k], At[m][k], acc[ai][bj][m][n], 0, 0, 0); __builtin_amdgcn_s_setprio(0); } while (0)
#define PG8_WAIT_V(n) asm volatile("s_waitcnt vmcnt(" #n ")" ::: "memory")
#define PG8_WAIT_L(n) asm volatile("s_waitcnt lgkmcnt(" #n ")" ::: "memory")
#define PG8_WAIT_VR(rx, n) asm volatile("s_cmp_lg_u32 %0, 0\n\ts_cbranch_scc1 1f\n\ts_waitcnt vmcnt(8)\n1:\n\ts_waitcnt vmcnt(%1)" :: "s"(rx), "n"(n) : "memory", "scc")
#define PG8_BAR __builtin_amdgcn_s_barrier()
#define PG8_SCHED __builtin_amdgcn_sched_barrier(0)
    Unit cur, nxt; int ui = 0;
    if (!S.next(0, cur)) return;
    f32x4 acc[2][2][4][2];
#pragma unroll
    for (int a = 0; a < 2; ++a)
#pragma unroll
        for (int b = 0; b < 2; ++b)
#pragma unroll
            for (int m = 0; m < 4; ++m)
#pragma unroll
                for (int n = 0; n < 2; ++n) acc[a][b][m][n] = (f32x4){0.f, 0.f, 0.f, 0.f};
    bf16x8 At[4][2], B0[2][2], B1[2][2];
    const char* cA = (const char*)g.A + (size_t)cur.pm * tstep; const char* cB = (const char*)g.Bt + (size_t)cur.pn * tstep;
    S.a_ready(cur);
    if constexpr (SP2) {
        PG8_STAGE(PG8_SB(0, 0), cB, voffB); PG8_STAGE(PG8_SB(0, 1), cB + hstep, voffB); PG8_STAGE(PG8_SA(0, 0), cA, voffA); PG8_STAGE(PG8_SA(0, 1), cA + hstep, voffA);
        if (wr == 1) PG8_BAR;
        PG8_WAIT_V(2); PG8_BAR;
        PG8_STAGE(PG8_SB(1, 0), cB + kstep, voffB); PG8_STAGE(PG8_SA(1, 0), cA + kstep, voffA); PG8_STAGE(PG8_SB(1, 1), cB + hstep + kstep, voffB);
        PG8_WAIT_V(6); PG8_BAR;
    } else {
        PG8_STAGE(PG8_SB(0, 0), cB, voffB); PG8_STAGE(PG8_SA(0, 0), cA, voffA); PG8_STAGE(PG8_SB(0, 1), cB + hstep, voffB); PG8_STAGE(PG8_SA(0, 1), cA + hstep, voffA);
        if (wr == 1) PG8_BAR;
        PG8_WAIT_V(4); PG8_BAR;
        PG8_STAGE(PG8_SB(1, 0), cB + kstep, voffB); PG8_STAGE(PG8_SA(1, 0), cA + kstep, voffA); PG8_STAGE(PG8_SB(1, 1), cB + hstep + kstep, voffB);
        PG8_WAIT_V(6); PG8_BAR;
    }
    for (;;) {
        const bool has_next = S.next(ui + 1, nxt);
        const char* nA = has_next ? (const char*)g.A + (size_t)nxt.pm * tstep : cA; const char* nB = has_next ? (const char*)g.Bt + (size_t)nxt.pn * tstep : cB;
        for (int t = 0; t < nt; t += 2) {
            const bool last = (t == nt - 2);
            const char* a1 = cA + (size_t)(t + 1) * kstep;
            const char* a2 = last ? nA : cA + (size_t)(t + 2) * kstep; const char* b2 = last ? nB : cB + (size_t)(t + 2) * kstep;
            const char* a3 = a2 + kstep; const char* b3 = b2 + kstep;
            if (last && has_next) S.a_ready(nxt);
            const int relax = __builtin_amdgcn_readfirstlane((t == 0 && ui > 0) ? 1 : 0);
            if constexpr (SP2) {
            PG8_LDB(B0, 0, 0); PG8_LDB(B1, 0, 1); PG8_SCHED; PG8_LDA(At, 0, 0); PG8_STAGE(PG8_SA(1, 1), a1 + hstep, voffA);
            PG8_WAIT_VR(relax, 8 + Epi::NST); PG8_WAIT_L(0); PG8_BAR; PG8_MMA(0, 0, At, B0); PG8_MMA(0, 1, At, B1); PG8_BAR; PG8_SCHED;
            PG8_LDA(At, 0, 1); PG8_STAGE(PG8_SB(0, 0), b2, voffB); PG8_STAGE(PG8_SB(0, 1), b2 + hstep, voffB); PG8_STAGE(PG8_SA(0, 0), a2, voffA);
            PG8_WAIT_VR(relax, 8 + Epi::NST); PG8_WAIT_L(0); PG8_BAR; PG8_MMA(1, 0, At, B0); PG8_MMA(1, 1, At, B1); PG8_BAR; PG8_SCHED;
            PG8_LDB(B0, 1, 0); PG8_LDB(B1, 1, 1); PG8_SCHED; PG8_LDA(At, 1, 0); PG8_STAGE(PG8_SA(0, 1), a2 + hstep, voffA);
            PG8_WAIT_V(8); PG8_WAIT_L(0); PG8_BAR; PG8_MMA(0, 0, At, B0); PG8_MMA(0, 1, At, B1); PG8_BAR; PG8_SCHED;
            PG8_LDA(At, 1, 1); PG8_STAGE(PG8_SB(1, 0), b3, voffB); PG8_STAGE(PG8_SB(1, 1), b3 + hstep, voffB); PG8_STAGE(PG8_SA(1, 0), a3, voffA);
            PG8_WAIT_V(8); PG8_WAIT_L(0); PG8_BAR; PG8_MMA(1, 0, At, B0); PG8_MMA(1, 1, At, B1); PG8_BAR; PG8_SCHED;
            } else {
            PG8_LDB(B0, 0, 0); PG8_SCHED; PG8_LDA(At, 0, 0); PG8_STAGE(PG8_SA(1, 1), a1 + hstep, voffA);
            PG8_WAIT_L(8); PG8_BAR; PG8_WAIT_L(0); PG8_MMA(0, 0, At, B0); PG8_BAR; PG8_SCHED;
            PG8_LDB(B1, 0, 1); PG8_STAGE(PG8_SB(0, 0), b2, voffB);
            PG8_BAR; PG8_WAIT_L(0); PG8_MMA(0, 1, At, B1); PG8_BAR;
            PG8_LDA(At, 0, 1); PG8_STAGE(PG8_SA(0, 0), a2, voffA);
            PG8_BAR; PG8_WAIT_L(0); PG8_MMA(1, 0, At, B0); PG8_BAR; PG8_SCHED;
            PG8_STAGE(PG8_SB(0, 1), b2 + hstep, voffB);
            PG8_WAIT_V(6); PG8_BAR; PG8_MMA(1, 1, At, B1); PG8_BAR;
            PG8_LDB(B0, 1, 0); PG8_SCHED; PG8_LDA(At, 1, 0); PG8_STAGE(PG8_SA(0, 1), a2 + hstep, voffA);
            PG8_WAIT_L(8); PG8_BAR; PG8_WAIT_L(0); PG8_MMA(0, 0, At, B0); PG8_BAR; PG8_SCHED;
            PG8_LDB(B1, 1, 1); PG8_STAGE(PG8_SB(1, 0), b3, voffB);
            PG8_BAR; PG8_WAIT_L(0); PG8_MMA(0, 1, At, B1); PG8_BAR;
            PG8_LDA(At, 1, 1); PG8_STAGE(PG8_SA(1, 0), a3, voffA);
            PG8_BAR; PG8_WAIT_L(0); PG8_MMA(1, 0, At, B0); PG8_BAR; PG8_SCHED;
            PG8_STAGE(PG8_SB(1, 1), b3 + hstep, voffB);
            PG8_WAIT_V(6); PG8_BAR; PG8_MMA(1, 1, At, B1); PG8_BAR;
            }
        }
        if constexpr (ALIGN_EPI) { if (wr == 0) PG8_BAR; }
        if constexpr (!Epi::AFTER_DRAIN) { E(acc, cur, wr, wc, fr, fq); S.done(cur); }
        if (!has_next) break;
#pragma unroll
        for (int a = 0; a < 2; ++a)
#pragma unroll
            for (int b = 0; b < 2; ++b)
#pragma unroll
                for (int m = 0; m < 4; ++m)
#pragma unroll
                    for (int n = 0; n < 2; ++n) acc[a][b][m][n] = (f32x4){0.f, 0.f, 0.f, 0.f};
        cur = nxt; cA = nA; cB = nB; ++ui;
        if constexpr (ALIGN_EPI) { if (wr == 1) PG8_BAR; }
    }
    PG8_WAIT_V(0);
    if constexpr (!ALIGN_EPI) { if (wr == 0) PG8_BAR; }
    PG8_BAR;
    if constexpr (Epi::AFTER_DRAIN) { E.fused(acc, cur, wr, wc, fr, fq, lds, wid, lane); S.done(cur); }
#undef PG8_SA
#undef PG8_SB
#undef PG8_STAGE
#undef PG8_LDA
#undef PG8_LDB
#undef PG8_MMA
#undef PG8_WAIT_V
#undef PG8_WAIT_L
#undef PG8_WAIT_VR
#undef PG8_BAR
#undef PG8_SCHED
}
}

namespace attn_body {
using bf16=__hip_bfloat16;
using bf16x8=__attribute__((ext_vector_type(8)))short;
using s16x4=__attribute__((ext_vector_type(4)))short;
using f32x16=__attribute__((ext_vector_type(16)))float;
using u32x4=__attribute__((ext_vector_type(4)))unsigned;
constexpr int BATCH=2,NHEAD=16,SEQ=8192,D=64,DM=NHEAD*D;
constexpr int NW=8,QBLK=32,QB=QBLK*NW,KVBLK=64,NQB=SEQ/QB;
constexpr int ATTN_PITCH=DM, ATTN_UNIT_ROWS=QB;
__device__ __forceinline__ int crow(int r,int hi){return (r&3)+8*(r>>2)+4*hi;}
#define SBAR() __builtin_amdgcn_sched_barrier(0)
__device__ __forceinline__ void cmask(f32x16&p0,f32x16&p1,int jb,int qrel,int hi){
  const float NEG=-INFINITY; int kb=64*jb+4*hi;
  #pragma unroll
  for(int r=0;r<16;++r){int kv=kb+(r&3)+8*(r>>2); if(kv>qrel)p0[r]=NEG; if(kv+32>qrel)p1[r]=NEG;}
}

constexpr int NSLOT=3, SLOTB=8192;
constexpr int LDS_K=0, LDS_V=NSLOT*SLOTB, LDS_WS=2*NSLOT*SLOTB, LDS_OST=LDS_WS+NW*64*4, LDS_CB=LDS_OST+NW*4096, LDS_BYTES=LDS_CB+SEQ*4;
constexpr int PRUNE_THR=40;
constexpr float C2=0.125f*1.4426950408889634f;
__device__ __forceinline__ void glds16(const void*gsrc,unsigned lds_dst){unsigned keep;
  asm volatile("s_mov_b32 %0, m0\n\ts_mov_b32 m0, %2\n\ts_nop 0\n\tglobal_load_lds_dwordx4 %1, off\n\ts_mov_b32 m0, %0":"=&s"(keep):"v"(gsrc),"s"(lds_dst):"memory");}
__device__ __forceinline__ float max3f(float a,float b,float c){float r;asm("v_max3_f32 %0, %1, %2, %3":"=v"(r):"v"(a),"v"(b),"v"(c));return r;}
__device__ __forceinline__ float max2f(float a,float b){float r;asm("v_max_f32_e32 %0, %1, %2":"=v"(r):"v"(a),"v"(b));return r;}
__device__ __forceinline__ float fadd_s(float a,float b){float r;asm("v_add_f32_e32 %0, %1, %2":"=v"(r):"v"(a),"v"(b));return r;}
__device__ __forceinline__ float fsub_s(float a,float b){float r;asm("v_sub_f32_e32 %0, %1, %2":"=v"(r):"v"(a),"v"(b));return r;}
typedef float f32x2_t __attribute__((ext_vector_type(2))); typedef __bf16 bf16x2_t __attribute__((ext_vector_type(2)));
__device__ __forceinline__ unsigned cvtpk_s(float lo,float hi){f32x2_t v={lo,hi};bf16x2_t b=__builtin_convertvector(v,bf16x2_t);return __builtin_bit_cast(unsigned,b);}
#define WAIT_BAR(N) asm volatile("s_waitcnt vmcnt(" #N ") lgkmcnt(0)\n\ts_barrier":::"memory")

__device__ __forceinline__ void split3(float x,unsigned&w0,unsigned&w1){
  const unsigned hb=__float_as_uint(x)&0xffff0000u; const float r1=x-__uint_as_float(hb);
  const unsigned mb=__float_as_uint(r1)&0xffff0000u; const float r2=r1-__uint_as_float(mb);
  w0=(hb>>16)|mb; w1=__float_as_uint(r2)>>16; }
__device__ __forceinline__ bf16x8 mk8(unsigned a,unsigned b,unsigned c,unsigned d){ u32x4 v={a,b,c,d}; return __builtin_bit_cast(bf16x8,v); }
__device__ __forceinline__ void qkt(f32x16&p0,f32x16&p1,const char*Kslot,const bf16x8*qr,int r32,int hi){
  const char*kb=Kslot+hi*1024+r32*16;
  #pragma unroll
  for(int d0=0;d0<4;++d0){
    const bf16x8 b0=*reinterpret_cast<const bf16x8*>(kb+d0*2048);
    const bf16x8 b1=*reinterpret_cast<const bf16x8*>(kb+d0*2048+512);
    p0=__builtin_amdgcn_mfma_f32_32x32x16_bf16(b0,qr[d0],p0,0,0,0);p1=__builtin_amdgcn_mfma_f32_32x32x16_bf16(b1,qr[d0],p1,0,0,0);}
}
typedef __attribute__((address_space(3))) const char* lds_cptr;
typedef short v4i16_t __attribute__((ext_vector_type(4)));
__device__ __forceinline__ void kload8(bf16x8*kf,lds_cptr kp){
  kf[0]=*(const __attribute__((address_space(3))) bf16x8*)(kp);      kf[1]=*(const __attribute__((address_space(3))) bf16x8*)(kp+512);
  kf[2]=*(const __attribute__((address_space(3))) bf16x8*)(kp+2048); kf[3]=*(const __attribute__((address_space(3))) bf16x8*)(kp+2560);
  kf[4]=*(const __attribute__((address_space(3))) bf16x8*)(kp+4096); kf[5]=*(const __attribute__((address_space(3))) bf16x8*)(kp+4608);
  kf[6]=*(const __attribute__((address_space(3))) bf16x8*)(kp+6144); kf[7]=*(const __attribute__((address_space(3))) bf16x8*)(kp+6656);
}
__device__ __forceinline__ void kload2(bf16x8*kf,lds_cptr kp,int j){ kf[2*j]=*(const __attribute__((address_space(3))) bf16x8*)(kp+j*2048); kf[2*j+1]=*(const __attribute__((address_space(3))) bf16x8*)(kp+j*2048+512); }
__device__ __forceinline__ s16x4 vtr(lds_cptr p){ return __builtin_bit_cast(s16x4,__builtin_amdgcn_ds_read_tr16_b64_v4i16((__attribute__((address_space(3))) v4i16_t*)p)); }
__device__ __forceinline__ float rowmax(const f32x16&p0,const f32x16&p1){
  float a=max3f(p0[0],p0[1],p1[0]),b=max3f(p0[2],p0[3],p1[1]);a=max3f(a,p1[2],p1[3]);
  #pragma unroll
  for(int r=4;r<16;r+=4){a=max3f(a,p0[r],p0[r+1]);b=max3f(b,p0[r+2],p0[r+3]);a=max3f(a,p1[r],p1[r+1]);b=max3f(b,p1[r+2],p1[r+3]);}
  const float m=max2f(a,b);
  auto rr=__builtin_amdgcn_permlane32_swap(__float_as_uint(m),__float_as_uint(m),false,false);
  return max2f(__uint_as_float(rr[0]),__uint_as_float(rr[1]));
}
__device__ __forceinline__ void pv(f32x16*o,int vb,bf16x8 pa0,bf16x8 pa1,bf16x8 pa2,bf16x8 pa3){
  #pragma unroll
  for(int d0=0;d0<2;++d0){s16x4 lo[4],hi[4];
    #pragma unroll
    for(int ks=0;ks<4;++ks){
      asm volatile("ds_read_b64_tr_b16 %0,%1 offset:%c2":"=&v"(lo[ks]):"v"(vb),"i"(d0*4096+ks*1024):"memory");
      asm volatile("ds_read_b64_tr_b16 %0,%1 offset:%c2":"=&v"(hi[ks]):"v"(vb),"i"(d0*4096+ks*1024+512):"memory");}
    asm volatile("s_waitcnt lgkmcnt(0)":::"memory");SBAR();
    #define PK(k) (bf16x8){lo[k][0],lo[k][1],lo[k][2],lo[k][3],hi[k][0],hi[k][1],hi[k][2],hi[k][3]}
    o[d0]=__builtin_amdgcn_mfma_f32_32x32x16_bf16(pa0,PK(0),o[d0],0,0,0);
    o[d0]=__builtin_amdgcn_mfma_f32_32x32x16_bf16(pa1,PK(1),o[d0],0,0,0);
    o[d0]=__builtin_amdgcn_mfma_f32_32x32x16_bf16(pa2,PK(2),o[d0],0,0,0);
    o[d0]=__builtin_amdgcn_mfma_f32_32x32x16_bf16(pa3,PK(3),o[d0],0,0,0);
    #undef PK
  }
}

#ifndef ATTN_STORE16
#define ATTN_STORE16(p,v) (*(u32x4*)(p)=(v))
#endif
template<int THRL> __device__ __forceinline__ void attn_unit(int b,int h,int qb,const bf16*Q,const bf16*__restrict__ K,const bf16*__restrict__ V,const float*__restrict__ CB,const unsigned*__restrict__ QKM,const bf16*__restrict__ Gt,bf16*O,char*shm,const int wave_k){
  int wid_o=wave_k; asm volatile("":"+s"(wid_o)); const int lane=lane_opaque(),r32=lane&31,hi=lane>>5; const int wid=wid_o; const int tid=wid*64+lane; (void)tid;
  const long rowbase=(long)b*SEQ; const int q0=qb*QB;
  const bf16*Qw=Q+(rowbase+q0+wid*QBLK)*DM+h*D;
  const bf16*Kh=K+rowbase*DM+h*D,*Vh=V+rowbase*DM+h*D;
  const unsigned lds0=(unsigned)(uintptr_t)shm;
  float*wsf=(float*)(shm+LDS_WS)+wid*64;
  const bf16* ksrc=Kh+(long)lane*DM+wid*8;
  const bf16* vsrc=Vh+(long)(16*(wid&3)+(lane>>2))*DM+(wid>>2)*32+(lane&3)*8;
  const unsigned kdst=lds0+LDS_K+wid*1024, vdst=lds0+LDS_V+wid*1024;
  #define DMA_K(t,slot) glds16(ksrc+(long)(t)*KVBLK*DM,(unsigned)__builtin_amdgcn_readfirstlane(kdst+(slot)))
  #define DMA_V(t,slot) glds16(vsrc+(long)(t)*KVBLK*DM,(unsigned)__builtin_amdgcn_readfirstlane(vdst+(slot)))
  const int vb0=(int)(lds0+LDS_V)+((lane>>4)&1)*32+(lane&3)*8+(4*hi+((lane&15)>>2))*64;
  const char*Kbase=shm+LDS_K; bf16x8 kf[8];
  const lds_cptr shm3=(lds_cptr)shm; const lds_cptr kp0=shm3+LDS_K+hi*1024+r32*16; const lds_cptr vp0=shm3+LDS_V+((lane>>4)&1)*32+(lane&3)*8+(4*hi+((lane&15)>>2))*64;
  int NT=(q0+QB)/KVBLK;
  { const float*cbg=CB+(long)(b*NHEAD+h)*SEQ+lane*4;
    for(int pc=wid;pc<NT/4;pc+=NW) glds16(cbg+pc*256,(unsigned)__builtin_amdgcn_readfirstlane(lds0+LDS_CB+pc*1024)); }
  int t0=0;
  { asm volatile("s_waitcnt vmcnt(0)\n\ts_barrier":::"memory");
    typedef __attribute__((address_space(3))) const float* lds_fptr0; const lds_fptr0 cb0=(lds_fptr0)((lds_cptr)shm+LDS_CB);
    const float qk=sqrtf(__uint_as_float(QKM[(b*NHEAD+h)*2])*__uint_as_float(QKM[(b*NHEAD+h)*2+1]));
    const float lim=cb0[q0]+2.0f*qk*1.001f+1.0f+(float)PRUNE_THR;
    int cnt=0;
    for(int base=0;base<NT-4;base+=64){ const int tt=base+lane; const bool pr=(tt<NT-4)&&(cb0[64*(tt<NT-4?tt:0)+63]>=lim); cnt+=__popcll(__ballot(pr)); }
    t0=cnt&~1; }
  ksrc+=(long)t0*KVBLK*DM; vsrc+=(long)t0*KVBLK*DM; NT-=t0;
  DMA_K(0,0);DMA_V(0,0);DMA_K(1,SLOTB);
  bf16x8 qr[4];
  #pragma unroll
  for(int d0=0;d0<4;++d0)qr[d0]=*reinterpret_cast<const bf16x8*>(&Qw[(long)r32*DM+d0*16+hi*8]);
  float mhat=0.f,l_reg=0.f;f32x16 o[2];o[0]=f32x16{};o[1]=f32x16{};
  typedef __attribute__((address_space(3))) const float* lds_fptr;
  const lds_fptr cbl=(lds_fptr)(shm3+LDS_CB)+lane+t0*64; bf16x8 qm,kb0,kb1; float cref=0.f; const f32x16 z16=f32x16{};
  #define MKQM() do{ unsigned a_,b_; split3(-mhat,a_,b_); qm=hi?mk8(0u,0u,0u,0u):mk8(0x3F803F80u,0x3F80u|(a_<<16),(a_>>16)|(b_<<16),0u); }while(0)
  #define BIAS(t) do{ unsigned w0_,w1_; split3(cref-cbl[(t)*64],w0_,w1_); w1_|=0x3F800000u; \
    auto s0_=__builtin_amdgcn_permlane32_swap(w0_,w0_,false,false); auto s1_=__builtin_amdgcn_permlane32_swap(w1_,w1_,false,false); \
    kb0=mk8(w0_,w1_,0x3F803F80u,0u); kb1=mk8(s0_[1],s1_[1],0x3F803F80u,0u); }while(0)
  const int qrel=wid*QBLK+r32;
  #define CMASK(P0,P1,t) do{int jb_=(t)-(NT-4); if(jb_>=0)cmask(P0,P1,jb_,qrel,hi);}while(0)
  bool resc=false;
  #define START(P0,P1) do{ const float rm=rowmax(P0,P1); resc=false; \
    { const float dl=rm; mhat=fadd_s(mhat,dl); \
      _Pragma("unroll") for(int r=0;r<16;++r){P0[r]=fsub_s(P0[r],dl);P1[r]=fsub_s(P1[r],dl);} \
      } \
    _Pragma("unroll") for(int r=0;r<16;++r)P0[r]=__builtin_amdgcn_exp2f(P0[r]); }while(0)
  #define RESC() do{ if(resc){ asm volatile("s_waitcnt lgkmcnt(0)":::"memory"); \
      _Pragma("unroll") for(int d_=0;d_<2;++d_) _Pragma("unroll") for(int r=0;r<16;++r)o[d_][r]*=wsf[crow(r,hi)]; } }while(0)
  f32x16 pA0,pA1,pB0,pB1;
  int sl_prev=0,sl_cur=0,sl_next=SLOTB;
  #define ROT() do{sl_prev=sl_cur;sl_cur=sl_next;sl_next=(sl_next==(NSLOT-1)*SLOTB)?0:sl_next+SLOTB;}while(0)
  DMA_K(2,2*SLOTB);
  WAIT_BAR(3);
  cref=*((lds_fptr)(shm3+LDS_CB)+q0); MKQM(); BIAS(0);
  pA0=__builtin_amdgcn_mfma_f32_32x32x16_bf16(kb0,qm,z16,0,0,0); pA1=__builtin_amdgcn_mfma_f32_32x32x16_bf16(kb1,qm,z16,0,0,0);
  qkt(pA0,pA1,Kbase,qr,r32,hi);asm volatile("s_nop 15\n\ts_nop 7":"+v"(pA0),"+v"(pA1));CMASK(pA0,pA1,0);
  START(pA0,pA1);
  _Pragma("unroll") for(int r=0;r<16;++r)pA1[r]=__builtin_amdgcn_exp2f(pA1[r]);
  WAIT_BAR(0);
  DMA_K(3,0);DMA_V(1,SLOTB);
  ROT();
  kload8(kf,kp0+sl_cur);
  WAIT_BAR(2);
  s16x4 vlo[8],vhi[8]; u32x4 pw0,pw1,pw2,pw3;
  #define PKW(P,B) cvtpk_s(P[B],P[B+1])
  #define PAF(k) __builtin_bit_cast(bf16x8,pw##k)
  #define VFR(i) (bf16x8){vlo[i][0],vlo[i][1],vlo[i][2],vlo[i][3],vhi[i][0],vhi[i][1],vhi[i][2],vhi[i][3]}
  #define PIN(x) asm volatile("":"+v"(x))
  #define MX3(a,b,c) __builtin_fmaxf(__builtin_fmaxf((a),(b)),(c))
  #define GAPA(MF,A0,A1,A2,A3,W0,W1,PW) do{ MF; sacc+=A0; sacc+=A1; sacc+=A2; sacc+=A3; PIN(sacc); W0; W1; PIN(PW); SBAR(); }while(0)
  #define EX(v) __builtin_amdgcn_exp2f(v)
  #define GAPB(MF,X,B) do{ MF; X[B]=EX(X[B]); X[B+1]=EX(X[B+1]); X[B+2]=EX(X[B+2]); X[B+3]=EX(X[B+3]); PIN(X); SBAR(); }while(0)
  #define VRD(i) do{ vlo[i]=vtr(vp_+(((i)>>2)*4096+((i)&3)*1024)); vhi[i]=vtr(vp_+(((i)>>2)*4096+((i)&3)*1024+512)); }while(0)
  #define KRD(G,j) do{ if(G){ kload2(kf,kp0+sl_next,j); SBAR(); } }while(0)
  #define STEP(C0,C1,P0,P1,t,GK,GV,GL) do{ SBAR(); \
    MKQM(); BIAS(t); C0=__builtin_amdgcn_mfma_f32_32x32x16_bf16(kb0,qm,z16,0,0,0); C1=__builtin_amdgcn_mfma_f32_32x32x16_bf16(kb1,qm,z16,0,0,0); SBAR(); \
    const lds_cptr vp_=vp0+sl_prev; \
    VRD(0); SBAR(); float sacc=(P0[0]+P0[1]); \
    GAPA(C0=__builtin_amdgcn_mfma_f32_32x32x16_bf16(kf[0],qr[0],C0,0,0,0), P0[2],P0[3],P0[4],P0[5],     pw0[0]=PKW(P0,0), pw0[1]=PKW(P0,2), pw0); \
    VRD(4); SBAR(); GAPA(C1=__builtin_amdgcn_mfma_f32_32x32x16_bf16(kf[1],qr[0],C1,0,0,0), P0[6],P0[7],P0[8],P0[9],     pw0[2]=PKW(P0,4), pw0[3]=PKW(P0,6), pw0); \
    VRD(1); SBAR(); GAPA(C0=__builtin_amdgcn_mfma_f32_32x32x16_bf16(kf[2],qr[1],C0,0,0,0),   P0[10],P0[11],P0[12],P0[13], pw1[0]=PKW(P0,8), pw1[1]=PKW(P0,10), pw1); \
    VRD(5); SBAR(); GAPA(C1=__builtin_amdgcn_mfma_f32_32x32x16_bf16(kf[3],qr[1],C1,0,0,0),   P0[14],P0[15],P1[0],P1[1],   pw1[2]=PKW(P0,12),pw1[3]=PKW(P0,14), pw1); \
    VRD(2); SBAR(); GAPA(C0=__builtin_amdgcn_mfma_f32_32x32x16_bf16(kf[4],qr[2],C0,0,0,0),   P1[2],P1[3],P1[4],P1[5],     pw2[0]=PKW(P1,0), pw2[1]=PKW(P1,2), pw2); \
    VRD(6); SBAR(); GAPA(C1=__builtin_amdgcn_mfma_f32_32x32x16_bf16(kf[5],qr[2],C1,0,0,0),   P1[6],P1[7],P1[8],P1[9],     pw2[2]=PKW(P1,4), pw2[3]=PKW(P1,6), pw2); \
    VRD(3); SBAR(); GAPA(C0=__builtin_amdgcn_mfma_f32_32x32x16_bf16(kf[6],qr[3],C0,0,0,0),   P1[10],P1[11],P1[12],P1[13], pw3[0]=PKW(P1,8), pw3[1]=PKW(P1,10), pw3); \
    VRD(7); SBAR(); GAPA(C1=__builtin_amdgcn_mfma_f32_32x32x16_bf16(kf[7],qr[3],C1,0,0,0),   P1[14],P1[15],0.f,0.f,       pw3[2]=PKW(P1,12),pw3[3]=PKW(P1,14), pw3); \
    l_reg+=sacc; \
    if(GK){DMA_K((t)+3,sl_cur);} if(GV){DMA_V((t)+1,sl_next);} \
    CMASK(C0,C1,t); \
    { float a=MX3(C0[0],C0[1],C1[0]),b=MX3(C0[2],C0[3],C1[1]); a=MX3(a,C1[2],C1[3]); \
      _Pragma("unroll") for(int r=4;r<16;r+=4){a=MX3(a,C0[r],C0[r+1]);b=MX3(b,C0[r+2],C0[r+3]);a=MX3(a,C1[r],C1[r+1]);b=MX3(b,C1[r+2],C1[r+3]);} \
      float rm=__builtin_fmaxf(a,b); { auto rr=__builtin_amdgcn_permlane32_swap(__float_as_uint(rm),__float_as_uint(rm),false,false); rm=__builtin_fmaxf(__uint_as_float(rr[0]),__uint_as_float(rr[1])); } \
      resc=false; \
      if(__builtin_expect(__any(rm>(float)THRL),0)){ const float dl=__builtin_fmaxf(rm,0.f); mhat+=dl; \
        _Pragma("unroll") for(int r=0;r<16;++r){C0[r]-=dl;C1[r]-=dl;} \
        const float f=__builtin_amdgcn_exp2f(-dl); l_reg*=f; if(hi==0)wsf[r32]=f; resc=true; } } \
    SBAR(); \
    GAPB(o[0]=__builtin_amdgcn_mfma_f32_32x32x16_bf16(PAF(0),VFR(0),o[0],0,0,0), C0,0); \
    GAPB(o[1]=__builtin_amdgcn_mfma_f32_32x32x16_bf16(PAF(0),VFR(4),o[1],0,0,0), C0,4); \
    KRD(GL,0); GAPB(o[0]=__builtin_amdgcn_mfma_f32_32x32x16_bf16(PAF(1),VFR(1),o[0],0,0,0), C0,8); \
    KRD(GL,1); GAPB(o[1]=__builtin_amdgcn_mfma_f32_32x32x16_bf16(PAF(1),VFR(5),o[1],0,0,0), C0,12); \
    KRD(GL,2); GAPB(o[0]=__builtin_amdgcn_mfma_f32_32x32x16_bf16(PAF(2),VFR(2),o[0],0,0,0), C1,0); \
    KRD(GL,3); GAPB(o[1]=__builtin_amdgcn_mfma_f32_32x32x16_bf16(PAF(2),VFR(6),o[1],0,0,0), C1,4); \
    GAPB(o[0]=__builtin_amdgcn_mfma_f32_32x32x16_bf16(PAF(3),VFR(3),o[0],0,0,0), C1,8); \
    GAPB(o[1]=__builtin_amdgcn_mfma_f32_32x32x16_bf16(PAF(3),VFR(7),o[1],0,0,0), C1,12); \
    }while(0)
  int t=1;
  #undef CMASK
  #define CMASK(P0,P1,t) do{}while(0)
  for(;t+5<NT;t+=2){
    STEP(pB0,pB1,pA0,pA1,t,true,true,true);     WAIT_BAR(2); RESC(); ROT();
    STEP(pA0,pA1,pB0,pB1,t+1,true,true,true);   WAIT_BAR(2); RESC(); ROT();
  }
  #undef CMASK
  #define CMASK(P0,P1,t) do{int jb_=(t)-(NT-4); if(jb_>=0)cmask(P0,P1,jb_,qrel,hi);}while(0)
  #define ENDW(tt) do{ if((tt)+3<NT){WAIT_BAR(2);} else if((tt)+2<NT){WAIT_BAR(1);} else {WAIT_BAR(0);} }while(0)
  for(;t+1<NT;t+=2){
    STEP(pB0,pB1,pA0,pA1,t,(t+3<NT),(t+1<NT),(t+1<NT));       ENDW(t);   RESC(); ROT();
    STEP(pA0,pA1,pB0,pB1,t+1,(t+4<NT),(t+2<NT),(t+2<NT));     ENDW(t+1); RESC(); ROT();
  }
  STEP(pB0,pB1,pA0,pA1,NT-1,false,false,false); RESC();
  { float sacc=pB0[0]+pB0[1]; _Pragma("unroll") for(int r=2;r<16;++r)sacc+=pB0[r]; _Pragma("unroll") for(int r=0;r<16;++r)sacc+=pB1[r]; l_reg+=sacc;
    pw0=(u32x4){PKW(pB0,0),PKW(pB0,2),PKW(pB0,4),PKW(pB0,6)};pw1=(u32x4){PKW(pB0,8),PKW(pB0,10),PKW(pB0,12),PKW(pB0,14)};pw2=(u32x4){PKW(pB1,0),PKW(pB1,2),PKW(pB1,4),PKW(pB1,6)};pw3=(u32x4){PKW(pB1,8),PKW(pB1,10),PKW(pB1,12),PKW(pB1,14)};
    SBAR(); pv(o,vb0+sl_cur,PAF(0),PAF(1),PAF(2),PAF(3)); }
  #undef PKW
  #undef PAF
  #undef VFR
  #undef PIN
  #undef MX3
  #undef GAPA
  #undef GAPB
  #undef EX
  #undef VRD
  #undef KRD
  #undef STEP
  #undef ENDW
  {auto rr=__builtin_amdgcn_permlane32_swap(__float_as_uint(l_reg),__float_as_uint(l_reg),false,false);l_reg=__uint_as_float(rr[0])+__uint_as_float(rr[1]);}
  if(hi==0)wsf[32+r32]=l_reg;asm volatile("s_waitcnt lgkmcnt(0)":::"memory");
  float rli[16];
  #pragma unroll
  for(int r=0;r<16;++r)rli[r]=__builtin_amdgcn_rcpf(wsf[32+crow(r,hi)]);
  bf16*Ow=O+(rowbase+q0+wid*QBLK)*DM+h*D; const bf16*Gw=Gt+(rowbase+q0+wid*QBLK)*DM+h*D;
  { bf16*stg=(bf16*)(shm+LDS_OST)+wid*2048;
    #pragma unroll
    for(int r=0;r<16;++r){const int orow=crow(r,hi);
      #pragma unroll
      for(int d0=0;d0<2;++d0)stg[orow*64+d0*32+r32]=__float2bfloat16(o[d0][r]*rli[r]);}
    asm volatile("s_waitcnt lgkmcnt(0)":::"memory");
    #pragma unroll
    for(int i=0;i<4;++i){const int row=i*8+(lane>>3),ch=lane&7; const u32x4 v=*(const u32x4*)(stg+row*64+ch*8); const u32x4 g=*(const u32x4*)(Gw+(long)row*DM+ch*8); u32x4 w;
      #pragma unroll
      for(int e=0;e<4;++e){ const float o0=__uint_as_float(v[e]<<16),o1=__uint_as_float(v[e]&0xffff0000u),g0=__uint_as_float(g[e]<<16),g1=__uint_as_float(g[e]&0xffff0000u);
        w[e]=cvtpk_s(o0*g0*__builtin_amdgcn_rcpf(1.f+__expf(-g0)),o1*g1*__builtin_amdgcn_rcpf(1.f+__expf(-g1))); }
      ATTN_STORE16(Ow+(long)row*DM+ch*8,w);} }
  asm volatile("s_waitcnt lgkmcnt(0)\n\ts_barrier":::"memory");
  #undef DMA_K
  #undef DMA_V
  #undef CMASK
  #undef START
  #undef RESC
  #undef ROT
  #undef MKQM
  #undef BIAS
}
constexpr int ATTN_LDS_BYTES=LDS_BYTES;
struct AttnTensors { const bf16* Q; const bf16* K; const bf16* V; const float* CB; const unsigned* QKM; const bf16* G; bf16* O; };
struct AttnUnit { int bh; int qb; };
struct StaticOrder {
  int vcu;
  __device__ __forceinline__ explicit StaticOrder(int grid,int block):vcu((block%8)*(grid/8)+block/8){}
  __device__ __forceinline__ bool next(int i,AttnUnit&u)const{ if(i>=4)return false; const int s=vcu&7; u.bh=vcu>>3; u.qb=(i==0)?s:(i==1)?15-s:(i==2)?16+s:31-s; return true; }
  __device__ __forceinline__ void a_ready(const AttnUnit&)const{}
  __device__ __forceinline__ void done(const AttnUnit&)const{}
};
template<class Sched,int THRL=8> __device__ __forceinline__ void attn_phase(char*lds,const AttnTensors&T,const Sched&S,const int wave_k){
  AttnUnit u;
  for(int i=0;S.next(i,u);++i){ S.a_ready(u); attn_unit<THRL>(u.bh/NHEAD,u.bh%NHEAD,u.qb,T.Q,T.K,T.V,T.CB,T.QKM,T.G,T.O,lds,wave_k); S.done(u); }
}
#undef SBAR
#undef WAIT_BAR
}

#define LAS __attribute__((address_space(3)))
#define XB_TMO      128
#define XB_XCNT(j)  (256  + 64 * (j))
#define XB_XSUB(j)  (1280 + 64 * (j))
#define XB_XGEN(j)  (2304 + 64 * (j))
#define XB_TOP      3328
#define XB_TOPGEN   3392
#define XCD_BAR_WORDS 3456
#define XB_SPIN_CAP (1u << 18)

__device__ __forceinline__ unsigned xb_ld(unsigned* p)              { return __hip_atomic_load(p, __ATOMIC_RELAXED, __HIP_MEMORY_SCOPE_AGENT); }
__device__ __forceinline__ unsigned xb_add(unsigned* p, unsigned v) { return __hip_atomic_fetch_add(p, v, __ATOMIC_RELAXED, __HIP_MEMORY_SCOPE_AGENT); }
__device__ __forceinline__ unsigned xb_xcc_id() { return (unsigned)__builtin_amdgcn_s_getreg((3 << 11) | 20) & 0xFu; }
#define XB_SPIN(cond, bar) do { unsigned _sp = 0; while (cond) { __builtin_amdgcn_s_sleep(1); \
    if ((++_sp & 255u) == 0u) { if (xb_ld(&(bar)[XB_TMO])) break; if (_sp > XB_SPIN_CAP) { atomicAdd(&(bar)[XB_TMO], 1u); break; } } } } while (0)

struct XcdBarrier {
    unsigned* bar; unsigned x;
    volatile LAS unsigned* st;
};

__device__ __forceinline__ XcdBarrier xcd_barrier_post(unsigned* bar, volatile LAS unsigned* st) {
    XcdBarrier b; b.bar = bar; b.x = xb_xcc_id(); b.st = st;
    if (threadIdx.x == 0) (void)xb_add(&bar[XB_XCNT(b.x)], 1u);
    return b;
}
__device__ __forceinline__ void xcd_barrier_complete(unsigned* bar, unsigned x_in, unsigned& nloc, unsigned& nx) { unsigned x = x_in;
    const unsigned G = gridDim.x * gridDim.y * gridDim.z;
    asm volatile("" : "+s"(x));
    unsigned sum, cnt, mine, sp = 0u;
    for (;;) {
        sum = 0u; cnt = 0u; mine = 0u;
#pragma unroll
        for (unsigned j = 0; j < 16; ++j) { const unsigned c = xb_ld(&bar[XB_XCNT(j)]); sum += c; cnt += (c > 0u) ? 1u : 0u; mine = (j == x) ? c : mine; }
        if (sum == G) break;
        __builtin_amdgcn_s_sleep(1);
        if ((++sp & 255u) == 0u) { if (xb_ld(&bar[XB_TMO])) break; if (sp > XB_SPIN_CAP) { atomicAdd(&bar[XB_TMO], 1u); break; } }
    }
    nloc = mine > 0u ? mine : 1u; nx = cnt > 0u ? cnt : 1u;
}

__device__ __forceinline__ void xcd_barrier(const XcdBarrier& b, const bool t0  ) {
    asm volatile("s_waitcnt vmcnt(0)" ::: "memory");
    __syncthreads();
    if (t0) {
        unsigned* bar = b.bar;
        __builtin_amdgcn_s_waitcnt(0);
        unsigned nloc = b.st[0], nx = b.st[1];
        if (nloc == 0u) { xcd_barrier_complete(bar, b.x, nloc, nx); b.st[0] = nloc; b.st[1] = nx; }
        const unsigned old = xb_add(&bar[XB_XSUB(b.x)], 1u);
        const unsigned gen = old / nloc;
        if (old + 1u == (gen + 1u) * nloc) {
            __builtin_amdgcn_fence(__ATOMIC_RELEASE, "agent");
            asm volatile("s_waitcnt vmcnt(0)" ::: "memory");
            const unsigned og = xb_add(&bar[XB_TOP], 1u);
            const unsigned tg = og / nx;
            if (og + 1u == (tg + 1u) * nx) xb_add(&bar[XB_TOPGEN], 1u);
            else XB_SPIN(xb_ld(&bar[XB_TOPGEN]) == tg, bar);
            __builtin_amdgcn_fence(__ATOMIC_ACQUIRE, "agent");
            xb_add(&bar[XB_XGEN(b.x)], 1u);
            asm volatile("s_waitcnt vmcnt(0)" ::: "memory");
        } else {
            XB_SPIN(xb_ld(&bar[XB_XGEN(b.x)]) == gen, bar);
            __builtin_amdgcn_fence(__ATOMIC_ACQUIRE, "agent");
            asm volatile("s_waitcnt vmcnt(0)" ::: "memory");
        }
    }
    __syncthreads();
}

typedef unsigned short bf16_t;
typedef short bf16x8 __attribute__((ext_vector_type(8)));
typedef float f32x4 __attribute__((ext_vector_type(4)));
typedef unsigned u32x4 __attribute__((ext_vector_type(4)));
typedef unsigned u32x2 __attribute__((ext_vector_type(2)));
__device__ __forceinline__ float bf2f(bf16_t v) { return __uint_as_float((unsigned)v << 16); }
__device__ __forceinline__ unsigned f2bfu(float f) { unsigned u = __float_as_uint(f); return (u + 0x7fffu + ((u >> 16) & 1u)) >> 16; }
__device__ __forceinline__ bf16_t f2bf(float f) { return (bf16_t)f2bfu(f); }
__device__ __forceinline__ unsigned pk2(float lo, float hi) { return f2bfu(lo) | (f2bfu(hi) << 16); }
__device__ __forceinline__ float sigmoidf_(float x) { return __builtin_amdgcn_rcpf(1.0f + __expf(-x)); }
__device__ __forceinline__ float siluf_(float x) { return x * __builtin_amdgcn_rcpf(1.0f + __expf(-x)); }
template <int CTRL> __device__ __forceinline__ float dppf(float v) { return __int_as_float(__builtin_amdgcn_update_dpp(0, __float_as_int(v), CTRL, 0xf, 0xf, true)); }
__device__ __forceinline__ float allred16(float v) { v += dppf<0xB1>(v); v += dppf<0x4E>(v); v += dppf<0x141>(v); v += dppf<0x140>(v); return v; }
__device__ __forceinline__ float rdlane(float v, int l) { return __int_as_float(__builtin_amdgcn_readlane(__float_as_int(v), l)); }
__device__ __forceinline__ float wave_sum(float v) { v = allred16(v); return (rdlane(v, 0) + rdlane(v, 16)) + (rdlane(v, 32) + rdlane(v, 48)); }
__device__ __forceinline__ void ld8bf(const bf16_t* p, float (&o)[8]) {
    const u32x4 v = *(const u32x4*)p;
#pragma unroll
    for (int i = 0; i < 4; ++i) { o[2 * i] = __uint_as_float(v[i] << 16); o[2 * i + 1] = __uint_as_float(v[i] & 0xffff0000u); }
}
__device__ __forceinline__ void ld4bf(const bf16_t* p, float (&o)[4]) {
    const u32x2 v = *(const u32x2*)p;
#pragma unroll
    for (int i = 0; i < 2; ++i) { o[2 * i] = __uint_as_float(v[i] << 16); o[2 * i + 1] = __uint_as_float(v[i] & 0xffff0000u); }
}

struct EpiG1 {
    static constexpr bool PERM = true, AFTER_DRAIN = false; static constexpr int NST = 16; unsigned char* ws;
    __device__ __forceinline__ void operator()(const f32x4 (&acc)[2][2][4][2], const pg8::Unit& u, int wr, int wc, int fr, int fq) const {
        const int pn = u.pn, row0 = u.pm * 256 + wr * 64 + fr, cin = wc * 32 + 8 * fq;
        if (pn == 56) {
            float* S = (float*)(ws + O_S);
#pragma unroll
            for (int ai = 0; ai < 2; ++ai)
#pragma unroll
                for (int m = 0; m < 4; ++m) { float* rp = S + (size_t)(row0 + ai * 128 + m * 16) * 256 + cin;
#pragma unroll
                    for (int bj = 0; bj < 2; ++bj) { *(f32x4*)(rp + bj * 128) = acc[ai][bj][m][0]; *(f32x4*)(rp + bj * 128 + 4) = acc[ai][bj][m][1]; } }
            return;
        }
        size_t off; int ldc, coff; float sc = 1.f;
        if (pn < 16) { off = O_UA; ldc = 4096; coff = pn * 256; }
        else if (pn < 28) { off = O_UB; ldc = 3072; coff = (pn - 16) * 256; }
        else if (pn < 56) { const int sidx = (pn - 28) >> 2; off = O_GB + (size_t)sidx * (32 * MiB); ldc = 1024; coff = ((pn - 28) & 3) * 256; if (sidx == 1) sc = C2; }
        else { off = O_ML; ldc = 8192; coff = (pn - 57) * 256; }
        bf16_t* base = (bf16_t*)(ws + off) + coff + cin;
#pragma unroll
        for (int ai = 0; ai < 2; ++ai)
#pragma unroll
            for (int m = 0; m < 4; ++m) { bf16_t* rowp = base + (size_t)(row0 + ai * 128 + m * 16) * ldc;
#pragma unroll
                for (int bj = 0; bj < 2; ++bj) { const f32x4 v0 = acc[ai][bj][m][0] * sc, v1 = acc[ai][bj][m][1] * sc; u32x4 w;
                    w.x = pg8::cvt_pk_bf16(v0[0], v0[1]); w.y = pg8::cvt_pk_bf16(v0[2], v0[3]); w.z = pg8::cvt_pk_bf16(v1[0], v1[1]); w.w = pg8::cvt_pk_bf16(v1[2], v1[3]);
                    *(u32x4*)(rowp + bj * 128) = w; } }
    }
};
struct EpiML {
    static constexpr bool PERM = true, AFTER_DRAIN = false; static constexpr int NST = 16; unsigned char* ws;
    __device__ __forceinline__ void operator()(const f32x4 (&acc)[2][2][4][2], const pg8::Unit& u, int wr, int wc, int fr, int fq) const {
        const int row0 = u.pm * 256 + wr * 64 + fr; bf16_t* base = (bf16_t*)(ws + O_ML) + (u.pn + 3) * 256 + wc * 32 + 8 * fq;
#pragma unroll
        for (int ai = 0; ai < 2; ++ai)
#pragma unroll
            for (int m = 0; m < 4; ++m) { bf16_t* rowp = base + (size_t)(row0 + ai * 128 + m * 16) * 8192;
#pragma unroll
                for (int bj = 0; bj < 2; ++bj) { const f32x4 v0 = acc[ai][bj][m][0], v1 = acc[ai][bj][m][1]; u32x4 w;
                    w.x = pg8::cvt_pk_bf16(v0[0], v0[1]); w.y = pg8::cvt_pk_bf16(v0[2], v0[3]); w.z = pg8::cvt_pk_bf16(v1[0], v1[1]); w.w = pg8::cvt_pk_bf16(v1[2], v1[3]);
                    *(u32x4*)(rowp + bj * 128) = w; } }
    }
};
struct PoolOrder {
    int G, c;
    __device__ bool next(int i, pg8::Unit& u) const { const int j = i * G + c; if (j >= 256) return false; u.pm = j; u.pn = j >> 6; return true; }
    __device__ __forceinline__ void a_ready(const pg8::Unit&) const {}
    __device__ __forceinline__ void done(const pg8::Unit&) const {}
};
struct RangeOrder {
    pg8::StaticOrder S; int i0, i1;
    __device__ bool next(int i, pg8::Unit& u) const { return (i0 + i < i1) && S.next(i0 + i, u); }
    __device__ __forceinline__ void a_ready(const pg8::Unit&) const {}
    __device__ __forceinline__ void done(const pg8::Unit&) const {}
};
struct EpiPool {
    static constexpr bool PERM = true, AFTER_DRAIN = false; static constexpr int NST = 16; unsigned char* ws; const float* ps;
    __device__ __forceinline__ void operator()(const f32x4 (&acc)[2][2][4][2], const pg8::Unit& u, int wr, int wc, int fr, int fq) const {
        const int g = u.pn, row0 = (u.pm & 63) * 256 + wr * 64 + fr, col0 = g * 256 + wc * 32 + 8 * fq;
        const bf16_t* GD = (const bf16_t*)(ws + O_GD) + col0; bf16_t* Y = (bf16_t*)(ws + O_Y) + (size_t)3 * T * W + col0; const float* psc = ps + col0;
#pragma unroll
        for (int ai = 0; ai < 2; ++ai)
#pragma unroll
            for (int m = 0; m < 4; ++m) { const size_t row = (size_t)(row0 + ai * 128 + m * 16);
#pragma unroll
                for (int bj = 0; bj < 2; ++bj) { float gd[8]; ld8bf(GD + row * W + bj * 128, gd);
                    const f32x4 p0 = *(const f32x4*)(psc + bj * 128), p1 = *(const f32x4*)(psc + bj * 128 + 4); float o[8];
#pragma unroll
                    for (int e = 0; e < 4; ++e) { o[e] = acc[ai][bj][m][0][e] * p0[e] * siluf_(gd[e]); o[4 + e] = acc[ai][bj][m][1][e] * p1[e] * siluf_(gd[4 + e]); }
                    u32x4 w; w.x = pg8::cvt_pk_bf16(o[0], o[1]); w.y = pg8::cvt_pk_bf16(o[2], o[3]); w.z = pg8::cvt_pk_bf16(o[4], o[5]); w.w = pg8::cvt_pk_bf16(o[6], o[7]);
                    *(u32x4*)(Y + row * W + bj * 128) = w; }
                if (m & 1) asm volatile("" ::: "memory"); }
    }
};
struct EpiG2 {
    static constexpr bool PERM = true, AFTER_DRAIN = false; static constexpr int NST = 16; unsigned char* ws; const float* w0; const float* a0;
    __device__ __forceinline__ void operator()(const f32x4 (&acc)[2][2][4][2], const pg8::Unit& u, int wr, int wc, int fr, int fq) const {
        const int row0 = u.pm * 256 + wr * 64 + fr; const bool dec = u.pn < 4; const int col0 = (u.pn & 3) * 256 + wc * 32 + 8 * fq;
        bf16_t* out = (bf16_t*)(ws + (dec ? O_WDEC : O_ASIG)) + col0; const float* bias = (dec ? w0 : a0) + col0;
        const float mul = dec ? 0.6065306597126334f : 1.0f;
#pragma unroll
        for (int ai = 0; ai < 2; ++ai)
#pragma unroll
            for (int m = 0; m < 4; ++m) { bf16_t* rp = out + (size_t)(row0 + ai * 128 + m * 16) * W;
#pragma unroll
                for (int bj = 0; bj < 2; ++bj) { float o[8]; const f32x4 b0 = *(const f32x4*)(bias + bj * 128), b1 = *(const f32x4*)(bias + bj * 128 + 4);
#pragma unroll
                    for (int e = 0; e < 4; ++e) { o[e] = mul * sigmoidf_(acc[ai][bj][m][0][e] + b0[e]); o[4 + e] = mul * sigmoidf_(acc[ai][bj][m][1][e] + b1[e]); }
                    u32x4 w; w.x = pg8::cvt_pk_bf16(o[0], o[1]); w.y = pg8::cvt_pk_bf16(o[2], o[3]); w.z = pg8::cvt_pk_bf16(o[4], o[5]); w.w = pg8::cvt_pk_bf16(o[6], o[7]);
                    *(u32x4*)(rp + bj * 128) = w; }
                asm volatile("" ::: "memory"); }
    }
};
struct EpiG3Q {
    static constexpr bool PERM = true, AFTER_DRAIN = false; static constexpr int NST = 16; unsigned char* ws; const float* bm; int wg;
    __device__ __forceinline__ void operator()(const f32x4 (&acc)[2][2][4][2], const pg8::Unit& u, int wr, int wc, int fr, int fq) const {
        const int kb = u.pn >> 3, pn = u.pn & 7, pm = u.pm & 63;
        const size_t slab = ((size_t)(wg >> 3) * 3) * (256 * D) + (size_t)(wg & 7) * 256 - ((size_t)pm * 256 * D + (size_t)pn * 256);
        const int row0 = pm * 256 + wr * 64 + fr, col0 = pn * 256 + wc * 32 + 8 * fq;
        const bf16_t* ML = (const bf16_t*)(ws + O_ML) + kb * 2048 + col0; const float* bmk = bm + kb * 2048 + col0;
        f32x4 bv[2][2];
#pragma unroll
        for (int bj = 0; bj < 2; ++bj) { bv[bj][0] = *(const f32x4*)(bmk + bj * 128); bv[bj][1] = *(const f32x4*)(bmk + bj * 128 + 4); }
        if (kb < 3) {
            bf16_t* GP = (bf16_t*)(ws + O_GP) + slab + (size_t)kb * (256 * D) + col0;
#pragma unroll
            for (int ai = 0; ai < 2; ++ai) {
                u32x4 mlv[4][2];
#pragma unroll
                for (int m = 0; m < 4; ++m)
#pragma unroll
                    for (int bj = 0; bj < 2; ++bj) mlv[m][bj] = *(const u32x4*)(ML + (size_t)(row0 + ai * 128 + m * 16) * 8192 + bj * 128);
#pragma unroll
                for (int m = 0; m < 4; ++m) { const size_t row = (size_t)(row0 + ai * 128 + m * 16);
#pragma unroll
                    for (int bj = 0; bj < 2; ++bj) {
                        float ml[8];
#pragma unroll
                        for (int i = 0; i < 4; ++i) { ml[2 * i] = __uint_as_float(mlv[m][bj][i] << 16); ml[2 * i + 1] = __uint_as_float(mlv[m][bj][i] & 0xffff0000u); }
                        f32x4 s0, s1;
#pragma unroll
                        for (int e = 0; e < 4; ++e) { s0[e] = sigmoidf_(ml[e] + bv[bj][0][e]) * acc[ai][bj][m][0][e]; s1[e] = sigmoidf_(ml[4 + e] + bv[bj][1][e]) * acc[ai][bj][m][1][e]; }
                        u32x4 w; w.x = pg8::cvt_pk_bf16(s0[0], s0[1]); w.y = pg8::cvt_pk_bf16(s0[2], s0[3]); w.z = pg8::cvt_pk_bf16(s1[0], s1[1]); w.w = pg8::cvt_pk_bf16(s1[2], s1[3]);
                        *(u32x4*)(GP + row * D + bj * 128) = w;
                    } }
                asm volatile("" ::: "memory"); }
        } else {
            const bf16_t* GP = (const bf16_t*)(ws + O_GP) + slab + col0; bf16_t* MG = (bf16_t*)(ws + O_MG) + col0;
#pragma unroll
            for (int ai = 0; ai < 2; ++ai)
#pragma unroll
                for (int mp = 0; mp < 2; ++mp) {
                    u32x4 mlv[2][2], gp[3][2][2];
#pragma unroll
                    for (int mm = 0; mm < 2; ++mm)
#pragma unroll
                        for (int bj = 0; bj < 2; ++bj) { const size_t row = (size_t)(row0 + ai * 128 + (2 * mp + mm) * 16);
                            mlv[mm][bj] = *(const u32x4*)(ML + row * 8192 + bj * 128);
#pragma unroll
                            for (int k = 0; k < 3; ++k) gp[k][mm][bj] = *(const u32x4*)(GP + (size_t)k * (256 * D) + row * D + bj * 128); }
#pragma unroll
                    for (int mm = 0; mm < 2; ++mm) { const int m = 2 * mp + mm; const size_t row = (size_t)(row0 + ai * 128 + m * 16);
#pragma unroll
                        for (int bj = 0; bj < 2; ++bj) { u32x4 w;
#pragma unroll
                            for (int i = 0; i < 4; ++i) { const int n = i >> 1, e = (i & 1) * 2;
                                float lo = sigmoidf_(__uint_as_float(mlv[mm][bj][i] << 16) + bv[bj][n][e]) * acc[ai][bj][m][n][e], hi = sigmoidf_(__uint_as_float(mlv[mm][bj][i] & 0xffff0000u) + bv[bj][n][e + 1]) * acc[ai][bj][m][n][e + 1];
#pragma unroll
                                for (int k = 0; k < 3; ++k) { lo += __uint_as_float(gp[k][mm][bj][i] << 16); hi += __uint_as_float(gp[k][mm][bj][i] & 0xffff0000u); }
                                w[i] = pg8::cvt_pk_bf16(lo, hi); }
                            *(u32x4*)(MG + row * D + bj * 128) = w; } }
                    asm volatile("" ::: "memory"); }
        }
    }
};
struct BranchOrder {
    pg8::StaticOrder S0;
    __device__ void init(int G, int c) { S0.init(T, D, G, c); }
    __device__ bool next(int i, pg8::Unit& u) const { pg8::Unit t; if (!S0.next(i >> 2, t)) return false; const int kb = i & 3; u.pm = kb * 64 + t.pm; u.pn = kb * 8 + t.pn; return true; }
    __device__ __forceinline__ void a_ready(const pg8::Unit&) const {}
    __device__ __forceinline__ void done(const pg8::Unit&) const {}
};
__device__ __forceinline__ void g3_sum(unsigned char* ws, const BranchOrder& S, int tid) {
    const bf16_t* GP = (const bf16_t*)(ws + O_GP); bf16_t* MG = (bf16_t*)(ws + O_MG);
    pg8::Unit t;
    for (int j = 0; S.S0.next(j, t); ++j)
        for (int i0 = tid; i0 < 256 * 32; i0 += 4 * 512) {
            u32x4 v[4][4];
#pragma unroll
            for (int q = 0; q < 4; ++q) { const int i = i0 + q * 512, r = i >> 5, c8 = (i & 31) * 8; const size_t off = (size_t)(t.pm * 256 + r) * D + t.pn * 256 + c8;
#pragma unroll
                for (int kb = 0; kb < 4; ++kb) v[q][kb] = *(const u32x4*)(GP + (size_t)kb * T * D + off); }
#pragma unroll
            for (int q = 0; q < 4; ++q) { const int i = i0 + q * 512, r = i >> 5, c8 = (i & 31) * 8; const size_t off = (size_t)(t.pm * 256 + r) * D + t.pn * 256 + c8; u32x4 w;
#pragma unroll
                for (int e = 0; e < 4; ++e) { float lo = 0.f, hi = 0.f;
#pragma unroll
                    for (int kb = 0; kb < 4; ++kb) { lo += __uint_as_float(v[q][kb][e] << 16); hi += __uint_as_float(v[q][kb][e] & 0xffff0000u); }
                    w[e] = pk2(lo, hi); }
                *(u32x4*)(MG + off) = w; }
        }
}
struct EpiG4 {
    static constexpr bool PERM = true, AFTER_DRAIN = false; static constexpr int NST = 32; const float* xin32; const bf16_t* xinb; bf16_t* xout;
    __device__ __forceinline__ void operator()(const f32x4 (&acc)[2][2][4][2], const pg8::Unit& u, int wr, int wc, int fr, int fq) const {
        const int row0 = u.pm * 256 + wr * 64 + fr, col0 = u.pn * 256 + wc * 32 + 8 * fq;
        if (xin32) {
#pragma unroll
            for (int q8 = 0; q8 < 4; ++q8) { const int ai = q8 >> 1, m0 = (q8 & 1) * 2;
                f32x4 xv[2][2][2];
#pragma unroll
                for (int mm = 0; mm < 2; ++mm) { const size_t off = (size_t)(row0 + ai * 128 + (m0 + mm) * 16) * D + col0;
#pragma unroll
                    for (int bj = 0; bj < 2; ++bj) { xv[mm][bj][0] = *(const f32x4*)(xin32 + off + bj * 128); xv[mm][bj][1] = *(const f32x4*)(xin32 + off + bj * 128 + 4); } }
#pragma unroll
                for (int mm = 0; mm < 2; ++mm) { const size_t off = (size_t)(row0 + ai * 128 + (m0 + mm) * 16) * D + col0;
#pragma unroll
                    for (int bj = 0; bj < 2; ++bj) { const f32x4 x0 = xv[mm][bj][0] + acc[ai][bj][m0 + mm][0], x1 = xv[mm][bj][1] + acc[ai][bj][m0 + mm][1]; u32x4 w;
                        w.x = pg8::cvt_pk_bf16(x0[0], x0[1]); w.y = pg8::cvt_pk_bf16(x0[2], x0[3]); w.z = pg8::cvt_pk_bf16(x1[0], x1[1]); w.w = pg8::cvt_pk_bf16(x1[2], x1[3]);
                        *(u32x4*)(xout + off + bj * 128) = w; } }
                asm volatile("" ::: "memory"); }
        } else {
#pragma unroll
            for (int ai = 0; ai < 2; ++ai) {
                u32x4 xv[4][2];
#pragma unroll
                for (int m = 0; m < 4; ++m)
#pragma unroll
                    for (int bj = 0; bj < 2; ++bj) xv[m][bj] = *(const u32x4*)(xinb + (size_t)(row0 + ai * 128 + m * 16) * D + col0 + bj * 128);
#pragma unroll
                for (int m = 0; m < 4; ++m) { const size_t off = (size_t)(row0 + ai * 128 + m * 16) * D + col0;
#pragma unroll
                    for (int bj = 0; bj < 2; ++bj) { u32x4 w;
#pragma unroll
                        for (int i = 0; i < 4; ++i) { const int n = i >> 1, e = (i & 1) * 2;
                            const float lo = __uint_as_float(xv[m][bj][i] << 16) + acc[ai][bj][m][n][e], hi = __uint_as_float(xv[m][bj][i] & 0xffff0000u) + acc[ai][bj][m][n][e + 1];
                            w[i] = pg8::cvt_pk_bf16(lo, hi); }
                        *(u32x4*)(xout + off + bj * 128) = w; } }
                asm volatile("" ::: "memory"); }
        }
    }
};
__device__ __forceinline__ int win_col(int n) {
    if (n < PGB) return n;
    if (n < PQ) return OBG + (n - PGB);
    if (n < PGC) return OCQ + (n - PQ);
    if (n < PUD) return OCG + (n - PGC);
    if (n < PGD) return ODI + (n - PUD);
    if (n < PS) return ODG + (n - PGD);
    if (n < PML) { const int j = n - PS; if (j < 64) return OWL + j; if (j < 128) return OAL + (j - 64); if (j < 144) return OCF + (j - 128); return -1; }
    return OML + (n - PML);
}
__device__ __forceinline__ void p1_weights(const Params& p, LAS unsigned char* lds, int gw, int ngw, int wave, int lane, size_t gt, size_t ngt) {
    LAS float* scr = (LAS float*)(lds + wave * 9216);
    constexpr int I0 = 4 * (NP / 32) * (D / 64), I1 = 16 * (D / 32) * (W / 64), I2 = 4 * (D / 32) * (D / 64), I3 = 16 * (256 / 32) * (256 / 64);
    for (int it = gw; it < I0 + I1 + I2 + I3; it += ngw) {
        int mode, r = it; if (r < I0) mode = 0; else if (r < I0 + I1) { mode = 1; r -= I0; } else if (r < I0 + I1 + I2) { mode = 2; r -= I0 + I1; } else { mode = 3; r -= I0 + I1 + I2; }
        const int N = (mode == 0) ? NP : (mode == 3 ? 256 : D), K = (mode == 1) ? W : (mode == 3 ? 256 : D), nb = N / 32, per = nb * (K / 64);
        const int mat = r / per, q = r % per, n0 = (q % nb) * 32, k0 = (q / nb) * 64, n4 = (lane & 7) * 4, kr = lane >> 3;
        const float* src; long ld; bf16_t* dst; int col;
        if (mode == 0) { col = win_col(n0 + n4); src = p.in[I_WIN] + (size_t)mat * D * NIN; ld = NIN; dst = (bf16_t*)(p.ws + O_WTIN) + (size_t)mat * NP * D; }
        else if (mode == 1) { src = p.in[I_WB] + (size_t)mat * W * D; ld = D; col = n0 + n4; dst = (bf16_t*)(p.ws + O_WTBR) + (size_t)mat * D * W; }
        else if (mode == 2) { src = p.in[I_WO] + (size_t)mat * D * D; ld = D; col = n0 + n4; dst = (bf16_t*)(p.ws + O_WTOUT) + (size_t)mat * D * D; }
        else { src = p.in[I_PW] + (size_t)mat * 65536; ld = 256; col = n0 + n4; dst = (bf16_t*)(p.ws + O_WD) + (size_t)mat * 65536; }
#pragma unroll
        for (int i = 0; i < 8; ++i) { const int kk = 8 * i + kr; const f32x4 v = (col >= 0) ? *(const f32x4*)(src + (size_t)(k0 + kk) * ld + col) : (f32x4){0.f, 0.f, 0.f, 0.f}; *(LAS f32x4*)(scr + kk * 36 + n4) = v; }
        asm volatile("s_waitcnt lgkmcnt(0)" ::: "memory");
        const int c = lane & 7;
#pragma unroll
        for (int j = 0; j < 4; ++j) { const int n = (lane >> 3) + 8 * j; const LAS float* sp = scr + (8 * c) * 36 + n; u32x4 o;
            o.x = pk2(sp[0 * 36], sp[1 * 36]); o.y = pk2(sp[2 * 36], sp[3 * 36]); o.z = pk2(sp[4 * 36], sp[5 * 36]); o.w = pk2(sp[6 * 36], sp[7 * 36]);
            *(u32x4*)(dst + (size_t)(n0 + n) * K + k0 + 8 * c) = o; }
        asm volatile("s_waitcnt lgkmcnt(0)" ::: "memory");
    }
    for (size_t i = gt; i < (size_t)4 * 2048 * 256; i += ngt) {
        const int k = (int)(i & 255), n = (int)((i >> 8) & 2047), l = (int)(i >> 19);
        float v = 0.f;
        if (n < 1024) { if (k < 64) v = p.in[I_W2][((size_t)l * 64 + k) * W + n]; }
        else { if (k >= 64 && k < 128) v = p.in[I_A2][((size_t)l * 64 + (k - 64)) * W + (n - 1024)]; }
        ((bf16_t*)(p.ws + O_WTLORA))[i] = f2bf(v);
    }
}
__device__ __forceinline__ void e_rmsnorm(const float* __restrict__ x, const float* __restrict__ g, bf16_t* __restrict__ h, float* __restrict__ outf, int gw, int ngw, int lane, int rend = T) {
    for (int m0 = gw; m0 < rend; m0 += 2 * ngw) {
        const int m1 = (m0 + ngw < rend) ? m0 + ngw : m0;
        const f32x4* xr0 = (const f32x4*)(x + (size_t)m0 * D); const f32x4* xr1 = (const f32x4*)(x + (size_t)m1 * D);
        f32x4 v0[8], v1[8]; float ss0 = 0.f, ss1 = 0.f;
#pragma unroll
        for (int j = 0; j < 8; ++j) { v0[j] = xr0[lane + 64 * j]; v1[j] = xr1[lane + 64 * j]; }
#pragma unroll
        for (int j = 0; j < 8; ++j) { ss0 += (v0[j].x * v0[j].x + v0[j].y * v0[j].y) + (v0[j].z * v0[j].z + v0[j].w * v0[j].w); ss1 += (v1[j].x * v1[j].x + v1[j].y * v1[j].y) + (v1[j].z * v1[j].z + v1[j].w * v1[j].w); }
        ss0 = wave_sum(ss0); ss1 = wave_sum(ss1);
        const float rs0 = rsqrtf(ss0 * (1.0f / D) + 1e-6f), rs1 = rsqrtf(ss1 * (1.0f / D) + 1e-6f);
#pragma unroll
        for (int j = 0; j < 8; ++j) {
            const f32x4 gg = ((const f32x4*)g)[lane + 64 * j];
            const f32x4 o0 = v0[j] * rs0 * gg, o1 = v1[j] * rs1 * gg;
            if (h) { u32x2 w; w.x = pk2(o0.x, o0.y); w.y = pk2(o0.z, o0.w); *(u32x2*)(h + (size_t)m0 * D + (lane + 64 * j) * 4) = w;
                     if (m1 != m0) { w.x = pk2(o1.x, o1.y); w.y = pk2(o1.z, o1.w); *(u32x2*)(h + (size_t)m1 * D + (lane + 64 * j) * 4) = w; } }
            else { ((f32x4*)(outf + (size_t)m0 * D))[lane + 64 * j] = o0; if (m1 != m0) ((f32x4*)(outf + (size_t)m1 * D))[lane + 64 * j] = o1; }
        }
    }
}
__device__ __forceinline__ void e_rmsnorm_bf(const bf16_t* __restrict__ x, const float* __restrict__ g, bf16_t* __restrict__ h, float* __restrict__ outf, int gw, int ngw, int lane, int rend = T) {
    for (int m0 = gw; m0 < rend; m0 += 2 * ngw) {
        const int m1 = (m0 + ngw < rend) ? m0 + ngw : m0;
        const u32x4* xr0 = (const u32x4*)(x + (size_t)m0 * D); const u32x4* xr1 = (const u32x4*)(x + (size_t)m1 * D);
        u32x4 r0[4], r1[4]; float v0[4][8], v1[4][8], ss0 = 0.f, ss1 = 0.f;
#pragma unroll
        for (int j = 0; j < 4; ++j) { r0[j] = xr0[lane + 64 * j]; r1[j] = xr1[lane + 64 * j]; }
#pragma unroll
        for (int j = 0; j < 4; ++j)
#pragma unroll
            for (int i = 0; i < 4; ++i) { v0[j][2 * i] = __uint_as_float(r0[j][i] << 16); v0[j][2 * i + 1] = __uint_as_float(r0[j][i] & 0xffff0000u); v1[j][2 * i] = __uint_as_float(r1[j][i] << 16); v1[j][2 * i + 1] = __uint_as_float(r1[j][i] & 0xffff0000u);
                ss0 += v0[j][2 * i] * v0[j][2 * i] + v0[j][2 * i + 1] * v0[j][2 * i + 1]; ss1 += v1[j][2 * i] * v1[j][2 * i] + v1[j][2 * i + 1] * v1[j][2 * i + 1]; }
        ss0 = wave_sum(ss0); ss1 = wave_sum(ss1);
        const float rs0 = rsqrtf(ss0 * (1.0f / D) + 1e-6f), rs1 = rsqrtf(ss1 * (1.0f / D) + 1e-6f);
#pragma unroll
        for (int j = 0; j < 4; ++j) {
            const f32x4 ga = *(const f32x4*)(g + (lane + 64 * j) * 8), gb = *(const f32x4*)(g + (lane + 64 * j) * 8 + 4);
            float o0[8], o1[8];
#pragma unroll
            for (int e = 0; e < 4; ++e) { o0[e] = v0[j][e] * rs0 * ga[e]; o0[4 + e] = v0[j][4 + e] * rs0 * gb[e]; o1[e] = v1[j][e] * rs1 * ga[e]; o1[4 + e] = v1[j][4 + e] * rs1 * gb[e]; }
            if (h) { u32x4 w; w.x = pk2(o0[0], o0[1]); w.y = pk2(o0[2], o0[3]); w.z = pk2(o0[4], o0[5]); w.w = pk2(o0[6], o0[7]); *(u32x4*)(h + (size_t)m0 * D + (lane + 64 * j) * 8) = w;
                     if (m1 != m0) { w.x = pk2(o1[0], o1[1]); w.y = pk2(o1[2], o1[3]); w.z = pk2(o1[4], o1[5]); w.w = pk2(o1[6], o1[7]); *(u32x4*)(h + (size_t)m1 * D + (lane + 64 * j) * 8) = w; } }
            else { float* p0 = outf + (size_t)m0 * D + (lane + 64 * j) * 8; *(f32x4*)p0 = (f32x4){o0[0], o0[1], o0[2], o0[3]}; *(f32x4*)(p0 + 4) = (f32x4){o0[4], o0[5], o0[6], o0[7]};
                   if (m1 != m0) { float* p1 = outf + (size_t)m1 * D + (lane + 64 * j) * 8; *(f32x4*)p1 = (f32x4){o1[0], o1[1], o1[2], o1[3]}; *(f32x4*)(p1 + 4) = (f32x4){o1[4], o1[5], o1[6], o1[7]}; } }
        }
    }
}
__device__ __forceinline__ void e1_conv(const bf16_t* __restrict__ UA, bf16_t* __restrict__ Y, const float* __restrict__ cw, size_t gt, size_t ngt) {
    for (size_t it = gt; it < (size_t)(T / 4) * 128; it += ngt) {
        const int t0 = (int)(it >> 7) * 4, c = (int)(it & 127) * 8, s0 = t0 & (SEQ - 1);
        float w0[8], w1[8], w2[8], cm2[8], cm1[8], a[8], b2[8];
#pragma unroll
        for (int i = 0; i < 8; ++i) { w0[i] = cw[c + i]; w1[i] = cw[W + c + i]; w2[i] = cw[2 * W + c + i]; cm2[i] = 0.f; cm1[i] = 0.f; }
        u32x4 vb[4], vg[4], va[4], vx[4];
#pragma unroll
        for (int j = 0; j < 4; ++j) { const size_t t = (size_t)(t0 + j); vb[j] = *(const u32x4*)(UA + t * 4096 + c); vg[j] = *(const u32x4*)(UA + t * 4096 + 3072 + c); va[j] = *(const u32x4*)(UA + t * 4096 + 1024 + c); vx[j] = *(const u32x4*)(UA + t * 4096 + 2048 + c); }
        if (s0 > 0) {
            ld8bf(UA + (size_t)(t0 - 2) * 4096 + 1024 + c, a); ld8bf(UA + (size_t)(t0 - 2) * 4096 + 2048 + c, b2);
#pragma unroll
            for (int i = 0; i < 8; ++i) cm2[i] = a[i] * b2[i];
            ld8bf(UA + (size_t)(t0 - 1) * 4096 + 1024 + c, a); ld8bf(UA + (size_t)(t0 - 1) * 4096 + 2048 + c, b2);
#pragma unroll
            for (int i = 0; i < 8; ++i) cm1[i] = a[i] * b2[i];
        }
#pragma unroll
        for (int j = 0; j < 4; ++j) {
            const size_t t = (size_t)(t0 + j);
            float bg[8], g[8], cx[8];
#pragma unroll
            for (int i = 0; i < 4; ++i) { bg[2 * i] = __uint_as_float(vb[j][i] << 16); bg[2 * i + 1] = __uint_as_float(vb[j][i] & 0xffff0000u); g[2 * i] = __uint_as_float(vg[j][i] << 16); g[2 * i + 1] = __uint_as_float(vg[j][i] & 0xffff0000u);
                a[2 * i] = __uint_as_float(va[j][i] << 16); a[2 * i + 1] = __uint_as_float(va[j][i] & 0xffff0000u); b2[2 * i] = __uint_as_float(vx[j][i] << 16); b2[2 * i + 1] = __uint_as_float(vx[j][i] & 0xffff0000u); }
            u32x4 o; float z[8];
#pragma unroll
            for (int i = 0; i < 8; ++i) { cx[i] = a[i] * b2[i]; z[i] = (w0[i] * cm2[i] + w1[i] * cm1[i] + w2[i] * cx[i]) * bg[i] * siluf_(g[i]); cm2[i] = cm1[i]; cm1[i] = cx[i]; }
#pragma unroll
            for (int i = 0; i < 4; ++i) o[i] = pk2(z[2 * i], z[2 * i + 1]);
            *(u32x4*)(Y + t * W + c) = o;
        }
    }
}
__device__ __forceinline__ void e1_pool(const bf16_t* __restrict__ UD, bf16_t* __restrict__ PG, size_t gt, size_t ngt) {
    for (size_t it = gt; it < (size_t)(T / 16) * 128; it += ngt) {
        const int t0 = (int)(it >> 7) * 16, c = (int)(it & 127) * 8, s0 = t0 & (SEQ - 1);
        const int win = 2 << (c >> 8);
        float sum[8], tmp[8], cur[8];
#pragma unroll
        for (int i = 0; i < 8; ++i) sum[i] = 0.f;
        u32x4 cv[16];
#pragma unroll
        for (int j = 0; j < 16; ++j) cv[j] = *(const u32x4*)(UD + (size_t)(t0 + j) * W + c);
        if (s0 > 0) {
#pragma unroll
            for (int j = 1; j < 16; ++j) if (j < win) { ld8bf(UD + (size_t)(t0 - j) * W + c, tmp);
#pragma unroll
                for (int i = 0; i < 8; ++i) sum[i] += tmp[i]; } }
        bf16_t* dst = PG + ((size_t)(c >> 8) * T + t0) * 256 + (c & 255);
#pragma unroll
        for (int j = 0; j < 16; ++j) {
            const int s = s0 + j;
#pragma unroll
            for (int i = 0; i < 4; ++i) { cur[2 * i] = __uint_as_float(cv[j][i] << 16); cur[2 * i + 1] = __uint_as_float(cv[j][i] & 0xffff0000u); }
#pragma unroll
            for (int i = 0; i < 8; ++i) sum[i] += cur[i];
            const int cnt = (s + 1 < win) ? s + 1 : win; const float inv = 1.0f / (float)cnt;
            u32x4 o;
#pragma unroll
            for (int i = 0; i < 4; ++i) o[i] = pk2(sum[2 * i] * inv - cur[2 * i], sum[2 * i + 1] * inv - cur[2 * i + 1]);
            *(u32x4*)(dst + (size_t)j * 256) = o;
            if (s + 1 >= win) {
                ld8bf(UD + ((size_t)(t0 + j) + 1 - win) * W + c, tmp);
#pragma unroll
                for (int i = 0; i < 8; ++i) sum[i] -= tmp[i]; }
        }
    }
}
__device__ __forceinline__ void e1_lora(const float* __restrict__ S, bf16_t* __restrict__ LA, float* __restrict__ LF, const float* __restrict__ mu, const float* __restrict__ bf, size_t gt, size_t ngt) {
#pragma unroll 4
    for (size_t it = gt; it < (size_t)T * 64; it += ngt) {
        const int t = (int)(it >> 6), j = (int)(it & 63) * 4, s = t & (SEQ - 1);
        f32x4 o = {0.f, 0.f, 0.f, 0.f};
        if (j < 128) {
            const f32x4 cur = *(const f32x4*)(S + (size_t)t * 256 + j), prv = (s > 0) ? *(const f32x4*)(S + (size_t)(t - 1) * 256 + j) : (f32x4){0.f, 0.f, 0.f, 0.f}, m4 = *(const f32x4*)(mu + j);
#pragma unroll
            for (int e = 0; e < 4; ++e) { const float xm = cur[e] + (prv[e] - cur[e]) * m4[e]; o[e] = (j < 64) ? (1.0f - 2.0f * __builtin_amdgcn_rcpf(__expf(2.0f * xm) + 1.0f)) : xm; }
        } else if (j < 144) {
            const f32x4 x4 = *(const f32x4*)(S + (size_t)t * 256 + j) + *(const f32x4*)(bf + (j - 128)); f32x4 lf;
#pragma unroll
            for (int e = 0; e < 4; ++e) lf[e] = fminf(x4[e], 0.f) - __logf(1.0f + __expf(-fabsf(x4[e])));
            *(f32x4*)(LF + (size_t)t * 16 + (j - 128)) = lf;
        }
        u32x2 w; w.x = pk2(o[0], o[1]); w.y = pk2(o[2], o[3]);
        *(u32x2*)(LA + (size_t)t * 256 + j) = w;
    }
}
__device__ __forceinline__ void e1_phase(const Params& p, int l, size_t gt, size_t ngt, int gw, int ngw, int lane) {
    unsigned char* ws = p.ws;
    e1_lora((const float*)(ws + O_S), (bf16_t*)(ws + O_LA), (float*)(ws + O_LF), p.in[I_MU] + (size_t)l * 3200 + 3072, p.in[I_BF] + (size_t)l * 16, gt, ngt);
}
__device__ __forceinline__ void e_cumsum_wg(const Params& p, int l, int bh, int wave, int lane, volatile LAS float* wsum) {
    const int b = bh >> 4, h = bh & 15;
    const float* SF = (const float*)(p.ws + O_S) + ((size_t)b * SEQ) * 256 + 128 + h; float* CB = (float*)(p.ws + O_CB) + (size_t)bh * SEQ; const float bfh = p.in[I_BF][(size_t)l * 16 + h];
    const int s0 = (wave * 64 + lane) * 16;
    float v[16], loc = 0.f;
#pragma unroll
    for (int i = 0; i < 16; ++i) { const float x = SF[(size_t)(s0 + i) * 256] + bfh; v[i] = fminf(x, 0.f) - __logf(1.0f + __expf(-fabsf(x))); }
#pragma unroll
    for (int i = 0; i < 16; ++i) loc += v[i];
    float inc = loc;
#pragma unroll
    for (int o = 1; o < 64; o <<= 1) { const float n = __int_as_float(__builtin_amdgcn_ds_bpermute(((lane >= o) ? lane - o : lane) << 2, __float_as_int(inc))); if (lane >= o) inc += n; }
    if (lane == 63) wsum[wave] = inc;
    asm volatile("s_waitcnt lgkmcnt(0)" ::: "memory"); __builtin_amdgcn_s_barrier(); asm volatile("" ::: "memory");
    float run = inc - loc;
#pragma unroll
    for (int w = 0; w < 7; ++w) run += (w < wave) ? wsum[w] : 0.f;
#pragma unroll
    for (int i = 0; i < 4; ++i) { f32x4 o;
#pragma unroll
        for (int e = 0; e < 4; ++e) { run += v[4 * i + e]; o[e] = run * LOG2E; }
        *(f32x4*)(CB + s0 + 4 * i) = o; }
}
constexpr int LDS_LA = 131072 + 8192;
constexpr int CB_APT = 0, CB_RTT = 2048, CB_G1T = 4096, CB_ARBT = 4608, CB_ARKT = 5120, CB_WC = 5632, CB_BB = 6144, CB_KB = 8192, CB_VT = 10240, CB_BYTES = 12288;
constexpr int GRP = 36;
constexpr int EL_X = 0, EL_Y = 4608, EL_ATT = 9216, EL_GR = 11264, EL_TM = 0, EL_G1 = 1088, EL_BYTES = 16384;
__device__ __forceinline__ unsigned pkbf(float lo, float hi) { return pg8::cvt_pk_bf16(lo, hi); }
__device__ __forceinline__ void e2c_phase(const Params& p, int l, LAS unsigned char* lds, int bx, int wave, int lane) {
    unsigned char* ws = p.ws;
    const bf16_t* UB = (const bf16_t*)(ws + O_UB); const bf16_t* WTL = (const bf16_t*)(ws + O_WTLORA) + (size_t)l * 2048 * 256;
    const float* w0p = p.in[I_W0] + (size_t)l * W; const float* a0p = p.in[I_A0] + (size_t)l * W;
    unsigned char* BLOB = ws + O_SCN; float* BON = (float*)(ws + O_VS);
    const float* mu = p.in[I_MU] + (size_t)l * 3200; const float* kkp = p.in[I_KK] + (size_t)l * W; const float* kap = p.in[I_KA] + (size_t)l * W;
    LAS unsigned char* L = lds + wave * EL_BYTES;
    const int r32 = lane & 31, hh = lane >> 5, l16 = lane & 15, rg = lane >> 4;
    for (int k_ = 0; k_ < 8; ++k_) {
        const int jr = k_ >> 1, cr = bx * 4 + jr, b = cr >> 9, c = cr & 511, h = wave * 2 + (k_ & 1), bh = b * 16 + h, ch = h * 64 + lane;
        const size_t tok0 = (size_t)b * SEQ + c * 16;
        const float mr = mu[ch], mk = mu[1024 + ch], mv = mu[2048 + ch], kkc = kkp[ch], kac = kap[ch], rkc = p.in[I_RK][(size_t)l * W + ch];
        float pr = 0.f, pk = 0.f, pv = 0.f;
        if (c > 0) { pr = bf2f(UB[(tok0 - 1) * 3072 + ch]); pk = bf2f(UB[(tok0 - 1) * 3072 + 1024 + ch]); pv = bf2f(UB[(tok0 - 1) * 3072 + 2048 + ch]); }
        float At[16], Rt[16], Bh[16], Kh[16], Vv[16];
        float Wc = 1.0f;
        float wdv[16], asv[16];
        { attn_body::f32x16 xw0 = attn_body::f32x16{}, xw1 = xw0, xa0 = xw0, xa1 = xw0;
          const int arow = jr * 16 + (lane & 15); const LAS unsigned char* ap = lds + LDS_LA + arow * 256; const bf16_t* bw = WTL + (size_t)(h * 64 + r32) * 256 + hh * 8; const bf16_t* ba = bw + (size_t)1024 * 256 + 64;
#pragma unroll
          for (int ks = 0; ks < 4; ++ks) {
              u32x4 aw = {0u, 0u, 0u, 0u}, aa = {0u, 0u, 0u, 0u};
              if (r32 < 16) { aw = *(const LAS u32x4*)(ap + (((ks * 2 + hh) ^ (arow & 15)) * 16)); aa = *(const LAS u32x4*)(ap + (((8 + ks * 2 + hh) ^ (arow & 15)) * 16)); }
              const bf16x8 fw = __builtin_bit_cast(bf16x8, aw), fa = __builtin_bit_cast(bf16x8, aa);
              xw0 = __builtin_amdgcn_mfma_f32_32x32x16_bf16(fw, *(const bf16x8*)(bw + ks * 16), xw0, 0, 0, 0);
              xw1 = __builtin_amdgcn_mfma_f32_32x32x16_bf16(fw, *(const bf16x8*)(bw + 32 * 256 + ks * 16), xw1, 0, 0, 0);
              xa0 = __builtin_amdgcn_mfma_f32_32x32x16_bf16(fa, *(const bf16x8*)(ba + ks * 16), xa0, 0, 0, 0);
              xa1 = __builtin_amdgcn_mfma_f32_32x32x16_bf16(fa, *(const bf16x8*)(ba + 32 * 256 + ks * 16), xa1, 0, 0, 0);
          }
          const float w0c = w0p[ch], a0c = a0p[ch];
#pragma unroll
          for (int r = 0; r < 8; ++r) { const int t = (r & 3) + 8 * (r >> 2);
              auto rw = __builtin_amdgcn_permlane32_swap(__float_as_uint(xw0[r]), __float_as_uint(xw1[r]), false, false);
              auto ra = __builtin_amdgcn_permlane32_swap(__float_as_uint(xa0[r]), __float_as_uint(xa1[r]), false, false);
              wdv[t] = __builtin_amdgcn_exp2f(-0.6065306597126334f * LOG2E * sigmoidf_(__builtin_bit_cast(float, (unsigned)rw[0]) + w0c));
              wdv[t + 4] = __builtin_amdgcn_exp2f(-0.6065306597126334f * LOG2E * sigmoidf_(__builtin_bit_cast(float, (unsigned)rw[1]) + w0c));
              asv[t] = sigmoidf_(__builtin_bit_cast(float, (unsigned)ra[0]) + a0c); asv[t + 4] = sigmoidf_(__builtin_bit_cast(float, (unsigned)ra[1]) + a0c); }
        }
        float invn_l;
        { LAS float* PT = (LAS float*)(L + EL_X); float pk2_ = pk;
#pragma unroll
          for (int t = 0; t < 16; ++t) { const float ck = bf2f(UB[(tok0 + t) * 3072 + 1024 + ch]); const float kr = (ck + (pk2_ - ck) * mk) * kkc; pk2_ = ck; PT[t * 68 + lane] = kr * kr; }
          asm volatile("s_waitcnt lgkmcnt(0)" ::: "memory");
          const LAS float* pr_ = PT + l16 * 68 + rg * 16; float n2 = 0.f;
#pragma unroll
          for (int i = 0; i < 4; ++i) { const f32x4 q4 = *(const LAS f32x4*)(pr_ + 4 * i); n2 += (q4[0] + q4[1]) + (q4[2] + q4[3]); }
          n2 += __builtin_bit_cast(float, __builtin_amdgcn_ds_swizzle(__builtin_bit_cast(int, n2), 0x401F));
          { const unsigned ub_ = __float_as_uint(n2); auto rr = __builtin_amdgcn_permlane32_swap(ub_, ub_, false, false); n2 = __uint_as_float(rr[0]) + __uint_as_float(rr[1]); }
          invn_l = 1.0f / fmaxf(sqrtf(n2), 1e-12f);
          asm volatile("s_waitcnt lgkmcnt(0)" ::: "memory"); }
#pragma unroll
        for (int t = 0; t < 16; ++t) {
            const size_t tok = tok0 + t;
            const float cr = bf2f(UB[tok * 3072 + ch]), ck = bf2f(UB[tok * 3072 + 1024 + ch]), cv = bf2f(UB[tok * 3072 + 2048 + ch]);
            const float wd = wdv[t], as = asv[t];
            const float r = cr + (pr - cr) * mr, k = ck + (pk - ck) * mk, v = cv + (pv - cv) * mv;
            pr = cr; pk = ck; pv = cv;
            const float kkr = k * kkc, k2 = k * (1.0f + (as - 1.0f) * kac);
            const float kk = kkr * rdlane(invn_l, t);
            const float Wprev = Wc; Wc *= wd; const float iW = __builtin_amdgcn_rcpf(Wc);
            At[t] = -kk * Wprev; Rt[t] = r * Wc; Bh[t] = kk * as * iW; Kh[t] = k2 * iW; Vv[t] = v; ((LAS float*)(L + EL_X))[t * 68 + lane] = r * k2 * rkc;
        }
        { LAS float* PT = (LAS float*)(L + EL_X);
          asm volatile("s_waitcnt lgkmcnt(0)" ::: "memory");
          const LAS float* pr_ = PT + l16 * 68 + rg * 16; float bs = 0.f;
#pragma unroll
          for (int i = 0; i < 4; ++i) { const f32x4 q4 = *(const LAS f32x4*)(pr_ + 4 * i); bs += (q4[0] + q4[1]) + (q4[2] + q4[3]); }
          bs += __builtin_bit_cast(float, __builtin_amdgcn_ds_swizzle(__builtin_bit_cast(int, bs), 0x401F));
          { const unsigned ub_ = __builtin_bit_cast(unsigned, bs); auto rr = __builtin_amdgcn_permlane32_swap(ub_, ub_, false, false); bs = __builtin_bit_cast(float, (unsigned)rr[0]) + __builtin_bit_cast(float, (unsigned)rr[1]); }
          if (lane < 16) BON[(tok0 + lane) * 16 + h] = bs;
          asm volatile("s_waitcnt lgkmcnt(0)" ::: "memory"); }
        { LAS bf16_t* X = (LAS bf16_t*)(L + EL_X); LAS bf16_t* Y = (LAS bf16_t*)(L + EL_Y);
#pragma unroll
          for (int t = 0; t < 16; ++t) { const unsigned ux = pkbf(Bh[t], Kh[t]), uy = pkbf(At[t], Rt[t]);
              X[t * 72 + lane] = (bf16_t)(ux & 0xffffu); X[(16 + t) * 72 + lane] = (bf16_t)(ux >> 16); Y[t * 72 + lane] = (bf16_t)(uy & 0xffffu); Y[(16 + t) * 72 + lane] = (bf16_t)(uy >> 16); }
          u32x4 w0, w1;
#pragma unroll
          for (int i = 0; i < 4; ++i) { w0[i] = pkbf(At[2 * i], At[2 * i + 1]); w1[i] = pkbf(At[8 + 2 * i], At[8 + 2 * i + 1]); }
          *(LAS u32x4*)(L + EL_ATT + lane * 32) = w0; *(LAS u32x4*)(L + EL_ATT + lane * 32 + 16) = w1; }
        asm volatile("s_waitcnt lgkmcnt(0)" ::: "memory");
        attn_body::f32x16 gram = attn_body::f32x16{};
#pragma unroll
        for (int s4 = 0; s4 < 4; ++s4) {
            const bf16x8 fa = *(const LAS bf16x8*)(L + EL_X + r32 * 144 + s4 * 32 + hh * 16), fb = *(const LAS bf16x8*)(L + EL_Y + r32 * 144 + s4 * 32 + hh * 16);
            gram = __builtin_amdgcn_mfma_f32_32x32x16_bf16(fa, fb, gram, 0, 0, 0);
        }
        { LAS float* GR = (LAS float*)(L + EL_GR);
#pragma unroll
          for (int i = 0; i < 16; ++i) GR[((i & 3) + 8 * (i >> 2) + 4 * hh) * GRP + r32] = gram[i]; }
        asm volatile("s_waitcnt lgkmcnt(0)" ::: "memory");
        { const LAS float* GR = (const LAS float*)(L + EL_GR); float x[16];
          int l16o = l16; asm volatile("" : "+v"(l16o));
#pragma unroll
          for (int t = 0; t < 16; ++t) x[t] = (l16o == t) ? 1.0f : 0.f;
#pragma unroll
          for (int s_ = 0; s_ < 15; ++s_) { f32x4 n4[4];
#pragma unroll
              for (int g = (s_ + 1) >> 2; g < 4; ++g) n4[g] = *(const LAS f32x4*)(GR + s_ * GRP + 4 * g);
              if ((s_ & 1) == 1) asm volatile("" ::: "memory");
#pragma unroll
              for (int g = (s_ + 1) >> 2; g < 4; ++g)
#pragma unroll
                  for (int e = 0; e < 4; ++e) if (4 * g + e > s_) x[4 * g + e] += x[s_] * n4[g][e]; }
          asm volatile("s_waitcnt lgkmcnt(0)" ::: "memory");
          LAS float* TM = (LAS float*)(L + EL_TM);
          if (rg == 0) {
#pragma unroll
              for (int t = 0; t < 16; ++t) TM[l16 * 17 + t] = x[t]; } }
        asm volatile("s_waitcnt lgkmcnt(0)" ::: "memory");
        attn_body::f32x16 ap0, ap1, g1;
        { const LAS float* TM = (const LAS float*)(L + EL_TM); const LAS float* GR = (const LAS float*)(L + EL_GR);
          u32x4 tb, ga;
#pragma unroll
          for (int i = 0; i < 4; ++i) {
              const float t0 = (r32 < 16) ? TM[(8 * hh + 2 * i) * 17 + r32] : 0.f, t1 = (r32 < 16) ? TM[(8 * hh + 2 * i + 1) * 17 + r32] : 0.f; tb[i] = pkbf(t0, t1);
              const int s0 = 8 * hh + 2 * i, s1 = s0 + 1;
              const float a0 = (r32 < 16 && r32 < s0) ? GR[(16 + r32) * GRP + s0] : 0.f, a1 = (r32 < 16 && r32 < s1) ? GR[(16 + r32) * GRP + s1] : 0.f; ga[i] = pkbf(a0, a1); }
          const bf16x8 ftm = __builtin_bit_cast(bf16x8, tb);
          const bf16x8 fa0 = *(const LAS bf16x8*)(L + EL_ATT + r32 * 32 + hh * 16), fa1 = *(const LAS bf16x8*)(L + EL_ATT + (32 + r32) * 32 + hh * 16);
          const attn_body::f32x16 z16 = attn_body::f32x16{};
          ap0 = __builtin_amdgcn_mfma_f32_32x32x16_bf16(fa0, ftm, z16, 0, 0, 0);
          ap1 = __builtin_amdgcn_mfma_f32_32x32x16_bf16(fa1, ftm, z16, 0, 0, 0);
          g1 = __builtin_amdgcn_mfma_f32_32x32x16_bf16(__builtin_bit_cast(bf16x8, ga), ftm, z16, 0, 0, 0);
          LAS float* G1L = (LAS float*)(L + EL_G1);
          if (r32 < 16) {
#pragma unroll
              for (int i = 0; i < 8; ++i) G1L[((i & 3) + 8 * (i >> 2) + 4 * hh) * 17 + r32] = g1[i]; } }
        asm volatile("s_waitcnt lgkmcnt(0)" ::: "memory");
        unsigned char* out = BLOB + ((size_t)(bh >> 1) * 512 + c) * (2 * CB_BYTES) + (size_t)(bh & 1) * CB_BYTES;
        { const LAS float* GR = (const LAS float*)(L + EL_GR); const LAS float* G1L = (const LAS float*)(L + EL_G1); const LAS unsigned char* Yb = L + EL_Y;
          if (r32 < 16) {
              const int t = r32, slot = (t + 16 * hh) * 16;
#pragma unroll
              for (int s = 0; s < 2; ++s) {
                  u32x4 w0, w1;
#pragma unroll
                  for (int i = 0; i < 4; ++i) { w0[i] = pkbf(ap0[8 * s + 2 * i], ap0[8 * s + 2 * i + 1]); w1[i] = pkbf(ap1[8 * s + 2 * i], ap1[8 * s + 2 * i + 1]); }
                  *(u32x4*)(out + CB_APT + s * 512 + slot) = w0; *(u32x4*)(out + CB_APT + (2 + s) * 512 + slot) = w1;
#pragma unroll
                  for (int kt = 0; kt < 2; ++kt) { const LAS unsigned char* yr = Yb + (16 + t) * 144 + (32 * kt + 16 * s + 4 * hh) * 2;
                      const u32x2 lo = *(const LAS u32x2*)(yr), hi2 = *(const LAS u32x2*)(yr + 16); u32x4 w; w.x = lo.x; w.y = lo.y; w.z = hi2.x; w.w = hi2.y;
                      *(u32x4*)(out + CB_RTT + (kt * 2 + s) * 512 + slot) = w; }
              }
              u32x4 wg, wb, wk;
#pragma unroll
              for (int i = 0; i < 4; ++i) {
                  const int j0 = 2 * i, j1 = 2 * i + 1;
                  wg[i] = pkbf(G1L[(8 * hh + j0) * 17 + t], G1L[(8 * hh + j1) * 17 + t]);
                  const int sa = 8 * (j0 >> 2) + 4 * hh + (j0 & 3), sb = sa + 1;
                  wb[i] = pkbf((sa <= t) ? GR[sa * GRP + 16 + t] : 0.f, (sb <= t) ? GR[sb * GRP + 16 + t] : 0.f);
                  const int ka = 8 * hh + j0, kb = ka + 1;
                  wk[i] = pkbf((ka <= t) ? GR[(16 + ka) * GRP + 16 + t] : 0.f, (kb <= t) ? GR[(16 + kb) * GRP + 16 + t] : 0.f); }
              *(u32x4*)(out + CB_G1T + slot) = wg; *(u32x4*)(out + CB_ARBT + slot) = wb; *(u32x4*)(out + CB_ARKT + slot) = wk;
          }
          *(float*)(out + CB_WC + lane * 4) = Wc;
          u32x4 bP0, bP1, kP0, kP1, vP0, vP1;
#pragma unroll
          for (int i = 0; i < 2; ++i) {
              bP0[i] = pkbf(Bh[2 * i] * Wc, Bh[2 * i + 1] * Wc); bP0[2 + i] = pkbf(Bh[8 + 2 * i] * Wc, Bh[9 + 2 * i] * Wc);
              bP1[i] = pkbf(Bh[4 + 2 * i] * Wc, Bh[5 + 2 * i] * Wc); bP1[2 + i] = pkbf(Bh[12 + 2 * i] * Wc, Bh[13 + 2 * i] * Wc); }
#pragma unroll
          for (int i = 0; i < 4; ++i) { kP0[i] = pkbf(Kh[2 * i] * Wc, Kh[2 * i + 1] * Wc); kP1[i] = pkbf(Kh[8 + 2 * i] * Wc, Kh[9 + 2 * i] * Wc); vP0[i] = pkbf(Vv[2 * i], Vv[2 * i + 1]); vP1[i] = pkbf(Vv[8 + 2 * i], Vv[9 + 2 * i]); }
          u32x4 f0, f1;
#pragma unroll
          for (int i = 0; i < 4; ++i) { auto rr = __builtin_amdgcn_permlane32_swap(bP0[i], bP1[i], false, false); f0[i] = rr[0]; f1[i] = rr[1]; }
          *(u32x4*)(out + CB_BB + lane * 16) = f0; *(u32x4*)(out + CB_BB + 1024 + lane * 16) = f1;
#pragma unroll
          for (int i = 0; i < 4; ++i) { auto rr = __builtin_amdgcn_permlane32_swap(kP0[i], kP1[i], false, false); f0[i] = rr[0]; f1[i] = rr[1]; }
          *(u32x4*)(out + CB_KB + lane * 16) = f0; *(u32x4*)(out + CB_KB + 1024 + lane * 16) = f1;
#pragma unroll
          for (int i = 0; i < 4; ++i) { auto rr = __builtin_amdgcn_permlane32_swap(vP0[i], vP1[i], false, false); f0[i] = rr[0]; f1[i] = rr[1]; }
          *(u32x4*)(out + CB_VT + lane * 16) = f0; *(u32x4*)(out + CB_VT + 1024 + lane * 16) = f1;
        }
        asm volatile("s_waitcnt lgkmcnt(0)" ::: "memory");
    }
}
constexpr int SC_SLOT = 2 * CB_BYTES, SC_NCH = SEQ / 16;
__device__ __forceinline__ void scan_block(LAS unsigned char* lds, const unsigned char* BLOB, bf16_t* YS, int blk, int wid, int lane) {
    if (wid >= 4) {
        const int lw = wid - 4;
        const unsigned char* gS = BLOB + (size_t)blk * 512 * SC_SLOT + lane * 16;
#define SC_ISSUE(c) do { const int sl_ = ((c) & 3) * SC_SLOT; const unsigned char* s_ = gS + (size_t)(c) * SC_SLOT; \
        _Pragma("unroll") for (int i_ = 0; i_ < 6; ++i_) __builtin_amdgcn_global_load_lds((const unsigned*)(s_ + (lw + 4 * i_) * 1024), (LAS unsigned*)(lds + sl_ + (lw + 4 * i_) * 1024), 16, 0, 0); } while (0)
        SC_ISSUE(0); SC_ISSUE(1); SC_ISSUE(2);
        for (int c = 0; c < SC_NCH; ++c) {
            if (c + 2 < SC_NCH) asm volatile("s_waitcnt vmcnt(12)" ::: "memory"); else asm volatile("s_waitcnt vmcnt(0)" ::: "memory");
            __builtin_amdgcn_s_barrier();
            asm volatile("" ::: "memory");
            if (c + 3 < SC_NCH) SC_ISSUE(c + 3);
        }
#undef SC_ISSUE
    } else {
        typedef attn_body::f32x16 f32x16;
        const int hsel = wid >> 1, vh = wid & 1, bh = blk * 2 + hsel, r32 = lane & 31, hi = lane >> 5, slot16 = ((lane & 15) + 16 * hi) * 16;
        bf16_t* yp = YS + ((size_t)bh * (SEQ / 4) * 64 + vh * 32 + r32) * 4;
        f32x16 Z0 = f32x16{}, Z1 = f32x16{};
        const f32x16 z16 = f32x16{};
#define SC_CVT(dst, src, s_) do { u32x4 w_; _Pragma("unroll") for (int i_ = 0; i_ < 4; ++i_) w_[i_] = pkbf(src[8 * (s_) + 2 * i_], src[8 * (s_) + 2 * i_ + 1]); dst = __builtin_bit_cast(bf16x8, w_); } while (0)
#define SC_M16(off) (*(const LAS bf16x8*)(base + (off) + slot16))
#define SC_M32(off) (*(const LAS bf16x8*)(base + (off) + lane * 16))
#define MF(a_, b_, c_) __builtin_amdgcn_mfma_f32_32x32x16_bf16(a_, b_, c_, 0, 0, 0)
        for (int c = 0; c < SC_NCH; ++c) {
            __builtin_amdgcn_s_barrier();
            asm volatile("" ::: "memory");
            const LAS unsigned char* base = lds + (c & 3) * SC_SLOT + hsel * CB_BYTES;
            bf16x8 zb00, zb01, zb10, zb11, ub;
            SC_CVT(zb00, Z0, 0); SC_CVT(zb01, Z0, 1); SC_CVT(zb10, Z1, 0); SC_CVT(zb11, Z1, 1);
            const bf16x8 vt = SC_M32(CB_VT + vh * 1024);
            f32x16 U = MF(SC_M16(CB_APT + 0), zb00, z16); U = MF(SC_M16(CB_APT + 512), zb01, U); U = MF(SC_M16(CB_APT + 1024), zb10, U); U = MF(SC_M16(CB_APT + 1536), zb11, U);
            U = MF(SC_M16(CB_G1T), vt, U);
            f32x16 Y = MF(SC_M16(CB_RTT + 0), zb00, z16); Y = MF(SC_M16(CB_RTT + 512), zb01, Y); Y = MF(SC_M16(CB_RTT + 1024), zb10, Y); Y = MF(SC_M16(CB_RTT + 1536), zb11, Y);
            Y = MF(SC_M16(CB_ARKT), vt, Y);
            SC_CVT(ub, U, 0);
            Y = MF(SC_M16(CB_ARBT), ub, Y);
            {
                const LAS float* wc = (const LAS float*)(base + CB_WC) + 4 * hi;
#pragma unroll
                for (int g = 0; g < 4; ++g) { const f32x4 w0 = *(const LAS f32x4*)(wc + 8 * g), w1 = *(const LAS f32x4*)(wc + 32 + 8 * g);
#pragma unroll
                    for (int e = 0; e < 4; ++e) { Z0[4 * g + e] *= w0[e]; Z1[4 * g + e] *= w1[e]; } }
            }
            Z0 = MF(SC_M32(CB_BB), ub, Z0); Z1 = MF(SC_M32(CB_BB + 1024), ub, Z1);
            Z0 = MF(SC_M32(CB_KB), vt, Z0); Z1 = MF(SC_M32(CB_KB + 1024), vt, Z1);
            { u32x2 w_; w_.x = pkbf(Y[0], Y[1]); w_.y = pkbf(Y[2], Y[3]); *(u32x2*)(yp + (size_t)(c * 4 + hi) * 256) = w_; }
            { u32x2 w_; w_.x = pkbf(Y[4], Y[5]); w_.y = pkbf(Y[6], Y[7]); *(u32x2*)(yp + (size_t)(c * 4 + 2 + hi) * 256) = w_; }
        }
#undef SC_CVT
#undef SC_M16
#undef SC_M32
#undef MF
    }
    asm volatile("s_waitcnt vmcnt(0) lgkmcnt(0)" ::: "memory"); __builtin_amdgcn_s_barrier();
}
__device__ __forceinline__ void e3_items(const bf16_t* __restrict__ YS, const float* __restrict__ BON, const bf16_t* __restrict__ GB, const bf16_t* __restrict__ UBv0, bf16_t* __restrict__ Y,
                                         const float* __restrict__ lg, const float* __restrict__ lb, const float* __restrict__ muv, int it0, int it1, int lane) {
#pragma unroll 2
    for (int it = it0; it < it1; ++it) {
        const int t0 = (it >> 2) * 4, hq = it & 3, s0 = t0 & (SEQ - 1), b = t0 >> 13;
        const int head = hq * 4 + (lane >> 4), l16 = lane & 15, c = head * 64 + l16 * 4, bh = b * 16 + head;
        const size_t off = (((size_t)bh * (SEQ / 4) + (s0 >> 2)) * 64 + l16 * 4) * 4;
        u32x2 y4[4];
#pragma unroll
        for (int i = 0; i < 4; ++i) y4[i] = *(const u32x2*)(YS + off + i * 4);
        const bf16_t* UBv = UBv0 + c;
        const f32x4 mv4 = *(const f32x4*)(muv + c);
        float pv[4];
        if (s0 > 0) ld4bf(UBv + (size_t)(t0 - 1) * 3072, pv);
        else {
#pragma unroll
            for (int i = 0; i < 4; ++i) pv[i] = 0.f; }
        const f32x4 lg4 = *(const f32x4*)(lg + c), lb4 = *(const f32x4*)(lb + c);
        u32x2 cvw[4], gw_[4]; float bonv[4];
#pragma unroll
        for (int j = 0; j < 4; ++j) { cvw[j] = *(const u32x2*)(UBv + (size_t)(t0 + j) * 3072); gw_[j] = *(const u32x2*)(GB + (size_t)(t0 + j) * W + c); bonv[j] = BON[(size_t)(t0 + j) * 16 + head]; }
#pragma unroll
        for (int j = 0; j < 4; ++j) {
            const int t = t0 + j;
            float y[4], g[4], cv[4], vm[4], sm = 0.f;
            cv[0] = __uint_as_float(cvw[j].x << 16); cv[1] = __uint_as_float(cvw[j].x & 0xffff0000u); cv[2] = __uint_as_float(cvw[j].y << 16); cv[3] = __uint_as_float(cvw[j].y & 0xffff0000u);
            g[0] = __uint_as_float(gw_[j].x << 16); g[1] = __uint_as_float(gw_[j].x & 0xffff0000u); g[2] = __uint_as_float(gw_[j].y << 16); g[3] = __uint_as_float(gw_[j].y & 0xffff0000u);
            const float bon = bonv[j];
#pragma unroll
            for (int i = 0; i < 4; ++i) { const unsigned wv = (j & 2) ? y4[i].y : y4[i].x; y[i] = __builtin_bit_cast(float, (j & 1) ? (wv & 0xffff0000u) : (wv << 16)); sm += y[i];
                vm[i] = cv[i] + (pv[i] - cv[i]) * mv4[i]; pv[i] = cv[i]; }
            const float mean = allred16(sm) * (1.0f / 64.0f);
            float q = 0.f;
#pragma unroll
            for (int i = 0; i < 4; ++i) { y[i] -= mean; q += y[i] * y[i]; }
            const float rstd = rsqrtf(allred16(q) * (1.0f / 64.0f) + 64e-5f);
            float o[4];
#pragma unroll
            for (int i = 0; i < 4; ++i) o[i] = (y[i] * rstd * lg4[i] + lb4[i] + bon * vm[i]) * siluf_(g[i]);
            u32x2 w; w.x = pk2(o[0], o[1]); w.y = pk2(o[2], o[3]);
            *(u32x2*)(Y + (size_t)t * W + c) = w;
        }
    }
}
__device__ __forceinline__ void e3_phase(const Params& p, int l, int it0, int it1, int lane) {
    unsigned char* ws = p.ws;
    e3_items((const bf16_t*)(ws + O_YS), (const float*)(ws + O_VS), (const bf16_t*)(ws + O_GB), (const bf16_t*)(ws + O_UB) + 2048, (bf16_t*)(ws + O_Y) + (size_t)1 * T * W,
             p.in[I_LG] + (size_t)l * W, p.in[I_LB] + (size_t)l * W, p.in[I_MU] + (size_t)l * 3200 + 2048, it0, it1, lane);
}
constexpr int NWAVES = 8;
constexpr int RING_BYTES = 131072;
constexpr int LDSCTL_OFF = RING_BYTES, MISC_OFF = LDSCTL_OFF + 320;
constexpr int LDS_BYTES = 155648;
constexpr int CW_BAR = 1024;
constexpr int CW_QUEUE = 200000;
constexpr int CW_QK = 204800;
constexpr int CW_E3 = 205312;
constexpr int CW_E2A = 205568;
constexpr int CW_GRP = 205824;
constexpr int NPH = 43;
#ifndef MK_PER_PHASE
#define MK_PER_PHASE 0
#endif
static_assert(attn_body::LDS_BYTES <= RING_BYTES && 4 * SC_SLOT <= RING_BYTES && 8 * EL_BYTES <= RING_BYTES && pg8::STAGE_BYTES <= RING_BYTES && 8 * 9216 <= RING_BYTES, "LDS map");
static_assert((CW_BAR + NPH * XCD_BAR_WORDS) <= CW_QUEUE && (CW_QUEUE + 32 * 64) <= CW_QK && (CW_QK + 4 * 64) <= CW_E3 && (CW_E3 + 4 * 64) <= CW_E2A && (CW_E2A + 4 * 64) <= CW_GRP && (CW_GRP + 4 * 3 * 64 * 32) * 4 <= (int)MiB, "barrier regions inside the zeroed control MiB");

__global__ void __launch_bounds__(NWAVES * 64, 2) fwd(Params p) {
    extern __shared__ __attribute__((aligned(16))) unsigned char lds_[];
    LAS unsigned char* lds = (LAS unsigned char*)lds_;
    volatile LAS unsigned* MISC = (volatile LAS unsigned*)(lds + MISC_OFF);
    const int G = gridDim.x; const int wave_k = __builtin_amdgcn_readfirstlane((int)threadIdx.x >> 6);
    for (int u = threadIdx.x; u < (LDS_BYTES - LDSCTL_OFF) / 4; u += NWAVES * 64) ((LAS unsigned*)(lds + LDSCTL_OFF))[u] = 0u;
    __syncthreads();
    unsigned* ctl = (unsigned*)(p.ws + O_CTL);
    XcdBarrier bar = xcd_barrier_post(ctl + CW_BAR + p.li * XCD_BAR_WORDS, MISC + 8);
    const int lo = p.ph_lo, hi = p.ph_hi;
    const int ngw = G * NWAVES; const size_t ngt = (size_t)G * (NWAVES * 64);
#define BX() int bx = blockIdx.x; asm volatile("" : "+s"(bx))
#define WSQ() Params q = p; __attribute__((address_space(1))) unsigned char* wsg_ = (__attribute__((address_space(1))) unsigned char*)p.ws; asm volatile("" : "+s"(wsg_)); q.ws = (unsigned char*)wsg_; unsigned char* ws = q.ws
#define IDS() int wave_o = wave_k, bx_o = blockIdx.x; asm volatile("" : "+s"(wave_o), "+s"(bx_o)); const int lane = lane_opaque(), wave = wave_o, tid_ = wave * 64 + lane, gw = bx_o * NWAVES + wave; \
    const size_t gt = (size_t)bx_o * (NWAVES * 64) + tid_; (void)lane; (void)wave; (void)gw; (void)gt
#define IN(id) (lo <= (id) && (id) < hi)
#define SEAM(id) do { if ((id) + 1 < hi) xcd_barrier(bar, wave_k == 0 && lane_opaque() == 0); } while (0)
    if (IN(1)) { WSQ(); (void)ws; IDS(); p1_weights(q, lds, gw, ngw, wave, lane, gt, ngt); SEAM(1); }
    for (int l = 0; l < DEPTH; ++l) {
        const int pb = 2 + 10 * l;
#define GRP_CTR(seam_) ((unsigned*)(ws + O_CTL) + CW_GRP + ((l * 3 + (seam_)) * 64 + pmg) * 32)
#define GRP_PUB(ptr_) do { asm volatile("s_waitcnt vmcnt(0) lgkmcnt(0)" ::: "memory"); __builtin_amdgcn_s_barrier(); asm volatile("" ::: "memory"); \
            int wv_ = wave_k; asm volatile("" : "+s"(wv_)); if (wv_ == 0 && lane_opaque() == 0) { __builtin_amdgcn_fence(__ATOMIC_RELEASE, "agent"); asm volatile("s_waitcnt vmcnt(0)" ::: "memory"); __hip_atomic_fetch_add((ptr_), 1u, __ATOMIC_RELAXED, __HIP_MEMORY_SCOPE_AGENT); } } while (0)
#define GRP_POLL(ptr_, n_) do { int wv_ = wave_k; asm volatile("" : "+s"(wv_)); if (wv_ == 0) { unsigned polls_ = 0; \
                while ((unsigned)__builtin_amdgcn_readfirstlane(__hip_atomic_load((ptr_), __ATOMIC_RELAXED, __HIP_MEMORY_SCOPE_AGENT)) < (unsigned)(n_)) { if (++polls_ > (1u << 20)) break; __builtin_amdgcn_s_sleep(4); } \
                __builtin_amdgcn_fence(__ATOMIC_ACQUIRE, "agent"); asm volatile("s_waitcnt vmcnt(0)" ::: "memory"); } \
            asm volatile("s_waitcnt vmcnt(0) lgkmcnt(0)" ::: "memory"); __builtin_amdgcn_s_barrier(); asm volatile("" ::: "memory"); } while (0)
        if (IN(pb + 0)) { WSQ(); IDS(); const int pmg = 8 * (bx_o & 7) + ((bx_o >> 3) & 7), r0 = pmg * 256 + (bx_o >> 6) * 64 + wave * 8;
            if (l == 0) e_rmsnorm(q.in[I_X], p.in[I_NG] + (size_t)l * D, (bf16_t*)(ws + O_H), nullptr, r0, 1, lane, r0 + 8);
            else { { const int l_ = l; const int l = l_ - 1; GRP_POLL(GRP_CTR(1), 4); }
                   e_rmsnorm_bf((const bf16_t*)(ws + O_X), p.in[I_NG] + (size_t)l * D, (bf16_t*)(ws + O_H), nullptr, r0, 1, lane, r0 + 8); }
            GRP_PUB(GRP_CTR(2)); }
        if (IN(pb + 1)) { WSQ(); { BX(); const int pmg = 8 * (bx & 7) + ((bx >> 3) & 7); GRP_POLL(GRP_CTR(2), 4); }
            pg8::Gemm g{(const bf16_t*)(ws + O_H), (const bf16_t*)(ws + O_WTIN) + (size_t)l * NP * D, T, PML + 768, D}; pg8::StaticOrder S; BX(); S.init(T, PML + 768, G, bx);
            EpiG1 E{ws};
            pg8::gemm_phase<EpiG1, pg8::StaticOrder, false, true>(lds, g, S, E, wave_k);
            SEAM(pb + 1);
        }
        if (IN(pb + 4)) { WSQ(); IDS();
            {
                const bf16_t* Qp = (const bf16_t*)(ws + O_Q) + lane * 16; const bf16_t* Kp = (const bf16_t*)(ws + O_K) + lane * 16; unsigned* qkm = (unsigned*)(ws + O_CTL) + CW_QK + l * 64;
                volatile LAS float* qs = (volatile LAS float*)(lds + LDSCTL_OFF + 1024);
                for (int bb = 0; bb < BATCH; ++bb) { float mq = 0.f, mk = 0.f;
                    static_assert(SEQ / (256 * NWAVES) == 4, "four tokens per wave and batch");
                    u32x4 qv[4][2], kv[4][2];
#pragma unroll
                    for (int k = 0; k < 4; ++k) { const size_t t = (size_t)(bb * SEQ + gw + k * (256 * NWAVES));
                        qv[k][0] = *(const u32x4*)(Qp + t * W); qv[k][1] = *(const u32x4*)(Qp + t * W + 8); kv[k][0] = *(const u32x4*)(Kp + t * W); kv[k][1] = *(const u32x4*)(Kp + t * W + 8); }
#pragma unroll
                    for (int k = 0; k < 4; ++k) { float sq = 0.f, sk = 0.f;
#pragma unroll
                        for (int j = 0; j < 2; ++j)
#pragma unroll
                            for (int e = 0; e < 4; ++e) { const float q0 = __uint_as_float(qv[k][j][e] << 16), q1 = __uint_as_float(qv[k][j][e] & 0xffff0000u), k0 = __uint_as_float(kv[k][j][e] << 16), k1 = __uint_as_float(kv[k][j][e] & 0xffff0000u);
                                sq += q0 * q0 + q1 * q1; sk += k0 * k0 + k1 * k1; }
                        sq += dppf<0xB1>(sq); sq += dppf<0x4E>(sq); sk += dppf<0xB1>(sk); sk += dppf<0x4E>(sk);
                        mq = fmaxf(mq, sq); mk = fmaxf(mk, sk); }
                    if ((lane & 3) == 0) { qs[(wave * 2 + bb) * 32 + (lane >> 2) * 2] = mq; qs[(wave * 2 + bb) * 32 + (lane >> 2) * 2 + 1] = mk; } }
                asm volatile("s_waitcnt lgkmcnt(0)" ::: "memory"); __builtin_amdgcn_s_barrier(); asm volatile("" ::: "memory");
                if (wave == 0) { float m = 0.f;
#pragma unroll
                    for (int w = 0; w < 8; ++w) m = fmaxf(m, qs[(w * 2 + (lane >> 5)) * 32 + (lane & 31)]);
                    __hip_atomic_fetch_max(qkm + lane, __float_as_uint(m), __ATOMIC_RELAXED, __HIP_MEMORY_SCOPE_AGENT); }
            }
            if (bx_o < 32) e_cumsum_wg(q, l, bx_o, wave, lane, (volatile LAS float*)(lds + LDSCTL_OFF + 4096));
            {
                const float* S = (const float*)(ws + O_S); const float* mu = p.in[I_MU] + (size_t)l * 3200 + 3072;
                const int r = tid_ >> 3, tok = bx_o * 64 + r, s_ = tok & (SEQ - 1);
#pragma unroll
                for (int hf = 0; hf < 2; ++hf) { const int qc = (tid_ & 7) * 2 + hf, j = qc * 8; u32x4 w;
#pragma unroll
                    for (int i2 = 0; i2 < 2; ++i2) {
                        const f32x4 cur = *(const f32x4*)(S + (size_t)tok * 256 + j + 4 * i2), prv = (s_ > 0) ? *(const f32x4*)(S + (size_t)(tok - 1) * 256 + j + 4 * i2) : (f32x4){0.f, 0.f, 0.f, 0.f}, m4 = *(const f32x4*)(mu + j + 4 * i2);
                        float o[4];
#pragma unroll
                        for (int e = 0; e < 4; ++e) { const float xm = cur[e] + (prv[e] - cur[e]) * m4[e]; o[e] = (j < 64) ? (1.0f - 2.0f * __builtin_amdgcn_rcpf(__expf(2.0f * xm) + 1.0f)) : xm; }
                        w[2 * i2] = pk2(o[0], o[1]); w[2 * i2 + 1] = pk2(o[2], o[3]); }
                    *(LAS u32x4*)(lds + LDS_LA + r * 256 + ((qc ^ (r & 15)) * 16)) = w; }
                asm volatile("s_waitcnt lgkmcnt(0)" ::: "memory"); __builtin_amdgcn_s_barrier(); asm volatile("" ::: "memory");
            }
            e2c_phase(q, l, lds, bx_o, wave, lane);
            asm volatile("s_waitcnt vmcnt(0) lgkmcnt(0)" ::: "memory"); __builtin_amdgcn_s_barrier(); asm volatile("" ::: "memory");
            if (wave == 0 && lane == 0) { __builtin_amdgcn_fence(__ATOMIC_RELEASE, "agent"); asm volatile("s_waitcnt vmcnt(0)" ::: "memory");
                __hip_atomic_fetch_add((unsigned*)(ws + O_CTL) + CW_E2A + l * 64, 1u, __ATOMIC_RELAXED, __HIP_MEMORY_SCOPE_AGENT); } }
#define POLL_GE(ptr_, n_) do { if (wave == 0) { unsigned polls_ = 0; \
                while ((unsigned)__builtin_amdgcn_readfirstlane(__hip_atomic_load((ptr_), __ATOMIC_RELAXED, __HIP_MEMORY_SCOPE_AGENT)) < (unsigned)(n_)) { if (++polls_ > (1u << 20)) break; __builtin_amdgcn_s_sleep(8); } \
                __builtin_amdgcn_fence(__ATOMIC_ACQUIRE, "agent"); asm volatile("s_waitcnt vmcnt(0)" ::: "memory"); } \
            asm volatile("s_waitcnt vmcnt(0) lgkmcnt(0)" ::: "memory"); __builtin_amdgcn_s_barrier(); asm volatile("" ::: "memory"); } while (0)
        if (IN(pb + 5)) { WSQ(); { int bx_o = blockIdx.x; asm volatile("" : "+s"(bx_o));
#define X_SIDE() do { IDS();     \
                e1_conv((const bf16_t*)(ws + O_UA), (bf16_t*)(ws + O_Y), p.in[I_CW] + (size_t)l * 3 * W, gt, ngt); \
                e1_pool((const bf16_t*)(ws + O_UD), (bf16_t*)(ws + O_PG), ((size_t)((bx_o & 63) * 16 + (tid_ >> 5)) << 7) | (size_t)((bx_o >> 6) * 32 + (tid_ & 31)), (size_t)1 << 40); \
                asm volatile("s_waitcnt vmcnt(0) lgkmcnt(0)" ::: "memory"); __builtin_amdgcn_s_barrier(); asm volatile("" ::: "memory");     \
                pg8::Gemm g2{(const bf16_t*)(ws + O_PG), (const bf16_t*)(ws + O_WD) + (size_t)l * 4 * 65536, 4 * T, 1024, 256}; PoolOrder S2{G, bx_o}; \
                EpiPool E2{ws, p.in[I_PS] + (size_t)l * W}; \
                pg8::gemm_phase<EpiPool, PoolOrder, true, true>(lds, g2, S2, E2, wave_k); } while (0)
            if (bx_o >= 240) { IDS(); POLL_GE((unsigned*)(ws + O_CTL) + CW_E2A + l * 64, G); scan_block(lds, ws + O_SCN, (bf16_t*)(ws + O_YS), bx_o - 240, wave, lane);
                if (wave == 0 && lane == 0) { __builtin_amdgcn_fence(__ATOMIC_RELEASE, "agent"); asm volatile("s_waitcnt vmcnt(0)" ::: "memory");
                    __hip_atomic_fetch_add((unsigned*)(ws + O_CTL) + CW_E3 + l * 64, 1u, __ATOMIC_RELAXED, __HIP_MEMORY_SCOPE_AGENT); }
                X_SIDE(); }
            else {
                { BX(); pg8::Gemm g{(const bf16_t*)(ws + O_H), (const bf16_t*)(ws + O_WTIN) + ((size_t)l * NP + PML + 768) * D, T, 29 * 256, D};
                  RangeOrder R; R.S.init(T, 29 * 256, 240, bx); R.i0 = 0; R.i1 = (bx >> 3) & 7; EpiML E{ws};
                  pg8::gemm_phase<EpiML, RangeOrder, false, true>(lds, g, R, E, wave_k); }
                X_SIDE();
                { BX(); pg8::Gemm g{(const bf16_t*)(ws + O_H), (const bf16_t*)(ws + O_WTIN) + ((size_t)l * NP + PML + 768) * D, T, 29 * 256, D};
                  RangeOrder R; R.S.init(T, 29 * 256, 240, bx); R.i0 = (bx >> 3) & 7; R.i1 = 64; EpiML E{ws};
                  pg8::gemm_phase<EpiML, RangeOrder, false, true>(lds, g, R, E, wave_k); }
            }
            }
            { IDS(); POLL_GE((unsigned*)(ws + O_CTL) + CW_E2A + l * 64, G);
                unsigned* qctr = (unsigned*)(ws + O_CTL) + CW_QUEUE + (l * 8) * 64;
                volatile LAS unsigned* qw = MISC + 16;
                int label = bx_o & 7, tries = 0;
                for (;;) {
                    if (wave == 0 && lane == 0) qw[0] = __hip_atomic_fetch_add(qctr + label * 64, 1u, __ATOMIC_RELAXED, __HIP_MEMORY_SCOPE_AGENT);
                    asm volatile("s_waitcnt vmcnt(0) lgkmcnt(0)" ::: "memory"); __builtin_amdgcn_s_barrier(); asm volatile("" ::: "memory");
                    const unsigned idx = qw[0];
                    asm volatile("s_waitcnt lgkmcnt(0)" ::: "memory"); __builtin_amdgcn_s_barrier(); asm volatile("" ::: "memory");
                    if (idx >= 128u) { label = (label + 1) & 7; if (++tries == 8) break; continue; }
                    const int qb = 31 - (int)(idx >> 2), bh = label + 8 * (int)(idx & 3u);
                    attn_body::attn_unit<8>(bh >> 4, bh & 15, qb, (const attn_body::bf16*)(ws + O_Q), (const attn_body::bf16*)(ws + O_K), (const attn_body::bf16*)(ws + O_V), (const float*)(ws + O_CB), (const unsigned*)(ws + O_CTL) + CW_QK + l * 64,
                                            (const attn_body::bf16*)(ws + O_GC), (attn_body::bf16*)(ws + O_Y) + (size_t)2 * T * W, (char*)lds_, wave_k);
                }
                unsigned* e3c = (unsigned*)(ws + O_CTL) + CW_E3 + l * 64;
                if (wave == 0) { unsigned polls = 0;
                    while ((unsigned)__builtin_amdgcn_readfirstlane(__hip_atomic_load(e3c, __ATOMIC_RELAXED, __HIP_MEMORY_SCOPE_AGENT)) < 16u) { if (++polls > (1u << 20)) break; __builtin_amdgcn_s_sleep(8); }
                    __builtin_amdgcn_fence(__ATOMIC_ACQUIRE, "agent"); asm volatile("s_waitcnt vmcnt(0)" ::: "memory"); }
                asm volatile("s_waitcnt vmcnt(0) lgkmcnt(0)" ::: "memory"); __builtin_amdgcn_s_barrier(); asm volatile("" ::: "memory");
                for (;;) {
                    if (wave == 0 && lane == 0) qw[0] = __hip_atomic_fetch_add(e3c + 32, 64u, __ATOMIC_RELAXED, __HIP_MEMORY_SCOPE_AGENT);
                    asm volatile("s_waitcnt vmcnt(0) lgkmcnt(0)" ::: "memory"); __builtin_amdgcn_s_barrier(); asm volatile("" ::: "memory");
                    const unsigned base = qw[0];
                    asm volatile("s_waitcnt lgkmcnt(0)" ::: "memory"); __builtin_amdgcn_s_barrier(); asm volatile("" ::: "memory");
                    if (base >= (unsigned)T) break;
                    e3_phase(q, l, (int)base + wave * 8, (int)base + wave * 8 + 8, lane);
                }
            }
            SEAM(pb + 5);
#undef POLL_GE
#undef X_SIDE
        }
        if (IN(pb + 8)) { WSQ();
            pg8::Gemm g{(const bf16_t*)(ws + O_Y), (const bf16_t*)(ws + O_WTBR) + (size_t)l * 4 * D * W, 4 * T, 4 * D, W}; BranchOrder S; BX(); S.init(G, bx);
            EpiG3Q E{ws, p.in[I_BM] + (size_t)l * NB * D, bx};
            pg8::gemm_phase<EpiG3Q, BranchOrder, true, true>(lds, g, S, E, wave_k);
            { const int pmg = 8 * (bx & 7) + ((bx >> 3) & 7); GRP_PUB(GRP_CTR(0)); }
        }
        if (IN(pb + 9)) { WSQ(); { BX(); const int pmg = 8 * (bx & 7) + ((bx >> 3) & 7); GRP_POLL(GRP_CTR(0), 4); }
            pg8::Gemm g{(const bf16_t*)(ws + O_MG), (const bf16_t*)(ws + O_WTOUT) + (size_t)l * D * D, T, D, D}; pg8::StaticOrder S; BX(); S.init(T, D, G, bx);
            EpiG4 E{(l == 0) ? q.in[I_X] : (const float*)nullptr, (const bf16_t*)(ws + O_X), (bf16_t*)(ws + O_X)};
            pg8::gemm_phase<EpiG4, pg8::StaticOrder, true, true>(lds, g, S, E, wave_k);
            if (l == DEPTH - 1) SEAM(pb + 9); else { const int pmg = 8 * (bx & 7) + ((bx >> 3) & 7); GRP_PUB(GRP_CTR(1)); }
        }
    }
    int lo2 = p.ph_lo, hi2 = p.ph_hi; asm volatile("" : "+s"(lo2), "+s"(hi2));
    if (lo2 <= 42 && 42 < hi2) { WSQ(); IDS(); e_rmsnorm_bf((const bf16_t*)(ws + O_X), p.in[I_FG], nullptr, p.out, gw, ngw, lane); }
#undef IN
#undef SEAM
}

extern "C" void kernel_launch(void* const* d_in, const int* in_sizes, int n_in, void* d_out, int out_size, void* d_ws, size_t ws_size, hipStream_t stream) {
    static int state = 0;
    if (state == 0) {
        if (n_in != 21 || in_sizes[0] != T * D || out_size != T * D || ws_size < WS_END) {
            fprintf(stderr, "kernel_launch: unexpected shapes (n_in %d, in0 %d, out %d, ws %zu < %zu); nothing launched\n", n_in, n_in > 0 ? in_sizes[0] : -1, out_size, ws_size, (size_t)WS_END);
            state = -1; return; }
        int dev = 0, cus = 0, per_cu = 0;
        if (hipGetDevice(&dev) != hipSuccess || hipDeviceGetAttribute(&cus, hipDeviceAttributeMultiprocessorCount, dev) != hipSuccess) { fprintf(stderr, "kernel_launch: device query failed\n"); state = -1; return; }
        if (hipFuncSetAttribute((const void*)fwd, hipFuncAttributeMaxDynamicSharedMemorySize, LDS_BYTES) != hipSuccess) { fprintf(stderr, "kernel_launch: hipFuncSetAttribute failed\n"); state = -1; return; }
        if (hipOccupancyMaxActiveBlocksPerMultiprocessor(&per_cu, (const void*)fwd, NWAVES * 64, LDS_BYTES) != hipSuccess || per_cu < 1)
            fprintf(stderr, "kernel_launch: note: occupancy query reports %d workgroups per CU\n", per_cu);
        (void)hipGetLastError();
        if (cus != 256) fprintf(stderr, "kernel_launch: note: %d CUs reported; this kernel launches 256 workgroups (one per CU of a 256-CU device)\n", cus);
        state = 1;
    }
    if (state < 0) return;
    if (hipMemsetAsync((char*)d_ws + O_CTL, 0, 1 * MiB, stream) != hipSuccess) { fprintf(stderr, "kernel_launch: memset failed\n"); return; }
    Params p{};
    for (int i = 0; i < 21; ++i) p.in[i] = (const float*)d_in[i];
    p.out = (float*)d_out; p.ws = (unsigned char*)d_ws;
#if MK_PER_PHASE
    for (int id = 0; id < NPH; ++id) { p.ph_lo = id; p.ph_hi = id + 1; p.li = id; p.pad = 0; hipLaunchKernelGGL(fwd, dim3(256), dim3(NWAVES * 64), LDS_BYTES, stream, p); }
#else
    p.ph_lo = 0; p.ph_hi = NPH; p.li = 0; p.pad = 0;
    hipLaunchKernelGGL(fwd, dim3(256), dim3(NWAVES * 64), LDS_BYTES, stream, p);
#endif
    const hipError_t le = hipPeekAtLastError();
    if (le != hipSuccess) fprintf(stderr, "kernel_launch: launch failed: %s\n", hipGetErrorName(le));
}
```

```cpp
#include <hip/hip_runtime.h>
#include <hip/hip_bf16.h>
#include <cstdio>
#include <cstdint>
#include <cmath>

__device__ __forceinline__ int lane_opaque() { int r; asm volatile("v_mbcnt_lo_u32_b32 %0, -1, 0\n\tv_mbcnt_hi_u32_b32 %0, -1, %0" : "=v"(r)); return r; }
constexpr int D = 2048, BATCH = 2, SEQ = 8192, T = BATCH * SEQ, DEPTH = 4, W = 1024, NB = 4;
constexpr int NIN = 22672;
constexpr int NP = 22784;
constexpr int OA = 0, OB = 4096, OWL = 7168, OAL = 7232, OBG = 7296, OCQ = 8320, OCF = 11392, OCG = 11408, ODI = 12432, ODG = 13456, OML = 14480;
constexpr int PA = 0, PB = 4096, PGB = 7168, PQ = 8192, PK = 9216, PV = 10240, PGC = 11264, PUD = 12288, PGD = 13312, PS = 14336, PML = 14592;
constexpr float C2 = 0.125f * 1.4426950408889634f;
constexpr float LOG2E = 1.4426950408889634f;

constexpr size_t MiB = 1u << 20;
constexpr size_t O_CTL = 0;
constexpr size_t O_WTIN = 1 * MiB;
constexpr size_t O_WTBR = O_WTIN + 356 * MiB;
constexpr size_t O_WTOUT = O_WTBR + 64 * MiB;
constexpr size_t O_WTLORA = O_WTOUT + 32 * MiB;
constexpr size_t O_WD = O_WTLORA + 4 * MiB;
constexpr size_t O_H = O_WD + 32 * MiB;
constexpr size_t O_UA = O_H + 64 * MiB;
constexpr size_t O_UB = O_UA + 128 * MiB;
constexpr size_t O_GB = O_UB + 96 * MiB;
constexpr size_t O_Q = O_GB + 32 * MiB;
constexpr size_t O_K = O_Q + 32 * MiB;
constexpr size_t O_V = O_K + 32 * MiB;
constexpr size_t O_GC = O_V + 32 * MiB;
constexpr size_t O_UD = O_GC + 32 * MiB;
constexpr size_t O_GD = O_UD + 32 * MiB;
constexpr size_t O_ML = O_GD + 32 * MiB;
constexpr size_t O_S = O_ML + 256 * MiB;
constexpr size_t O_LA = O_S + 16 * MiB;
constexpr size_t O_LF = O_LA + 8 * MiB;
constexpr size_t O_CB = O_LF + 1 * MiB;
constexpr size_t O_BON = O_CB + 1 * MiB;
constexpr size_t O_WDEC = O_BON + 1 * MiB;
constexpr size_t O_ASIG = O_WDEC + 64 * MiB;
constexpr size_t O_SCN = O_ASIG + 64 * MiB;
constexpr size_t O_VS = O_SCN + 320 * MiB;
constexpr size_t O_YS = O_VS + 64 * MiB;
constexpr size_t O_Y = O_YS + 64 * MiB;
constexpr size_t O_MG = O_Y + 128 * MiB;
constexpr size_t O_MACC = O_MG + 64 * MiB;
constexpr size_t O_X = O_MACC + 64 * MiB;
constexpr size_t O_GP = O_X + 128 * MiB;
constexpr size_t O_PG = O_GP + 256 * MiB;
constexpr size_t WS_END = O_PG + 32 * MiB;

struct Params { const float* in[21]; float* out; unsigned char* ws; int ph_lo, ph_hi, li, pad; };
enum { I_X = 0, I_NG, I_WIN, I_BM, I_CW, I_MU, I_W0, I_W2, I_A0, I_A2, I_KK, I_KA, I_RK, I_LG, I_LB, I_BF, I_PW, I_PS, I_WB, I_WO, I_FG };

namespace pg8 {
#define PG8_LAS __attribute__((address_space(3)))
typedef unsigned short bf16_t;
typedef short bf16x8 __attribute__((ext_vector_type(8)));
typedef float f32x4 __attribute__((ext_vector_type(4)));
typedef unsigned u32x4 __attribute__((ext_vector_type(4)));
constexpr int BM = 256, BK = 64, HALF = 128, HTB = HALF * BK * 2  , STAGE_BYTES = 8 * HTB, NXCD = 8, WGM = 8;

__host__ __device__ __forceinline__ int lds_byte(int r, int c) { const int st = (r >> 4) * 2 + (c >> 5), rr = r & 15, cc = c & 31, ob = rr * 64 + cc * 2; return st * 1024 + (ob ^ (((ob >> 9) & 1) << 5)); }
__host__ __device__ __forceinline__ void stage_rc(int b, int& R, int& C) { const int st = b / 1024, sb = b % 1024, swz = sb ^ (((sb >> 9) & 1) << 5); R = (st >> 1) * 16 + swz / 64; C = (st & 1) * 32 + (swz % 64) / 2; }
__host__ __device__ __forceinline__ int perm32(int rho) { const int n = rho >> 4, i = rho & 15; return 8 * (i >> 2) + 4 * n + (i & 3); }

struct Unit { int pm, pn; };
struct Gemm { const bf16_t* A; const bf16_t* Bt; int M, N, K; };

struct StaticOrder {
    int nM, nN, nwg, G, c;
    __host__ __device__ void init(int M, int N, int G_, int c_) { nM = M / BM; nN = N / BM; nwg = nM * nN; G = G_; c = c_; }
    __host__ __device__ bool next(int i, Unit& u) const {
        const long L = (long)i * G + c; if (L >= nwg) return false;
        int wgid = (int)L; { const int q = nwg / NXCD, r = nwg % NXCD, xcd = wgid % NXCD, off = wgid / NXCD; wgid = (xcd < r ? xcd * (q + 1) : r * (q + 1) + (xcd - r) * q) + off; }
        const int nig = WGM * nN, gid = wgid / nig, fm = gid * WGM, gsz = (nM - fm) < WGM ? (nM - fm) : WGM;
        u.pm = fm + ((wgid % nig) % gsz); u.pn = (wgid % nig) / gsz; return true;
    }
    __device__ __forceinline__ void a_ready(const Unit&) const {}
    __device__ __forceinline__ void done(const Unit&) const {}
};

__device__ __forceinline__ unsigned cvt_pk_bf16(float lo, float hi) { unsigned r; asm volatile("v_cvt_pk_bf16_f32 %0, %1, %2" : "=v"(r) : "v"(lo), "v"(hi)); return r; }

template <class Epi, class Sched, bool ALIGN_EPI = false, bool SP2 = false>
__device__ __forceinline__ void gemm_phase(PG8_LAS unsigned char* lds, const Gemm g, const Sched& S, const Epi& E, const int wave_k) {
    int wid_o = wave_k; asm volatile("" : "+s"(wid_o));
    const int lane = lane_opaque(), wid = wid_o, tid = wid * 64 + lane,
    wr = wid >> 2, wc = wid & 3, fr = lane & 15, fq = lane >> 4;
    const int K = g.K, nt = K / BK;
    unsigned voffA[2], voffB[2];
#pragma unroll
    for (int i = 0; i < 2; ++i) { int R, C; stage_rc(tid * 16 + i * 8192, R, C); const int Rb = Epi::PERM ? ((R & ~31) + perm32(R & 31)) : R;
        voffA[i] = (unsigned)(R * K + C) * 2u; voffB[i] = (unsigned)(Rb * K + C) * 2u; }
    const size_t kstep = (size_t)(BK * 2);
    const size_t hstep = (size_t)HALF * K * 2;
    const size_t tstep = 2 * hstep;
    const unsigned ldsw = (unsigned)wid * 1024u;
    const int aoff = lds_byte(wr * 64 + fr, fq * 8), boff = lds_byte(wc * 32 + fr, fq * 8);
#define PG8_SA(b, h) (((b) * 2 + (h)) * HTB)
#define PG8_SB(b, h) ((4 + (b) * 2 + (h)) * HTB)
#define PG8_STAGE(bufoff, gbase, voff) do { _Pragma("unroll") for (int _i = 0; _i < 2; ++_i) \
        __builtin_amdgcn_global_load_lds((const unsigned*)((const char*)(gbase) + (voff)[_i]), (PG8_LAS unsigned*)(lds + (bufoff) + ldsw + _i * 8192), 16, 0, 0); } while (0)
#define PG8_LDA(dst, b, h) do { _Pragma("unroll") for (int m = 0; m < 4; ++m) _Pragma("unroll") for (int k = 0; k < 2; ++k) dst[m][k] = *(const PG8_LAS bf16x8*)(lds + PG8_SA(b, h) + aoff + m * 2048 + k * 1024); } while (0)
#define PG8_LDB(dst, b, h) do { _Pragma("unroll") for (int n = 0; n < 2; ++n) _Pragma("unroll") for (int k = 0; k < 2; ++k) dst[n][k] = *(const PG8_LAS bf16x8*)(lds + PG8_SB(b, h) + boff + n * 2048 + k * 1024); } while (0)
#define PG8_MMA(ai, bj, At, Bt) do { __builtin_amdgcn_s_setprio(1); _Pragma("unroll") for (int m = 0; m < 4; ++m) _Pragma("unroll") for (int n = 0; n < 2; ++n) _Pragma("unroll") for (int k = 0; k < 2; ++k) \
        acc[ai][bj][m][n] = __builtin_amdgcn_mfma_f32_16x16x32_bf16(Bt[n][k], At[m][k], acc[ai][bj][m][n], 0, 0, 0); __builtin_amdgcn_s_setprio(0); } while (0)
#define PG8_WAIT_V(n) asm volatile("s_waitcnt vmcnt(" #n ")" ::: "memory")
#define PG8_WAIT_L(n) asm volatile("s_waitcnt lgkmcnt(" #n ")" ::: "memory")
#define PG8_WAIT_VR(rx, n) asm volatile("s_cmp_lg_u32 %0, 0\n\ts_cbranch_scc1 1f\n\ts_waitcnt vmcnt(8)\n1:\n\ts_waitcnt vmcnt(%1)" :: "s"(rx), "n"(n) : "memory", "scc")
#define PG8_BAR __builtin_amdgcn_s_barrier()
#define PG8_SCHED __builtin_amdgcn_sched_barrier(0)
    Unit cur, nxt; int ui = 0;
    if (!S.next(0, cur)) return;
    f32x4 acc[2][2][4][2];
#pragma unroll
    for (int a = 0; a < 2; ++a)
#pragma unroll
        for (int b = 0; b < 2; ++b)
#pragma unroll
            for (int m = 0; m < 4; ++m)
#pragma unroll
                for (int n = 0; n < 2; ++n) acc[a][b][m][n] = (f32x4){0.f, 0.f, 0.f, 0.f};
    bf16x8 At[4][2], B0[2][2], B1[2][2];
    const char* cA = (const char*)g.A + (size_t)cur.pm * tstep; const char* cB = (const char*)g.Bt + (size_t)cur.pn * tstep;
    S.a_ready(cur);
    if constexpr (SP2) {
        PG8_STAGE(PG8_SB(0, 0), cB, voffB); PG8_STAGE(PG8_SB(0, 1), cB + hstep, voffB); PG8_STAGE(PG8_SA(0, 0), cA, voffA); PG8_STAGE(PG8_SA(0, 1), cA + hstep, voffA);
        if (wr == 1) PG8_BAR;
        PG8_WAIT_V(2); PG8_BAR;
        PG8_STAGE(PG8_SB(1, 0), cB + kstep, voffB); PG8_STAGE(PG8_SA(1, 0), cA + kstep, voffA); PG8_STAGE(PG8_SB(1, 1), cB + hstep + kstep, voffB);
        PG8_WAIT_V(6); PG8_BAR;
    } else {
        PG8_STAGE(PG8_SB(0, 0), cB, voffB); PG8_STAGE(PG8_SA(0, 0), cA, voffA); PG8_STAGE(PG8_SB(0, 1), cB + hstep, voffB); PG8_STAGE(PG8_SA(0, 1), cA + hstep, voffA);
        if (wr == 1) PG8_BAR;
        PG8_WAIT_V(4); PG8_BAR;
        PG8_STAGE(PG8_SB(1, 0), cB + kstep, voffB); PG8_STAGE(PG8_SA(1, 0), cA + kstep, voffA); PG8_STAGE(PG8_SB(1, 1), cB + hstep + kstep, voffB);
        PG8_WAIT_V(6); PG8_BAR;
    }
    for (;;) {
        const bool has_next = S.next(ui + 1, nxt);
        const char* nA = has_next ? (const char*)g.A + (size_t)nxt.pm * tstep : cA; const char* nB = has_next ? (const char*)g.Bt + (size_t)nxt.pn * tstep : cB;
        for (int t = 0; t < nt; t += 2) {
            const bool last = (t == nt - 2);
            const char* a1 = cA + (size_t)(t + 1) * kstep;
            const char* a2 = last ? nA : cA + (size_t)(t + 2) * kstep; const char* b2 = last ? nB : cB + (size_t)(t + 2) * kstep;
            const char* a3 = a2 + kstep; const char* b3 = b2 + kstep;
            if (last && has_next) S.a_ready(nxt);
            const int relax = __builtin_amdgcn_readfirstlane((t == 0 && ui > 0) ? 1 : 0);
            if constexpr (SP2) {
            PG8_LDB(B0, 0, 0); PG8_LDB(B1, 0, 1); PG8_SCHED; PG8_LDA(At, 0, 0); PG8_STAGE(PG8_SA(1, 1), a1 + hstep, voffA);
            PG8_WAIT_VR(relax, 8 + Epi::NST); PG8_WAIT_L(0); PG8_BAR; PG8_MMA(0, 0, At, B0); PG8_MMA(0, 1, At, B1); PG8_BAR; PG8_SCHED;
            PG8_LDA(At, 0, 1); PG8_STAGE(PG8_SB(0, 0), b2, voffB); PG8_STAGE(PG8_SB(0, 1), b2 + hstep, voffB); PG8_STAGE(PG8_SA(0, 0), a2, voffA);
            PG8_WAIT_VR(relax, 8 + Epi::NST); PG8_WAIT_L(0); PG8_BAR; PG8_MMA(1, 0, At, B0); PG8_MMA(1, 1, At, B1); PG8_BAR; PG8_SCHED;
            PG8_LDB(B0, 1, 0); PG8_LDB(B1, 1, 1); PG8_SCHED; PG8_LDA(At, 1, 0); PG8_STAGE(PG8_SA(0, 1), a2 + hstep, voffA);
            PG8_WAIT_V(8); PG8_WAIT_L(0); PG8_BAR; PG8_MMA(0, 0, At, B0); PG8_MMA(0, 1, At, B1); PG8_BAR; PG8_SCHED;
            PG8_LDA(At, 1, 1); PG8_STAGE(PG8_SB(1, 0), b3, voffB); PG8_STAGE(PG8_SB(1, 1), b3 + hstep, voffB); PG8_STAGE(PG8_SA(1, 0), a3, voffA);
            PG8_WAIT_V(8); PG8_WAIT_L(0); PG8_BAR; PG8_MMA(1, 0, At, B0); PG8_MMA(1, 1, At, B1); PG8_BAR; PG8_SCHED;
            } else {
            PG8_LDB(B0, 0, 0); PG8_SCHED; PG8_LDA(At, 0, 0); PG8_STAGE(PG8_SA(1, 1), a1 + hstep, voffA);
            PG8_WAIT_L(8); PG8_BAR; PG8_WAIT_L(0); PG8_MMA(0, 0, At, B0); PG8_BAR; PG8_SCHED;
            PG8_LDB(B1, 0, 1); PG8_STAGE(PG8_SB(0, 0), b2, voffB);
            PG8_BAR; PG8_WAIT_L(0); PG8_MMA(0, 1, At, B1); PG8_BAR;
            PG8_LDA(At, 0, 1); PG8_STAGE(PG8_SA(0, 0), a2, voffA);
            PG8_BAR; PG8_WAIT_L(0); PG8_MMA(1, 0, At, B0); PG8_BAR; PG8_SCHED;
            PG8_STAGE(PG8_SB(0, 1), b2 + hstep, voffB);
            PG8_WAIT_V(6); PG8_BAR; PG8_MMA(1, 1, At, B1); PG8_BAR;
            PG8_LDB(B0, 1, 0); PG8_SCHED; PG8_LDA(At, 1, 0); PG8_STAGE(PG8_SA(0, 1), a2 + hstep, voffA);
            PG8_WAIT_L(8); PG8_BAR; PG8_WAIT_L(0); PG8_MMA(0, 0, At, B0); PG8_BAR; PG8_SCHED;
            PG8_LDB(B1, 1, 1); PG8_STAGE(PG8_SB(1, 0), b3, voffB);
            PG8_BAR; PG8_WAIT_L(0); PG8_MMA(0, 1, At, B1); PG8_BAR;
            PG8_LDA(At, 1, 1); PG8_STAGE(PG8_SA(1, 0), a3, voffA);
            PG8_BAR; PG8_WAIT_L(0); PG8_MMA(1, 0, At, B0); PG8_BAR; PG8_SCHED;
            PG8_STAGE(PG8_SB(1, 1), b3 + hstep, voffB);
            PG8_WAIT_V(6); PG8_BAR; PG8_MMA(1, 1, At, B1); PG8_BAR;
            }
        }
        if constexpr (ALIGN_EPI) { if (wr == 0) PG8_BAR; }
        if constexpr (!Epi::AFTER_DRAIN) { E(acc, cur, wr, wc, fr, fq); S.done(cur); }
        if (!has_next) break;
#pragma unroll
        for (int a = 0; a < 2; ++a)
#pragma unroll
            for (int b = 0; b < 2; ++b)
#pragma unroll
                for (int m = 0; m < 4; ++m)
#pragma unroll
                    for (int n = 0; n < 2; ++n) acc[a][b][m][n] = (f32x4){0.f, 0.f, 0.f, 0.f};
        cur = nxt; cA = nA; cB = nB; ++ui;
        if constexpr (ALIGN_EPI) { if (wr == 1) PG8_BAR; }
    }
    PG8_WAIT_V(0);
    if constexpr (!ALIGN_EPI) { if (wr == 0) PG8_BAR; }
    PG8_BAR;
    if constexpr (Epi::AFTER_DRAIN) { E.fused(acc, cur, wr, wc, fr, fq, lds, wid, lane); S.done(cur); }
#undef PG8_SA
#undef PG8_SB
#undef PG8_STAGE
#undef PG8_LDA
#undef PG8_LDB
#undef PG8_MMA
#undef PG8_WAIT_V
#undef PG8_WAIT_L
#undef PG8_WAIT_VR
#undef PG8_BAR
#undef PG8_SCHED
}
}

namespace attn_body {
using bf16=__hip_bfloat16;
using bf16x8=__attribute__((ext_vector_type(8)))short;
using s16x4=__attribute__((ext_vector_type(4)))short;
using f32x16=__attribute__((ext_vector_type(16)))float;
using u32x4=__attribute__((ext_vector_type(4)))unsigned;
constexpr int BATCH=2,NHEAD=16,SEQ=8192,D=64,DM=NHEAD*D;
constexpr int NW=8,QBLK=32,QB=QBLK*NW,KVBLK=64,NQB=SEQ/QB;
constexpr int ATTN_PITCH=DM, ATTN_UNIT_ROWS=QB;
__device__ __forceinline__ int crow(int r,int hi){return (r&3)+8*(r>>2)+4*hi;}
#define SBAR() __builtin_amdgcn_sched_barrier(0)
__device__ __forceinline__ void cmask(f32x16&p0,f32x16&p1,int jb,int qrel,int hi){
  const float NEG=-INFINITY; int kb=64*jb+4*hi;
  #pragma unroll
  for(int r=0;r<16;++r){int kv=kb+(r&3)+8*(r>>2); if(kv>qrel)p0[r]=NEG; if(kv+32>qrel)p1[r]=NEG;}
}

constexpr int NSLOT=3, SLOTB=8192;
constexpr int LDS_K=0, LDS_V=NSLOT*SLOTB, LDS_WS=2*NSLOT*SLOTB, LDS_OST=LDS_WS+NW*64*4, LDS_CB=LDS_OST+NW*4096, LDS_BYTES=LDS_CB+SEQ*4;
constexpr int PRUNE_THR=40;
constexpr float C2=0.125f*1.4426950408889634f;
__device__ __forceinline__ void glds16(const void*gsrc,unsigned lds_dst){unsigned keep;
  asm volatile("s_mov_b32 %0, m0\n\ts_mov_b32 m0, %2\n\ts_nop 0\n\tglobal_load_lds_dwordx4 %1, off\n\ts_mov_b32 m0, %0":"=&s"(keep):"v"(gsrc),"s"(lds_dst):"memory");}
__device__ __forceinline__ float max3f(float a,float b,float c){float r;asm("v_max3_f32 %0, %1, %2, %3":"=v"(r):"v"(a),"v"(b),"v"(c));return r;}
__device__ __forceinline__ float max2f(float a,float b){float r;asm("v_max_f32_e32 %0, %1, %2":"=v"(r):"v"(a),"v"(b));return r;}
__device__ __forceinline__ float fadd_s(float a,float b){float r;asm("v_add_f32_e32 %0, %1, %2":"=v"(r):"v"(a),"v"(b));return r;}
__device__ __forceinline__ float fsub_s(float a,float b){float r;asm("v_sub_f32_e32 %0, %1, %2":"=v"(r):"v"(a),"v"(b));return r;}
typedef float f32x2_t __attribute__((ext_vector_type(2))); typedef __bf16 bf16x2_t __attribute__((ext_vector_type(2)));
__device__ __forceinline__ unsigned cvtpk_s(float lo,float hi){f32x2_t v={lo,hi};bf16x2_t b=__builtin_convertvector(v,bf16x2_t);return __builtin_bit_cast(unsigned,b);}
#define WAIT_BAR(N) asm volatile("s_waitcnt vmcnt(" #N ") lgkmcnt(0)\n\ts_barrier":::"memory")

__device__ __forceinline__ void split3(float x,unsigned&w0,unsigned&w1){
  const unsigned hb=__float_as_uint(x)&0xffff0000u; const float r1=x-__uint_as_float(hb);
  const unsigned mb=__float_as_uint(r1)&0xffff0000u; const float r2=r1-__uint_as_float(mb);
  w0=(hb>>16)|mb; w1=__float_as_uint(r2)>>16; }
__device__ __forceinline__ bf16x8 mk8(unsigned a,unsigned b,unsigned c,unsigned d){ u32x4 v={a,b,c,d}; return __builtin_bit_cast(bf16x8,v); }
__device__ __forceinline__ void qkt(f32x16&p0,f32x16&p1,const char*Kslot,const bf16x8*qr,int r32,int hi){
  const char*kb=Kslot+hi*1024+r32*16;
  #pragma unroll
  for(int d0=0;d0<4;++d0){
    const bf16x8 b0=*reinterpret_cast<const bf16x8*>(kb+d0*2048);
    const bf16x8 b1=*reinterpret_cast<const bf16x8*>(kb+d0*2048+512);
    p0=__builtin_amdgcn_mfma_f32_32x32x16_bf16(b0,qr[d0],p0,0,0,0);p1=__builtin_amdgcn_mfma_f32_32x32x16_bf16(b1,qr[d0],p1,0,0,0);}
}
typedef __attribute__((address_space(3))) const char* lds_cptr;
typedef short v4i16_t __attribute__((ext_vector_type(4)));
__device__ __forceinline__ void kload8(bf16x8*kf,lds_cptr kp){
  kf[0]=*(const __attribute__((address_space(3))) bf16x8*)(kp);      kf[1]=*(const __attribute__((address_space(3))) bf16x8*)(kp+512);
  kf[2]=*(const __attribute__((address_space(3))) bf16x8*)(kp+2048); kf[3]=*(const __attribute__((address_space(3))) bf16x8*)(kp+2560);
  kf[4]=*(const __attribute__((address_space(3))) bf16x8*)(kp+4096); kf[5]=*(const __attribute__((address_space(3))) bf16x8*)(kp+4608);
  kf[6]=*(const __attribute__((address_space(3))) bf16x8*)(kp+6144); kf[7]=*(const __attribute__((address_space(3))) bf16x8*)(kp+6656);
}
__device__ __forceinline__ void kload2(bf16x8*kf,lds_cptr kp,int j){ kf[2*j]=*(const __attribute__((address_space(3))) bf16x8*)(kp+j*2048); kf[2*j+1]=*(const __attribute__((address_space(3))) bf16x8*)(kp+j*2048+512); }
__device__ __forceinline__ s16x4 vtr(lds_cptr p){ return __builtin_bit_cast(s16x4,__builtin_amdgcn_ds_read_tr16_b64_v4i16((__attribute__((address_space(3))) v4i16_t*)p)); }
__device__ __forceinline__ float rowmax(const f32x16&p0,const f32x16&p1){
  float a=max3f(p0[0],p0[1],p1[0]),b=max3f(p0[2],p0[3],p1[1]);a=max3f(a,p1[2],p1[3]);
  #pragma unroll
  for(int r=4;r<16;r+=4){a=max3f(a,p0[r],p0[r+1]);b=max3f(b,p0[r+2],p0[r+3]);a=max3f(a,p1[r],p1[r+1]);b=max3f(b,p1[r+2],p1[r+3]);}
  const float m=max2f(a,b);
  auto rr=__builtin_amdgcn_permlane32_swap(__float_as_uint(m),__float_as_uint(m),false,false);
  return max2f(__uint_as_float(rr[0]),__uint_as_float(rr[1]));
}
__device__ __forceinline__ void pv(f32x16*o,int vb,bf16x8 pa0,bf16x8 pa1,bf16x8 pa2,bf16x8 pa3){
  #pragma unroll
  for(int d0=0;d0<2;++d0){s16x4 lo[4],hi[4];
    #pragma unroll
    for(int ks=0;ks<4;++ks){
      asm volatile("ds_read_b64_tr_b16 %0,%1 offset:%c2":"=&v"(lo[ks]):"v"(vb),"i"(d0*4096+ks*1024):"memory");
      asm volatile("ds_read_b64_tr_b16 %0,%1 offset:%c2":"=&v"(hi[ks]):"v"(vb),"i"(d0*4096+ks*1024+512):"memory");}
    asm volatile("s_waitcnt lgkmcnt(0)":::"memory");SBAR();
    #define PK(k) (bf16x8){lo[k][0],lo[k][1],lo[k][2],lo[k][3],hi[k][0],hi[k][1],hi[k][2],hi[k][3]}
    o[d0]=__builtin_amdgcn_mfma_f32_32x32x16_bf16(pa0,PK(0),o[d0],0,0,0);
    o[d0]=__builtin_amdgcn_mfma_f32_32x32x16_bf16(pa1,PK(1),o[d0],0,0,0);
    o[d0]=__builtin_amdgcn_mfma_f32_32x32x16_bf16(pa2,PK(2),o[d0],0,0,0);
    o[d0]=__builtin_amdgcn_mfma_f32_32x32x16_bf16(pa3,PK(3),o[d0],0,0,0);
    #undef PK
  }
}

#ifndef ATTN_STORE16
#define ATTN_STORE16(p,v) (*(u32x4*)(p)=(v))
#endif
template<int THRL> __device__ __forceinline__ void attn_unit(int b,int h,int qb,const bf16*Q,const bf16*__restrict__ K,const bf16*__restrict__ V,const float*__restrict__ CB,const unsigned*__restrict__ QKM,const bf16*__restrict__ Gt,bf16*O,char*shm,const int wave_k){
  int wid_o=wave_k; asm volatile("":"+s"(wid_o)); const int lane=lane_opaque(),r32=lane&31,hi=lane>>5; const int wid=wid_o; const int tid=wid*64+lane; (void)tid;
  const long rowbase=(long)b*SEQ; const int q0=qb*QB;
  const bf16*Qw=Q+(rowbase+q0+wid*QBLK)*DM+h*D;
  const bf16*Kh=K+rowbase*DM+h*D,*Vh=V+rowbase*DM+h*D;
  const unsigned lds0=(unsigned)(uintptr_t)shm;
  float*wsf=(float*)(shm+LDS_WS)+wid*64;
  const bf16* ksrc=Kh+(long)lane*DM+wid*8;
  const bf16* vsrc=Vh+(long)(16*(wid&3)+(lane>>2))*DM+(wid>>2)*32+(lane&3)*8;
  const unsigned kdst=lds0+LDS_K+wid*1024, vdst=lds0+LDS_V+wid*1024;
  #define DMA_K(t,slot) glds16(ksrc+(long)(t)*KVBLK*DM,(unsigned)__builtin_amdgcn_readfirstlane(kdst+(slot)))
  #define DMA_V(t,slot) glds16(vsrc+(long)(t)*KVBLK*DM,(unsigned)__builtin_amdgcn_readfirstlane(vdst+(slot)))
  const int vb0=(int)(lds0+LDS_V)+((lane>>4)&1)*32+(lane&3)*8+(4*hi+((lane&15)>>2))*64;
  const char*Kbase=shm+LDS_K; bf16x8 kf[8];
  const lds_cptr shm3=(lds_cptr)shm; const lds_cptr kp0=shm3+LDS_K+hi*1024+r32*16; const lds_cptr vp0=shm3+LDS_V+((lane>>4)&1)*32+(lane&3)*8+(4*hi+((lane&15)>>2))*64;
  int NT=(q0+QB)/KVBLK;
  { const float*cbg=CB+(long)(b*NHEAD+h)*SEQ+lane*4;
    for(int pc=wid;pc<NT/4;pc+=NW) glds16(cbg+pc*256,(unsigned)__builtin_amdgcn_readfirstlane(lds0+LDS_CB+pc*1024)); }
  int t0=0;
  { asm volatile("s_waitcnt vmcnt(0)\n\ts_barrier":::"memory");
    typedef __attribute__((address_space(3))) const float* lds_fptr0; const lds_fptr0 cb0=(lds_fptr0)((lds_cptr)shm+LDS_CB);
    const float qk=sqrtf(__uint_as_float(QKM[(b*NHEAD+h)*2])*__uint_as_float(QKM[(b*NHEAD+h)*2+1]));
    const float lim=cb0[q0]+2.0f*qk*1.001f+1.0f+(float)PRUNE_THR;
    int cnt=0;
    for(int base=0;base<NT-4;base+=64){ const int tt=base+lane; const bool pr=(tt<NT-4)&&(cb0[64*(tt<NT-4?tt:0)+63]>=lim); cnt+=__popcll(__ballot(pr)); }
    t0=cnt&~1; }
  ksrc+=(long)t0*KVBLK*DM; vsrc+=(long)t0*KVBLK*DM; NT-=t0;
  DMA_K(0,0);DMA_V(0,0);DMA_K(1,SLOTB);
  bf16x8 qr[4];
  #pragma unroll
  for(int d0=0;d0<4;++d0)qr[d0]=*reinterpret_cast<const bf16x8*>(&Qw[(long)r32*DM+d0*16+hi*8]);
  float mhat=0.f,l_reg=0.f;f32x16 o[2];o[0]=f32x16{};o[1]=f32x16{};
  typedef __attribute__((address_space(3))) const float* lds_fptr;
  const lds_fptr cbl=(lds_fptr)(shm3+LDS_CB)+lane+t0*64; bf16x8 qm,kb0,kb1; float cref=0.f; const f32x16 z16=f32x16{};
  #define MKQM() do{ unsigned a_,b_; split3(-mhat,a_,b_); qm=hi?mk8(0u,0u,0u,0u):mk8(0x3F803F80u,0x3F80u|(a_<<16),(a_>>16)|(b_<<16),0u); }while(0)
  #define BIAS(t) do{ unsigned w0_,w1_; split3(cref-cbl[(t)*64],w0_,w1_); w1_|=0x3F800000u; \
    auto s0_=__builtin_amdgcn_permlane32_swap(w0_,w0_,false,false); auto s1_=__builtin_amdgcn_permlane32_swap(w1_,w1_,false,false); \
    kb0=mk8(w0_,w1_,0x3F803F80u,0u); kb1=mk8(s0_[1],s1_[1],0x3F803F80u,0u); }while(0)
  const int qrel=wid*QBLK+r32;
  #define CMASK(P0,P1,t) do{int jb_=(t)-(NT-4); if(jb_>=0)cmask(P0,P1,jb_,qrel,hi);}while(0)
  bool resc=false;
  #define START(P0,P1) do{ const float rm=rowmax(P0,P1); resc=false; \
    { const float dl=rm; mhat=fadd_s(mhat,dl); \
      _Pragma("unroll") for(int r=0;r<16;++r){P0[r]=fsub_s(P0[r],dl);P1[r]=fsub_s(P1[r],dl);} \
      } \
    _Pragma("unroll") for(int r=0;r<16;++r)P0[r]=__builtin_amdgcn_exp2f(P0[r]); }while(0)
  #define RESC() do{ if(resc){ asm volatile("s_waitcnt lgkmcnt(0)":::"memory"); \
      _Pragma("unroll") for(int d_=0;d_<2;++d_) _Pragma("unroll") for(int r=0;r<16;++r)o[d_][r]*=wsf[crow(r,hi)]; } }while(0)
  f32x16 pA0,pA1,pB0,pB1;
  int sl_prev=0,sl_cur=0,sl_next=SLOTB;
  #define ROT() do{sl_prev=sl_cur;sl_cur=sl_next;sl_next=(sl_next==(NSLOT-1)*SLOTB)?0:sl_next+SLOTB;}while(0)
  DMA_K(2,2*SLOTB);
  WAIT_BAR(3);
  cref=*((lds_fptr)(shm3+LDS_CB)+q0); MKQM(); BIAS(0);
  pA0=__builtin_amdgcn_mfma_f32_32x32x16_bf16(kb0,qm,z16,0,0,0); pA1=__builtin_amdgcn_mfma_f32_32x32x16_bf16(kb1,qm,z16,0,0,0);
  qkt(pA0,pA1,Kbase,qr,r32,hi);asm volatile("s_nop 15\n\ts_nop 7":"+v"(pA0),"+v"(pA1));CMASK(pA0,pA1,0);
  START(pA0,pA1);
  _Pragma("unroll") for(int r=0;r<16;++r)pA1[r]=__builtin_amdgcn_exp2f(pA1[r]);
  WAIT_BAR(0);
  DMA_K(3,0);DMA_V(1,SLOTB);
  ROT();
  kload8(kf,kp0+sl_cur);
  WAIT_BAR(2);
  s16x4 vlo[8],vhi[8]; u32x4 pw0,pw1,pw2,pw3;
  #define PKW(P,B) cvtpk_s(P[B],P[B+1])
  #define PAF(k) __builtin_bit_cast(bf16x8,pw##k)
  #define VFR(i) (bf16x8){vlo[i][0],vlo[i][1],vlo[i][2],vlo[i][3],vhi[i][0],vhi[i][1],vhi[i][2],vhi[i][3]}
  #define PIN(x) asm volatile("":"+v"(x))
  #define MX3(a,b,c) __builtin_fmaxf(__builtin_fmaxf((a),(b)),(c))
  #define GAPA(MF,A0,A1,A2,A3,W0,W1,PW) do{ MF; sacc+=A0; sacc+=A1; sacc+=A2; sacc+=A3; PIN(sacc); W0; W1; PIN(PW); SBAR(); }while(0)
  #define EX(v) __builtin_amdgcn_exp2f(v)
  #define GAPB(MF,X,B) do{ MF; X[B]=EX(X[B]); X[B+1]=EX(X[B+1]); X[B+2]=EX(X[B+2]); X[B+3]=EX(X[B+3]); PIN(X); SBAR(); }while(0)
  #define VRD(i) do{ vlo[i]=vtr(vp_+(((i)>>2)*4096+((i)&3)*1024)); vhi[i]=vtr(vp_+(((i)>>2)*4096+((i)&3)*1024+512)); }while(0)
  #define KRD(G,j) do{ if(G){ kload2(kf,kp0+sl_next,j); SBAR(); } }while(0)
  #define STEP(C0,C1,P0,P1,t,GK,GV,GL) do{ SBAR(); \
    MKQM(); BIAS(t); C0=__builtin_amdgcn_mfma_f32_32x32x16_bf16(kb0,qm,z16,0,0,0); C1=__builtin_amdgcn_mfma_f32_32x32x16_bf16(kb1,qm,z16,0,0,0); SBAR(); \
    const lds_cptr vp_=vp0+sl_prev; \
    VRD(0); SBAR(); float sacc=(P0[0]+P0[1]); \
    GAPA(C0=__builtin_amdgcn_mfma_f32_32x32x16_bf16(kf[0],qr[0],C0,0,0,0), P0[2],P0[3],P0[4],P0[5],     pw0[0]=PKW(P0,0), pw0[1]=PKW(P0,2), pw0); \
    VRD(4); SBAR(); GAPA(C1=__builtin_amdgcn_mfma_f32_32x32x16_bf16(kf[1],qr[0],C1,0,0,0), P0[6],P0[7],P0[8],P0[9],     pw0[2]=PKW(P0,4), pw0[3]=PKW(P0,6), pw0); \
    VRD(1); SBAR(); GAPA(C0=__builtin_amdgcn_mfma_f32_32x32x16_bf16(kf[2],qr[1],C0,0,0,0),   P0[10],P0[11],P0[12],P0[13], pw1[0]=PKW(P0,8), pw1[1]=PKW(P0,10), pw1); \
    VRD(5); SBAR(); GAPA(C1=__builtin_amdgcn_mfma_f32_32x32x16_bf16(kf[3],qr[1],C1,0,0,0),   P0[14],P0[15],P1[0],P1[1],   pw1[2]=PKW(P0,12),pw1[3]=PKW(P0,14), pw1); \
    VRD(2); SBAR(); GAPA(C0=__builtin_amdgcn_mfma_f32_32x32x16_bf16(kf[4],qr[2],C0,0,0,0),   P1[2],P1[3],P1[4],P1[5],     pw2[0]=PKW(P1,0), pw2[1]=PKW(P1,2), pw2); \
    VRD(6); SBAR(); GAPA(C1=__builtin_amdgcn_mfma_f32_32x32x16_bf16(kf[5],qr[2],C1,0,0,0),   P1[6],P1[7],P1[8],P1[9],     pw2[2]=PKW(P1,4), pw2[3]=PKW(P1,6), pw2); \
    VRD(3); SBAR(); GAPA(C0=__builtin_amdgcn_mfma_f32_32x32x16_bf16(kf[6],qr[3],C0,0,0,0),   P1[10],P1[11],P1[12],P1[13], pw3[0]=PKW(P1,8), pw3[1]=PKW(P1,10), pw3); \
    VRD(7); SBAR(); GAPA(C1=__builtin_amdgcn_mfma_f32_32x32x16_bf16(kf[7],qr[3],C1,0,0,0),   P1[14],P1[15],0.f,0.f,       pw3[2]=PKW(P1,12),pw3[3]=PKW(P1,14), pw3); \
    l_reg+=sacc; \
    if(GK){DMA_K((t)+3,sl_cur);} if(GV){DMA_V((t)+1,sl_next);} \
    CMASK(C0,C1,t); \
    { float a=MX3(C0[0],C0[1],C1[0]),b=MX3(C0[2],C0[3],C1[1]); a=MX3(a,C1[2],C1[3]); \
      _Pragma("unroll") for(int r=4;r<16;r+=4){a=MX3(a,C0[r],C0[r+1]);b=MX3(b,C0[r+2],C0[r+3]);a=MX3(a,C1[r],C1[r+1]);b=MX3(b,C1[r+2],C1[r+3]);} \
      float rm=__builtin_fmaxf(a,b); { auto rr=__builtin_amdgcn_permlane32_swap(__float_as_uint(rm),__float_as_uint(rm),false,false); rm=__builtin_fmaxf(__uint_as_float(rr[0]),__uint_as_float(rr[1])); } \
      resc=false; \
      if(__builtin_expect(__any(rm>(float)THRL),0)){ const float dl=__builtin_fmaxf(rm,0.f); mhat+=dl; \
        _Pragma("unroll") for(int r=0;r<16;++r){C0[r]-=dl;C1[r]-=dl;} \
        const float f=__builtin_amdgcn_exp2f(-dl); l_reg*=f; if(hi==0)wsf[r32]=f; resc=true; } } \
    SBAR(); \
    GAPB(o[0]=__builtin_amdgcn_mfma_f32_32x32x16_bf16(PAF(0),VFR(0),o[0],0,0,0), C0,0); \
    GAPB(o[1]=__builtin_amdgcn_mfma_f32_32x32x16_bf16(PAF(0),VFR(4),o[1],0,0,0), C0,4); \
    KRD(GL,0); GAPB(o[0]=__builtin_amdgcn_mfma_f32_32x32x16_bf16(PAF(1),VFR(1),o[0],0,0,0), C0,8); \
    KRD(GL,1); GAPB(o[1]=__builtin_amdgcn_mfma_f32_32x32x16_bf16(PAF(1),VFR(5),o[1],0,0,0), C0,12); \
    KRD(GL,2); GAPB(o[0]=__builtin_amdgcn_mfma_f32_32x32x16_bf16(PAF(2),VFR(2),o[0],0,0,0), C1,0); \
    KRD(GL,3); GAPB(o[1]=__builtin_amdgcn_mfma_f32_32x32x16_bf16(PAF(2),VFR(6),o[1],0,0,0), C1,4); \
    GAPB(o[0]=__builtin_amdgcn_mfma_f32_32x32x16_bf16(PAF(3),VFR(3),o[0],0,0,0), C1,8); \
    GAPB(o[1]=__builtin_amdgcn_mfma_f32_32x32x16_bf16(PAF(3),VFR(7),o[1],0,0,0), C1,12); \
    }while(0)
  int t=1;
  #undef CMASK
  #define CMASK(P0,P1,t) do{}while(0)
  for(;t+5<NT;t+=2){
    STEP(pB0,pB1,pA0,pA1,t,true,true,true);     WAIT_BAR(2); RESC(); ROT();
    STEP(pA0,pA1,pB0,pB1,t+1,true,true,true);   WAIT_BAR(2); RESC(); ROT();
  }
  #undef CMASK
  #define CMASK(P0,P1,t) do{int jb_=(t)-(NT-4); if(jb_>=0)cmask(P0,P1,jb_,qrel,hi);}while(0)
  #define ENDW(tt) do{ if((tt)+3<NT){WAIT_BAR(2);} else if((tt)+2<NT){WAIT_BAR(1);} else {WAIT_BAR(0);} }while(0)
  for(;t+1<NT;t+=2){
    STEP(pB0,pB1,pA0,pA1,t,(t+3<NT),(t+1<NT),(t+1<NT));       ENDW(t);   RESC(); ROT();
    STEP(pA0,pA1,pB0,pB1,t+1,(t+4<NT),(t+2<NT),(t+2<NT));     ENDW(t+1); RESC(); ROT();
  }
  STEP(pB0,pB1,pA0,pA1,NT-1,false,false,false); RESC();
  { float sacc=pB0[0]+pB0[1]; _Pragma("unroll") for(int r=2;r<16;++r)sacc+=pB0[r]; _Pragma("unroll") for(int r=0;r<16;++r)sacc+=pB1[r]; l_reg+=sacc;
    pw0=(u32x4){PKW(pB0,0),PKW(pB0,2),PKW(pB0,4),PKW(pB0,6)};pw1=(u32x4){PKW(pB0,8),PKW(pB0,10),PKW(pB0,12),PKW(pB0,14)};pw2=(u32x4){PKW(pB1,0),PKW(pB1,2),PKW(pB1,4),PKW(pB1,6)};pw3=(u32x4){PKW(pB1,8),PKW(pB1,10),PKW(pB1,12),PKW(pB1,14)};
    SBAR(); pv(o,vb0+sl_cur,PAF(0),PAF(1),PAF(2),PAF(3)); }
  #undef PKW
  #undef PAF
  #undef VFR
  #undef PIN
  #undef MX3
  #undef GAPA
  #undef GAPB
  #undef EX
  #undef VRD
  #undef KRD
  #undef STEP
  #undef ENDW
  {auto rr=__builtin_amdgcn_permlane32_swap(__float_as_uint(l_reg),__float_as_uint(l_reg),false,false);l_reg=__uint_as_float(rr[0])+__uint_as_float(rr[1]);}
  if(hi==0)wsf[32+r32]=l_reg;asm volatile("s_waitcnt lgkmcnt(0)":::"memory");
  float rli[16];
  #pragma unroll
  for(int r=0;r<16;++r)rli[r]=__builtin_amdgcn_rcpf(wsf[32+crow(r,hi)]);
  bf16*Ow=O+(rowbase+q0+wid*QBLK)*DM+h*D; const bf16*Gw=Gt+(rowbase+q0+wid*QBLK)*DM+h*D;
  { bf16*stg=(bf16*)(shm+LDS_OST)+wid*2048;
    #pragma unroll
    for(int r=0;r<16;++r){const int orow=crow(r,hi);
      #pragma unroll
      for(int d0=0;d0<2;++d0)stg[orow*64+d0*32+r32]=__float2bfloat16(o[d0][r]*rli[r]);}
    asm volatile("s_waitcnt lgkmcnt(0)":::"memory");
    #pragma unroll
    for(int i=0;i<4;++i){const int row=i*8+(lane>>3),ch=lane&7; const u32x4 v=*(const u32x4*)(stg+row*64+ch*8); const u32x4 g=*(const u32x4*)(Gw+(long)row*DM+ch*8); u32x4 w;
      #pragma unroll
      for(int e=0;e<4;++e){ const float o0=__uint_as_float(v[e]<<16),o1=__uint_as_float(v[e]&0xffff0000u),g0=__uint_as_float(g[e]<<16),g1=__uint_as_float(g[e]&0xffff0000u);
        w[e]=cvtpk_s(o0*g0*__builtin_amdgcn_rcpf(1.f+__expf(-g0)),o1*g1*__builtin_amdgcn_rcpf(1.f+__expf(-g1))); }
      ATTN_STORE16(Ow+(long)row*DM+ch*8,w);} }
  asm volatile("s_waitcnt lgkmcnt(0)\n\ts_barrier":::"memory");
  #undef DMA_K
  #undef DMA_V
  #undef CMASK
  #undef START
  #undef RESC
  #undef ROT
  #undef MKQM
  #undef BIAS
}
constexpr int ATTN_LDS_BYTES=LDS_BYTES;
struct AttnTensors { const bf16* Q; const bf16* K; const bf16* V; const float* CB; const unsigned* QKM; const bf16* G; bf16* O; };
struct AttnUnit { int bh; int qb; };
struct StaticOrder {
  int vcu;
  __device__ __forceinline__ explicit StaticOrder(int grid,int block):vcu((block%8)*(grid/8)+block/8){}
  __device__ __forceinline__ bool next(int i,AttnUnit&u)const{ if(i>=4)return false; const int s=vcu&7; u.bh=vcu>>3; u.qb=(i==0)?s:(i==1)?15-s:(i==2)?16+s:31-s; return true; }
  __device__ __forceinline__ void a_ready(const AttnUnit&)const{}
  __device__ __forceinline__ void done(const AttnUnit&)const{}
};
template<class Sched,int THRL=8> __device__ __forceinline__ void attn_phase(char*lds,const AttnTensors&T,const Sched&S,const int wave_k){
  AttnUnit u;
  for(int i=0;S.next(i,u);++i){ S.a_ready(u); attn_unit<THRL>(u.bh/NHEAD,u.bh%NHEAD,u.qb,T.Q,T.K,T.V,T.CB,T.QKM,T.G,T.O,lds,wave_k); S.done(u); }
}
#undef SBAR
#undef WAIT_BAR
}

#define LAS __attribute__((address_space(3)))
#define XB_TMO      128
#define XB_XCNT(j)  (256  + 64 * (j))
#define XB_XSUB(j)  (1280 + 64 * (j))
#define XB_XGEN(j)  (2304 + 64 * (j))
#define XB_TOP      3328
#define XB_TOPGEN   3392
#define XCD_BAR_WORDS 3456
#define XB_SPIN_CAP (1u << 18)

__device__ __forceinline__ unsigned xb_ld(unsigned* p)              { return __hip_atomic_load(p, __ATOMIC_RELAXED, __HIP_MEMORY_SCOPE_AGENT); }
__device__ __forceinline__ unsigned xb_add(unsigned* p, unsigned v) { return __hip_atomic_fetch_add(p, v, __ATOMIC_RELAXED, __HIP_MEMORY_SCOPE_AGENT); }
__device__ __forceinline__ unsigned xb_xcc_id() { return (unsigned)__builtin_amdgcn_s_getreg((3 << 11) | 20) & 0xFu; }
#define XB_SPIN(cond, bar) do { unsigned _sp = 0; while (cond) { __builtin_amdgcn_s_sleep(1); \
    if ((++_sp & 255u) == 0u) { if (xb_ld(&(bar)[XB_TMO])) break; if (_sp > XB_SPIN_CAP) { atomicAdd(&(bar)[XB_TMO], 1u); break; } } } } while (0)

struct XcdBarrier {
    unsigned* bar; unsigned x;
    volatile LAS unsigned* st;
};

__device__ __forceinline__ XcdBarrier xcd_barrier_post(unsigned* bar, volatile LAS unsigned* st) {
    XcdBarrier b; b.bar = bar; b.x = xb_xcc_id(); b.st = st;
    if (threadIdx.x == 0) (void)xb_add(&bar[XB_XCNT(b.x)], 1u);
    return b;
}
__device__ __forceinline__ void xcd_barrier_complete(unsigned* bar, unsigned x_in, unsigned& nloc, unsigned& nx) { unsigned x = x_in;
    const unsigned G = gridDim.x * gridDim.y * gridDim.z;
    asm volatile("" : "+s"(x));
    unsigned sum, cnt, mine, sp = 0u;
    for (;;) {
        sum = 0u; cnt = 0u; mine = 0u;
#pragma unroll
        for (unsigned j = 0; j < 16; ++j) { const unsigned c = xb_ld(&bar[XB_XCNT(j)]); sum += c; cnt += (c > 0u) ? 1u : 0u; mine = (j == x) ? c : mine; }
        if (sum == G) break;
        __builtin_amdgcn_s_sleep(1);
        if ((++sp & 255u) == 0u) { if (xb_ld(&bar[XB_TMO])) break; if (sp > XB_SPIN_CAP) { atomicAdd(&bar[XB_TMO], 1u); break; } }
    }
    nloc = mine > 0u ? mine : 1u; nx = cnt > 0u ? cnt : 1u;
}

__device__ __forceinline__ void xcd_barrier(const XcdBarrier& b, const bool t0  ) {
    asm volatile("s_waitcnt vmcnt(0)" ::: "memory");
    __syncthreads();
    if (t0) {
        unsigned* bar = b.bar;
        __builtin_amdgcn_s_waitcnt(0);
        unsigned nloc = b.st[0], nx = b.st[1];
        if (nloc == 0u) { xcd_barrier_complete(bar, b.x, nloc, nx); b.st[0] = nloc; b.st[1] = nx; }
        const unsigned old = xb_add(&bar[XB_XSUB(b.x)], 1u);
        const unsigned gen = old / nloc;
        if (old + 1u == (gen + 1u) * nloc) {
            __builtin_amdgcn_fence(__ATOMIC_RELEASE, "agent");
            asm volatile("s_waitcnt vmcnt(0)" ::: "memory");
            const unsigned og = xb_add(&bar[XB_TOP], 1u);
            const unsigned tg = og / nx;
            if (og + 1u == (tg + 1u) * nx) xb_add(&bar[XB_TOPGEN], 1u);
            else XB_SPIN(xb_ld(&bar[XB_TOPGEN]) == tg, bar);
            __builtin_amdgcn_fence(__ATOMIC_ACQUIRE, "agent");
            xb_add(&bar[XB_XGEN(b.x)], 1u);
            asm volatile("s_waitcnt vmcnt(0)" ::: "memory");
        } else {
            XB_SPIN(xb_ld(&bar[XB_XGEN(b.x)]) == gen, bar);
            __builtin_amdgcn_fence(__ATOMIC_ACQUIRE, "agent");
            asm volatile("s_waitcnt vmcnt(0)" ::: "memory");
        }
    }
    __syncthreads();
}

typedef unsigned short bf16_t;
typedef short bf16x8 __attribute__((ext_vector_type(8)));
typedef float f32x4 __attribute__((ext_vector_type(4)));
typedef unsigned u32x4 __attribute__((ext_vector_type(4)));
typedef unsigned u32x2 __attribute__((ext_vector_type(2)));
__device__ __forceinline__ float bf2f(bf16_t v) { return __uint_as_float((unsigned)v << 16); }
__device__ __forceinline__ unsigned f2bfu(float f) { unsigned u = __float_as_uint(f); return (u + 0x7fffu + ((u >> 16) & 1u)) >> 16; }
__device__ __forceinline__ bf16_t f2bf(float f) { return (bf16_t)f2bfu(f); }
__device__ __forceinline__ unsigned pk2(float lo, float hi) { return f2bfu(lo) | (f2bfu(hi) << 16); }
__device__ __forceinline__ float sigmoidf_(float x) { return __builtin_amdgcn_rcpf(1.0f + __expf(-x)); }
__device__ __forceinline__ float siluf_(float x) { return x * __builtin_amdgcn_rcpf(1.0f + __expf(-x)); }
template <int CTRL> __device__ __forceinline__ float dppf(float v) { return __int_as_float(__builtin_amdgcn_update_dpp(0, __float_as_int(v), CTRL, 0xf, 0xf, true)); }
__device__ __forceinline__ float allred16(float v) { v += dppf<0xB1>(v); v += dppf<0x4E>(v); v += dppf<0x141>(v); v += dppf<0x140>(v); return v; }
__device__ __forceinline__ float rdlane(float v, int l) { return __int_as_float(__builtin_amdgcn_readlane(__float_as_int(v), l)); }
__device__ __forceinline__ float wave_sum(float v) { v = allred16(v); return (rdlane(v, 0) + rdlane(v, 16)) + (rdlane(v, 32) + rdlane(v, 48)); }
__device__ __forceinline__ void ld8bf(const bf16_t* p, float (&o)[8]) {
    const u32x4 v = *(const u32x4*)p;
#pragma unroll
    for (int i = 0; i < 4; ++i) { o[2 * i] = __uint_as_float(v[i] << 16); o[2 * i + 1] = __uint_as_float(v[i] & 0xffff0000u); }
}
__device__ __forceinline__ void ld4bf(const bf16_t* p, float (&o)[4]) {
    const u32x2 v = *(const u32x2*)p;
#pragma unroll
    for (int i = 0; i < 2; ++i) { o[2 * i] = __uint_as_float(v[i] << 16); o[2 * i + 1] = __uint_as_float(v[i] & 0xffff0000u); }
}

struct EpiG1 {
    static constexpr bool PERM = true, AFTER_DRAIN = false; static constexpr int NST = 16; unsigned char* ws;
    __device__ __forceinline__ void operator()(const f32x4 (&acc)[2][2][4][2], const pg8::Unit& u, int wr, int wc, int fr, int fq) const {
        const int pn = u.pn, row0 = u.pm * 256 + wr * 64 + fr, cin = wc * 32 + 8 * fq;
        if (pn == 56) {
            float* S = (float*)(ws + O_S);
#pragma unroll
            for (int ai = 0; ai < 2; ++ai)
#pragma unroll
                for (int m = 0; m < 4; ++m) { float* rp = S + (size_t)(row0 + ai * 128 + m * 16) * 256 + cin;
#pragma unroll
                    for (int bj = 0; bj < 2; ++bj) { *(f32x4*)(rp + bj * 128) = acc[ai][bj][m][0]; *(f32x4*)(rp + bj * 128 + 4) = acc[ai][bj][m][1]; } }
            return;
        }
        size_t off; int ldc, coff; float sc = 1.f;
        if (pn < 16) { off = O_UA; ldc = 4096; coff = pn * 256; }
        else if (pn < 28) { off = O_UB; ldc = 3072; coff = (pn - 16) * 256; }
        else if (pn < 56) { const int sidx = (pn - 28) >> 2; off = O_GB + (size_t)sidx * (32 * MiB); ldc = 1024; coff = ((pn - 28) & 3) * 256; if (sidx == 1) sc = C2; }
        else { off = O_ML; ldc = 8192; coff = (pn - 57) * 256; }
        bf16_t* base = (bf16_t*)(ws + off) + coff + cin;
#pragma unroll
        for (int ai = 0; ai < 2; ++ai)
#pragma unroll
            for (int m = 0; m < 4; ++m) { bf16_t* rowp = base + (size_t)(row0 + ai * 128 + m * 16) * ldc;
#pragma unroll
                for (int bj = 0; bj < 2; ++bj) { const f32x4 v0 = acc[ai][bj][m][0] * sc, v1 = acc[ai][bj][m][1] * sc; u32x4 w;
                    w.x = pg8::cvt_pk_bf16(v0[0], v0[1]); w.y = pg8::cvt_pk_bf16(v0[2], v0[3]); w.z = pg8::cvt_pk_bf16(v1[0], v1[1]); w.w = pg8::cvt_pk_bf16(v1[2], v1[3]);
                    *(u32x4*)(rowp + bj * 128) = w; } }
    }
};
struct EpiML {
    static constexpr bool PERM = true, AFTER_DRAIN = false; static constexpr int NST = 16; unsigned char* ws;
    __device__ __forceinline__ void operator()(const f32x4 (&acc)[2][2][4][2], const pg8::Unit& u, int wr, int wc, int fr, int fq) const {
        const int row0 = u.pm * 256 + wr * 64 + fr; bf16_t* base = (bf16_t*)(ws + O_ML) + (u.pn + 3) * 256 + wc * 32 + 8 * fq;
#pragma unroll
        for (int ai = 0; ai < 2; ++ai)
#pragma unroll
            for (int m = 0; m < 4; ++m) { bf16_t* rowp = base + (size_t)(row0 + ai * 128 + m * 16) * 8192;
#pragma unroll
                for (int bj = 0; bj < 2; ++bj) { const f32x4 v0 = acc[ai][bj][m][0], v1 = acc[ai][bj][m][1]; u32x4 w;
                    w.x = pg8::cvt_pk_bf16(v0[0], v0[1]); w.y = pg8::cvt_pk_bf16(v0[2], v0[3]); w.z = pg8::cvt_pk_bf16(v1[0], v1[1]); w.w = pg8::cvt_pk_bf16(v1[2], v1[3]);
                    *(u32x4*)(rowp + bj * 128) = w; } }
    }
};
struct PoolOrder {
    int G, c;
    __device__ bool next(int i, pg8::Unit& u) const { const int j = i * G + c; if (j >= 256) return false; u.pm = j; u.pn = j >> 6; return true; }
    __device__ __forceinline__ void a_ready(const pg8::Unit&) const {}
    __device__ __forceinline__ void done(const pg8::Unit&) const {}
};
struct RangeOrder {
    pg8::StaticOrder S; int i0, i1;
    __device__ bool next(int i, pg8::Unit& u) const { return (i0 + i < i1) && S.next(i0 + i, u); }
    __device__ __forceinline__ void a_ready(const pg8::Unit&) const {}
    __device__ __forceinline__ void done(const pg8::Unit&) const {}
};
struct EpiPool {
    static constexpr bool PERM = true, AFTER_DRAIN = false; static constexpr int NST = 16; unsigned char* ws; const float* ps;
    __device__ __forceinline__ void operator()(const f32x4 (&acc)[2][2][4][2], const pg8::Unit& u, int wr, int wc, int fr, int fq) const {
        const int g = u.pn, row0 = (u.pm & 63) * 256 + wr * 64 + fr, col0 = g * 256 + wc * 32 + 8 * fq;
        const bf16_t* GD = (const bf16_t*)(ws + O_GD) + col0; bf16_t* Y = (bf16_t*)(ws + O_Y) + (size_t)3 * T * W + col0; const float* psc = ps + col0;
#pragma unroll
        for (int ai = 0; ai < 2; ++ai)
#pragma unroll
            for (int m = 0; m < 4; ++m) { const size_t row = (size_t)(row0 + ai * 128 + m * 16);
#pragma unroll
                for (int bj = 0; bj < 2; ++bj) { float gd[8]; ld8bf(GD + row * W + bj * 128, gd);
                    const f32x4 p0 = *(const f32x4*)(psc + bj * 128), p1 = *(const f32x4*)(psc + bj * 128 + 4); float o[8];
#pragma unroll
                    for (int e = 0; e < 4; ++e) { o[e] = acc[ai][bj][m][0][e] * p0[e] * siluf_(gd[e]); o[4 + e] = acc[ai][bj][m][1][e] * p1[e] * siluf_(gd[4 + e]); }
                    u32x4 w; w.x = pg8::cvt_pk_bf16(o[0], o[1]); w.y = pg8::cvt_pk_bf16(o[2], o[3]); w.z = pg8::cvt_pk_bf16(o[4], o[5]); w.w = pg8::cvt_pk_bf16(o[6], o[7]);
                    *(u32x4*)(Y + row * W + bj * 128) = w; }
                if (m & 1) asm volatile("" ::: "memory"); }
    }
};
struct EpiG2 {
    static constexpr bool PERM = true, AFTER_DRAIN = false; static constexpr int NST = 16; unsigned char* ws; const float* w0; const float* a0;
    __device__ __forceinline__ void operator()(const f32x4 (&acc)[2][2][4][2], const pg8::Unit& u, int wr, int wc, int fr, int fq) const {
        const int row0 = u.pm * 256 + wr * 64 + fr; const bool dec = u.pn < 4; const int col0 = (u.pn & 3) * 256 + wc * 32 + 8 * fq;
        bf16_t* out = (bf16_t*)(ws + (dec ? O_WDEC : O_ASIG)) + col0; const float* bias = (dec ? w0 : a0) + col0;
        const float mul = dec ? 0.6065306597126334f : 1.0f;
#pragma unroll
        for (int ai = 0; ai < 2; ++ai)
#pragma unroll
            for (int m = 0; m < 4; ++m) { bf16_t* rp = out + (size_t)(row0 + ai * 128 + m * 16) * W;
#pragma unroll
                for (int bj = 0; bj < 2; ++bj) { float o[8]; const f32x4 b0 = *(const f32x4*)(bias + bj * 128), b1 = *(const f32x4*)(bias + bj * 128 + 4);
#pragma unroll
                    for (int e = 0; e < 4; ++e) { o[e] = mul * sigmoidf_(acc[ai][bj][m][0][e] + b0[e]); o[4 + e] = mul * sigmoidf_(acc[ai][bj][m][1][e] + b1[e]); }
                    u32x4 w; w.x = pg8::cvt_pk_bf16(o[0], o[1]); w.y = pg8::cvt_pk_bf16(o[2], o[3]); w.z = pg8::cvt_pk_bf16(o[4], o[5]); w.w = pg8::cvt_pk_bf16(o[6], o[7]);
                    *(u32x4*)(rp + bj * 128) = w; }
                asm volatile("" ::: "memory"); }
    }
};
struct EpiG3Q {
    static constexpr bool PERM = true, AFTER_DRAIN = false; static constexpr int NST = 16; unsigned char* ws; const float* bm; int wg;
    __device__ __forceinline__ void operator()(const f32x4 (&acc)[2][2][4][2], const pg8::Unit& u, int wr, int wc, int fr, int fq) const {
        const int kb = u.pn >> 3, pn = u.pn & 7, pm = u.pm & 63;
        const size_t slab = ((size_t)(wg >> 3) * 3) * (256 * D) + (size_t)(wg & 7) * 256 - ((size_t)pm * 256 * D + (size_t)pn * 256);
        const int row0 = pm * 256 + wr * 64 + fr, col0 = pn * 256 + wc * 32 + 8 * fq;
        const bf16_t* ML = (const bf16_t*)(ws + O_ML) + kb * 2048 + col0; const float* bmk = bm + kb * 2048 + col0;
        f32x4 bv[2][2];
#pragma unroll
        for (int bj = 0; bj < 2; ++bj) { bv[bj][0] = *(const f32x4*)(bmk + bj * 128); bv[bj][1] = *(const f32x4*)(bmk + bj * 128 + 4); }
        if (kb < 3) {
            bf16_t* GP = (bf16_t*)(ws + O_GP) + slab + (size_t)kb * (256 * D) + col0;
#pragma unroll
            for (int ai = 0; ai < 2; ++ai) {
                u32x4 mlv[4][2];
#pragma unroll
                for (int m = 0; m < 4; ++m)
#pragma unroll
                    for (int bj = 0; bj < 2; ++bj) mlv[m][bj] = *(const u32x4*)(ML + (size_t)(row0 + ai * 128 + m * 16) * 8192 + bj * 128);
#pragma unroll
                for (int m = 0; m < 4; ++m) { const size_t row = (size_t)(row0 + ai * 128 + m * 16);
#pragma unroll
                    for (int bj = 0; bj < 2; ++bj) {
                        float ml[8];
#pragma unroll
                        for (int i = 0; i < 4; ++i) { ml[2 * i] = __uint_as_float(mlv[m][bj][i] << 16); ml[2 * i + 1] = __uint_as_float(mlv[m][bj][i] & 0xffff0000u); }
                        f32x4 s0, s1;
#pragma unroll
                        for (int e = 0; e < 4; ++e) { s0[e] = sigmoidf_(ml[e] + bv[bj][0][e]) * acc[ai][bj][m][0][e]; s1[e] = sigmoidf_(ml[4 + e] + bv[bj][1][e]) * acc[ai][bj][m][1][e]; }
                        u32x4 w; w.x = pg8::cvt_pk_bf16(s0[0], s0[1]); w.y = pg8::cvt_pk_bf16(s0[2], s0[3]); w.z = pg8::cvt_pk_bf16(s1[0], s1[1]); w.w = pg8::cvt_pk_bf16(s1[2], s1[3]);
                        *(u32x4*)(GP + row * D + bj * 128) = w;
                    } }
                asm volatile("" ::: "memory"); }
        } else {
            const bf16_t* GP = (const bf16_t*)(ws + O_GP) + slab + col0; bf16_t* MG = (bf16_t*)(ws + O_MG) + col0;
#pragma unroll
            for (int ai = 0; ai < 2; ++ai)
#pragma unroll
                for (int mp = 0; mp < 2; ++mp) {
                    u32x4 mlv[2][2], gp[3][2][2];
#pragma unroll
                    for (int mm = 0; mm < 2; ++mm)
#pragma unroll
                        for (int bj = 0; bj < 2; ++bj) { const size_t row = (size_t)(row0 + ai * 128 + (2 * mp + mm) * 16);
                            mlv[mm][bj] = *(const u32x4*)(ML + row * 8192 + bj * 128);
#pragma unroll
                            for (int k = 0; k < 3; ++k) gp[k][mm][bj] = *(const u32x4*)(GP + (size_t)k * (256 * D) + row * D + bj * 128); }
#pragma unroll
                    for (int mm = 0; mm < 2; ++mm) { const int m = 2 * mp + mm; const size_t row = (size_t)(row0 + ai * 128 + m * 16);
#pragma unroll
                        for (int bj = 0; bj < 2; ++bj) { u32x4 w;
#pragma unroll
                            for (int i = 0; i < 4; ++i) { const int n = i >> 1, e = (i & 1) * 2;
                                float lo = sigmoidf_(__uint_as_float(mlv[mm][bj][i] << 16) + bv[bj][n][e]) * acc[ai][bj][m][n][e], hi = sigmoidf_(__uint_as_float(mlv[mm][bj][i] & 0xffff0000u) + bv[bj][n][e + 1]) * acc[ai][bj][m][n][e + 1];
#pragma unroll
                                for (int k = 0; k < 3; ++k) { lo += __uint_as_float(gp[k][mm][bj][i] << 16); hi += __uint_as_float(gp[k][mm][bj][i] & 0xffff0000u); }
                                w[i] = pg8::cvt_pk_bf16(lo, hi); }
                            *(u32x4*)(MG + row * D + bj * 128) = w; } }
                    asm volatile("" ::: "memory"); }
        }
    }
};
struct BranchOrder {
    pg8::StaticOrder S0;
    __device__ void init(int G, int c) { S0.init(T, D, G, c); }
    __device__ bool next(int i, pg8::Unit& u) const { pg8::Unit t; if (!S0.next(i >> 2, t)) return false; const int kb = i & 3; u.pm = kb * 64 + t.pm; u.pn = kb * 8 + t.pn; return true; }
    __device__ __forceinline__ void a_ready(const pg8::Unit&) const {}
    __device__ __forceinline__ void done(const pg8::Unit&) const {}
};
__device__ __forceinline__ void g3_sum(unsigned char* ws, const BranchOrder& S, int tid) {
    const bf16_t* GP = (const bf16_t*)(ws + O_GP); bf16_t* MG = (bf16_t*)(ws + O_MG);
    pg8::Unit t;
    for (int j = 0; S.S0.next(j, t); ++j)
        for (int i0 = tid; i0 < 256 * 32; i0 += 4 * 512) {
            u32x4 v[4][4];
#pragma unroll
            for (int q = 0; q < 4; ++q) { const int i = i0 + q * 512, r = i >> 5, c8 = (i & 31) * 8; const size_t off = (size_t)(t.pm * 256 + r) * D + t.pn * 256 + c8;
#pragma unroll
                for (int kb = 0; kb < 4; ++kb) v[q][kb] = *(const u32x4*)(GP + (size_t)kb * T * D + off); }
#pragma unroll
            for (int q = 0; q < 4; ++q) { const int i = i0 + q * 512, r = i >> 5, c8 = (i & 31) * 8; const size_t off = (size_t)(t.pm * 256 + r) * D + t.pn * 256 + c8; u32x4 w;
#pragma unroll
                for (int e = 0; e < 4; ++e) { float lo = 0.f, hi = 0.f;
#pragma unroll
                    for (int kb = 0; kb < 4; ++kb) { lo += __uint_as_float(v[q][kb][e] << 16); hi += __uint_as_float(v[q][kb][e] & 0xffff0000u); }
                    w[e] = pk2(lo, hi); }
                *(u32x4*)(MG + off) = w; }
        }
}
struct EpiG4 {
    static constexpr bool PERM = true, AFTER_DRAIN = false; static constexpr int NST = 32; const float* xin32; const bf16_t* xinb; bf16_t* xout;
    __device__ __forceinline__ void operator()(const f32x4 (&acc)[2][2][4][2], const pg8::Unit& u, int wr, int wc, int fr, int fq) const {
        const int row0 = u.pm * 256 + wr * 64 + fr, col0 = u.pn * 256 + wc * 32 + 8 * fq;
        if (xin32) {
#pragma unroll
            for (int q8 = 0; q8 < 4; ++q8) { const int ai = q8 >> 1, m0 = (q8 & 1) * 2;
                f32x4 xv[2][2][2];
#pragma unroll
                for (int mm = 0; mm < 2; ++mm) { const size_t off = (size_t)(row0 + ai * 128 + (m0 + mm) * 16) * D + col0;
#pragma unroll
                    for (int bj = 0; bj < 2; ++bj) { xv[mm][bj][0] = *(const f32x4*)(xin32 + off + bj * 128); xv[mm][bj][1] = *(const f32x4*)(xin32 + off + bj * 128 + 4); } }
#pragma unroll
                for (int mm = 0; mm < 2; ++mm) { const size_t off = (size_t)(row0 + ai * 128 + (m0 + mm) * 16) * D + col0;
#pragma unroll
                    for (int bj = 0; bj < 2; ++bj) { const f32x4 x0 = xv[mm][bj][0] + acc[ai][bj][m0 + mm][0], x1 = xv[mm][bj][1] + acc[ai][bj][m0 + mm][1]; u32x4 w;
                        w.x = pg8::cvt_pk_bf16(x0[0], x0[1]); w.y = pg8::cvt_pk_bf16(x0[2], x0[3]); w.z = pg8::cvt_pk_bf16(x1[0], x1[1]); w.w = pg8::cvt_pk_bf16(x1[2], x1[3]);
                        *(u32x4*)(xout + off + bj * 128) = w; } }
                asm volatile("" ::: "memory"); }
        } else {
#pragma unroll
            for (int ai = 0; ai < 2; ++ai) {
                u32x4 xv[4][2];
#pragma unroll
                for (int m = 0; m < 4; ++m)
#pragma unroll
                    for (int bj = 0; bj < 2; ++bj) xv[m][bj] = *(const u32x4*)(xinb + (size_t)(row0 + ai * 128 + m * 16) * D + col0 + bj * 128);
#pragma unroll
                for (int m = 0; m < 4; ++m) { const size_t off = (size_t)(row0 + ai * 128 + m * 16) * D + col0;
#pragma unroll
                    for (int bj = 0; bj < 2; ++bj) { u32x4 w;
#pragma unroll
                        for (int i = 0; i < 4; ++i) { const int n = i >> 1, e = (i & 1) * 2;
                            const float lo = __uint_as_float(xv[m][bj][i] << 16) + acc[ai][bj][m][n][e], hi = __uint_as_float(xv[m][bj][i] & 0xffff0000u) + acc[ai][bj][m][n][e + 1];
                            w[i] = pg8::cvt_pk_bf16(lo, hi); }
                        *(u32x4*)(xout + off + bj * 128) = w; } }
                asm volatile("" ::: "memory"); }
        }
    }
};
__device__ __forceinline__ int win_col(int n) {
    if (n < PGB) return n;
    if (n < PQ) return OBG + (n - PGB);
    if (n < PGC) return OCQ + (n - PQ);
    if (n < PUD) return OCG + (n - PGC);
    if (n < PGD) return ODI + (n - PUD);
    if (n < PS) return ODG + (n - PGD);
    if (n < PML) { const int j = n - PS; if (j < 64) return OWL + j; if (j < 128) return OAL + (j - 64); if (j < 144) return OCF + (j - 128); return -1; }
    return OML + (n - PML);
}
__device__ __forceinline__ void p1_weights(const Params& p, LAS unsigned char* lds, int gw, int ngw, int wave, int lane, size_t gt, size_t ngt) {
    LAS float* scr = (LAS float*)(lds + wave * 9216);
    constexpr int I0 = 4 * (NP / 32) * (D / 64), I1 = 16 * (D / 32) * (W / 64), I2 = 4 * (D / 32) * (D / 64), I3 = 16 * (256 / 32) * (256 / 64);
    for (int it = gw; it < I0 + I1 + I2 + I3; it += ngw) {
        int mode, r = it; if (r < I0) mode = 0; else if (r < I0 + I1) { mode = 1; r -= I0; } else if (r < I0 + I1 + I2) { mode = 2; r -= I0 + I1; } else { mode = 3; r -= I0 + I1 + I2; }
        const int N = (mode == 0) ? NP : (mode == 3 ? 256 : D), K = (mode == 1) ? W : (mode == 3 ? 256 : D), nb = N / 32, per = nb * (K / 64);
        const int mat = r / per, q = r % per, n0 = (q % nb) * 32, k0 = (q / nb) * 64, n4 = (lane & 7) * 4, kr = lane >> 3;
        const float* src; long ld; bf16_t* dst; int col;
        if (mode == 0) { col = win_col(n0 + n4); src = p.in[I_WIN] + (size_t)mat * D * NIN; ld = NIN; dst = (bf16_t*)(p.ws + O_WTIN) + (size_t)mat * NP * D; }
        else if (mode == 1) { src = p.in[I_WB] + (size_t)mat * W * D; ld = D; col = n0 + n4; dst = (bf16_t*)(p.ws + O_WTBR) + (size_t)mat * D * W; }
        else if (mode == 2) { src = p.in[I_WO] + (size_t)mat * D * D; ld = D; col = n0 + n4; dst = (bf16_t*)(p.ws + O_WTOUT) + (size_t)mat * D * D; }
        else { src = p.in[I_PW] + (size_t)mat * 65536; ld = 256; col = n0 + n4; dst = (bf16_t*)(p.ws + O_WD) + (size_t)mat * 65536; }
#pragma unroll
        for (int i = 0; i < 8; ++i) { const int kk = 8 * i + kr; const f32x4 v = (col >= 0) ? *(const f32x4*)(src + (size_t)(k0 + kk) * ld + col) : (f32x4){0.f, 0.f, 0.f, 0.f}; *(LAS f32x4*)(scr + kk * 36 + n4) = v; }
        asm volatile("s_waitcnt lgkmcnt(0)" ::: "memory");
        const int c = lane & 7;
#pragma unroll
        for (int j = 0; j < 4; ++j) { const int n = (lane >> 3) + 8 * j; const LAS float* sp = scr + (8 * c) * 36 + n; u32x4 o;
            o.x = pk2(sp[0 * 36], sp[1 * 36]); o.y = pk2(sp[2 * 36], sp[3 * 36]); o.z = pk2(sp[4 * 36], sp[5 * 36]); o.w = pk2(sp[6 * 36], sp[7 * 36]);
            *(u32x4*)(dst + (size_t)(n0 + n) * K + k0 + 8 * c) = o; }
        asm volatile("s_waitcnt lgkmcnt(0)" ::: "memory");
    }
    for (int it = gw; it < 4 * 2 * 16; it += ngw) {
        const int l = it >> 5, tb = (it >> 4) & 1, n = (it & 15) * 64 + lane;
        const float* src = (tb ? p.in[I_A2] : p.in[I_W2]) + (size_t)l * 64 * W + n;
        float v[64];
#pragma unroll
        for (int k = 0; k < 64; ++k) v[k] = src[(size_t)k * W];
        bf16_t* dst = (bf16_t*)(p.ws + O_WTLORA) + ((size_t)l * 2048 + tb * 1024 + n) * 256;
        const u32x4 z = {0u, 0u, 0u, 0u}; const int jb = tb * 8;
#pragma unroll
        for (int j = 0; j < 32; ++j) if (j < jb || j >= jb + 8) *(u32x4*)(dst + 8 * j) = z;
#pragma unroll
        for (int jj = 0; jj < 8; ++jj) { u32x4 o; o.x = pk2(v[8 * jj], v[8 * jj + 1]); o.y = pk2(v[8 * jj + 2], v[8 * jj + 3]); o.z = pk2(v[8 * jj + 4], v[8 * jj + 5]); o.w = pk2(v[8 * jj + 6], v[8 * jj + 7]);
            *(u32x4*)(dst + 8 * (jb + jj)) = o; }
    }
}
__device__ __forceinline__ void e_rmsnorm(const float* __restrict__ x, const float* __restrict__ g, bf16_t* __restrict__ h, float* __restrict__ outf, int gw, int ngw, int lane, int rend = T) {
    for (int m0 = gw; m0 < rend; m0 += 2 * ngw) {
        const int m1 = (m0 + ngw < rend) ? m0 + ngw : m0;
        const f32x4* xr0 = (const f32x4*)(x + (size_t)m0 * D); const f32x4* xr1 = (const f32x4*)(x + (size_t)m1 * D);
        f32x4 v0[8], v1[8]; float ss0 = 0.f, ss1 = 0.f;
#pragma unroll
        for (int j = 0; j < 8; ++j) { v0[j] = xr0[lane + 64 * j]; v1[j] = xr1[lane + 64 * j]; }
#pragma unroll
        for (int j = 0; j < 8; ++j) { ss0 += (v0[j].x * v0[j].x + v0[j].y * v0[j].y) + (v0[j].z * v0[j].z + v0[j].w * v0[j].w); ss1 += (v1[j].x * v1[j].x + v1[j].y * v1[j].y) + (v1[j].z * v1[j].z + v1[j].w * v1[j].w); }
        ss0 = wave_sum(ss0); ss1 = wave_sum(ss1);
        const float rs0 = rsqrtf(ss0 * (1.0f / D) + 1e-6f), rs1 = rsqrtf(ss1 * (1.0f / D) + 1e-6f);
#pragma unroll
        for (int j = 0; j < 8; ++j) {
            const f32x4 gg = ((const f32x4*)g)[lane + 64 * j];
            const f32x4 o0 = v0[j] * rs0 * gg, o1 = v1[j] * rs1 * gg;
            if (h) { u32x2 w; w.x = pk2(o0.x, o0.y); w.y = pk2(o0.z, o0.w); *(u32x2*)(h + (size_t)m0 * D + (lane + 64 * j) * 4) = w;
                     if (m1 != m0) { w.x = pk2(o1.x, o1.y); w.y = pk2(o1.z, o1.w); *(u32x2*)(h + (size_t)m1 * D + (lane + 64 * j) * 4) = w; } }
            else { ((f32x4*)(outf + (size_t)m0 * D))[lane + 64 * j] = o0; if (m1 != m0) ((f32x4*)(outf + (size_t)m1 * D))[lane + 64 * j] = o1; }
        }
    }
}
__device__ __forceinline__ void e_rmsnorm_bf(const bf16_t* __restrict__ x, const float* __restrict__ g, bf16_t* __restrict__ h, float* __restrict__ outf, int gw, int ngw, int lane, int rend = T) {
    for (int m0 = gw; m0 < rend; m0 += 2 * ngw) {
        const int m1 = (m0 + ngw < rend) ? m0 + ngw : m0;
        const u32x4* xr0 = (const u32x4*)(x + (size_t)m0 * D); const u32x4* xr1 = (const u32x4*)(x + (size_t)m1 * D);
        u32x4 r0[4], r1[4]; float v0[4][8], v1[4][8], ss0 = 0.f, ss1 = 0.f;
#pragma unroll
        for (int j = 0; j < 4; ++j) { r0[j] = xr0[lane + 64 * j]; r1[j] = xr1[lane + 64 * j]; }
#pragma unroll
        for (int j = 0; j < 4; ++j)
#pragma unroll
            for (int i = 0; i < 4; ++i) { v0[j][2 * i] = __uint_as_float(r0[j][i] << 16); v0[j][2 * i + 1] = __uint_as_float(r0[j][i] & 0xffff0000u); v1[j][2 * i] = __uint_as_float(r1[j][i] << 16); v1[j][2 * i + 1] = __uint_as_float(r1[j][i] & 0xffff0000u);
                ss0 += v0[j][2 * i] * v0[j][2 * i] + v0[j][2 * i + 1] * v0[j][2 * i + 1]; ss1 += v1[j][2 * i] * v1[j][2 * i] + v1[j][2 * i + 1] * v1[j][2 * i + 1]; }
        ss0 = wave_sum(ss0); ss1 = wave_sum(ss1);
        const float rs0 = rsqrtf(ss0 * (1.0f / D) + 1e-6f), rs1 = rsqrtf(ss1 * (1.0f / D) + 1e-6f);
#pragma unroll
        for (int j = 0; j < 4; ++j) {
            const f32x4 ga = *(const f32x4*)(g + (lane + 64 * j) * 8), gb = *(const f32x4*)(g + (lane + 64 * j) * 8 + 4);
            float o0[8], o1[8];
#pragma unroll
            for (int e = 0; e < 4; ++e) { o0[e] = v0[j][e] * rs0 * ga[e]; o0[4 + e] = v0[j][4 + e] * rs0 * gb[e]; o1[e] = v1[j][e] * rs1 * ga[e]; o1[4 + e] = v1[j][4 + e] * rs1 * gb[e]; }
            if (h) { u32x4 w; w.x = pk2(o0[0], o0[1]); w.y = pk2(o0[2], o0[3]); w.z = pk2(o0[4], o0[5]); w.w = pk2(o0[6], o0[7]); *(u32x4*)(h + (size_t)m0 * D + (lane + 64 * j) * 8) = w;
                     if (m1 != m0) { w.x = pk2(o1[0], o1[1]); w.y = pk2(o1[2], o1[3]); w.z = pk2(o1[4], o1[5]); w.w = pk2(o1[6], o1[7]); *(u32x4*)(h + (size_t)m1 * D + (lane + 64 * j) * 8) = w; } }
            else { float* p0 = outf + (size_t)m0 * D + (lane + 64 * j) * 8; *(f32x4*)p0 = (f32x4){o0[0], o0[1], o0[2], o0[3]}; *(f32x4*)(p0 + 4) = (f32x4){o0[4], o0[5], o0[6], o0[7]};
                   if (m1 != m0) { float* p1 = outf + (size_t)m1 * D + (lane + 64 * j) * 8; *(f32x4*)p1 = (f32x4){o1[0], o1[1], o1[2], o1[3]}; *(f32x4*)(p1 + 4) = (f32x4){o1[4], o1[5], o1[6], o1[7]}; } }
        }
    }
}
__device__ __forceinline__ void e1_conv(const bf16_t* __restrict__ UA, bf16_t* __restrict__ Y, const float* __restrict__ cw, size_t gt, size_t ngt) {
    for (size_t it = gt; it < (size_t)(T / 4) * 128; it += ngt) {
        const int t0 = (int)(it >> 7) * 4, c = (int)(it & 127) * 8, s0 = t0 & (SEQ - 1);
        float w0[8], w1[8], w2[8], cm2[8], cm1[8], a[8], b2[8];
#pragma unroll
        for (int i = 0; i < 8; ++i) { w0[i] = cw[c + i]; w1[i] = cw[W + c + i]; w2[i] = cw[2 * W + c + i]; cm2[i] = 0.f; cm1[i] = 0.f; }
        u32x4 vb[4], vg[4], va[4], vx[4];
#pragma unroll
        for (int j = 0; j < 4; ++j) { const size_t t = (size_t)(t0 + j); vb[j] = *(const u32x4*)(UA + t * 4096 + c); vg[j] = *(const u32x4*)(UA + t * 4096 + 3072 + c); va[j] = *(const u32x4*)(UA + t * 4096 + 1024 + c); vx[j] = *(const u32x4*)(UA + t * 4096 + 2048 + c); }
        if (s0 > 0) {
            ld8bf(UA + (size_t)(t0 - 2) * 4096 + 1024 + c, a); ld8bf(UA + (size_t)(t0 - 2) * 4096 + 2048 + c, b2);
#pragma unroll
            for (int i = 0; i < 8; ++i) cm2[i] = a[i] * b2[i];
            ld8bf(UA + (size_t)(t0 - 1) * 4096 + 1024 + c, a); ld8bf(UA + (size_t)(t0 - 1) * 4096 + 2048 + c, b2);
#pragma unroll
            for (int i = 0; i < 8; ++i) cm1[i] = a[i] * b2[i];
        }
#pragma unroll
        for (int j = 0; j < 4; ++j) {
            const size_t t = (size_t)(t0 + j);
            float bg[8], g[8], cx[8];
#pragma unroll
            for (int i = 0; i < 4; ++i) { bg[2 * i] = __uint_as_float(vb[j][i] << 16); bg[2 * i + 1] = __uint_as_float(vb[j][i] & 0xffff0000u); g[2 * i] = __uint_as_float(vg[j][i] << 16); g[2 * i + 1] = __uint_as_float(vg[j][i] & 0xffff0000u);
                a[2 * i] = __uint_as_float(va[j][i] << 16); a[2 * i + 1] = __uint_as_float(va[j][i] & 0xffff0000u); b2[2 * i] = __uint_as_float(vx[j][i] << 16); b2[2 * i + 1] = __uint_as_float(vx[j][i] & 0xffff0000u); }
            u32x4 o; float z[8];
#pragma unroll
            for (int i = 0; i < 8; ++i) { cx[i] = a[i] * b2[i]; z[i] = (w0[i] * cm2[i] + w1[i] * cm1[i] + w2[i] * cx[i]) * bg[i] * siluf_(g[i]); cm2[i] = cm1[i]; cm1[i] = cx[i]; }
#pragma unroll
            for (int i = 0; i < 4; ++i) o[i] = pk2(z[2 * i], z[2 * i + 1]);
            *(u32x4*)(Y + t * W + c) = o;
        }
    }
}
__device__ __forceinline__ void e1_pool(const bf16_t* __restrict__ UD, bf16_t* __restrict__ PG, size_t gt, size_t ngt) {
    for (size_t it = gt; it < (size_t)(T / 16) * 128; it += ngt) {
        const int t0 = (int)(it >> 7) * 16, c = (int)(it & 127) * 8, s0 = t0 & (SEQ - 1);
        const int win = 2 << (c >> 8);
        float sum[8], tmp[8], cur[8];
#pragma unroll
        for (int i = 0; i < 8; ++i) sum[i] = 0.f;
        u32x4 cv[16];
#pragma unroll
        for (int j = 0; j < 16; ++j) cv[j] = *(const u32x4*)(UD + (size_t)(t0 + j) * W + c);
        if (s0 > 0) {
#pragma unroll
            for (int j = 1; j < 16; ++j) if (j < win) { ld8bf(UD + (size_t)(t0 - j) * W + c, tmp);
#pragma unroll
                for (int i = 0; i < 8; ++i) sum[i] += tmp[i]; } }
        bf16_t* dst = PG + ((size_t)(c >> 8) * T + t0) * 256 + (c & 255);
#pragma unroll
        for (int j = 0; j < 16; ++j) {
            const int s = s0 + j;
#pragma unroll
            for (int i = 0; i < 4; ++i) { cur[2 * i] = __uint_as_float(cv[j][i] << 16); cur[2 * i + 1] = __uint_as_float(cv[j][i] & 0xffff0000u); }
#pragma unroll
            for (int i = 0; i < 8; ++i) sum[i] += cur[i];
            const int cnt = (s + 1 < win) ? s + 1 : win; const float inv = 1.0f / (float)cnt;
            u32x4 o;
#pragma unroll
            for (int i = 0; i < 4; ++i) o[i] = pk2(sum[2 * i] * inv - cur[2 * i], sum[2 * i + 1] * inv - cur[2 * i + 1]);
            *(u32x4*)(dst + (size_t)j * 256) = o;
            if (s + 1 >= win) {
                ld8bf(UD + ((size_t)(t0 + j) + 1 - win) * W + c, tmp);
#pragma unroll
                for (int i = 0; i < 8; ++i) sum[i] -= tmp[i]; }
        }
    }
}
__device__ __forceinline__ void e1_lora(const float* __restrict__ S, bf16_t* __restrict__ LA, float* __restrict__ LF, const float* __restrict__ mu, const float* __restrict__ bf, size_t gt, size_t ngt) {
#pragma unroll 4
    for (size_t it = gt; it < (size_t)T * 64; it += ngt) {
        const int t = (int)(it >> 6), j = (int)(it & 63) * 4, s = t & (SEQ - 1);
        f32x4 o = {0.f, 0.f, 0.f, 0.f};
        if (j < 128) {
            const f32x4 cur = *(const f32x4*)(S + (size_t)t * 256 + j), prv = (s > 0) ? *(const f32x4*)(S + (size_t)(t - 1) * 256 + j) : (f32x4){0.f, 0.f, 0.f, 0.f}, m4 = *(const f32x4*)(mu + j);
#pragma unroll
            for (int e = 0; e < 4; ++e) { const float xm = cur[e] + (prv[e] - cur[e]) * m4[e]; o[e] = (j < 64) ? (1.0f - 2.0f * __builtin_amdgcn_rcpf(__expf(2.0f * xm) + 1.0f)) : xm; }
        } else if (j < 144) {
            const f32x4 x4 = *(const f32x4*)(S + (size_t)t * 256 + j) + *(const f32x4*)(bf + (j - 128)); f32x4 lf;
#pragma unroll
            for (int e = 0; e < 4; ++e) lf[e] = fminf(x4[e], 0.f) - __logf(1.0f + __expf(-fabsf(x4[e])));
            *(f32x4*)(LF + (size_t)t * 16 + (j - 128)) = lf;
        }
        u32x2 w; w.x = pk2(o[0], o[1]); w.y = pk2(o[2], o[3]);
        *(u32x2*)(LA + (size_t)t * 256 + j) = w;
    }
}
__device__ __forceinline__ void e1_phase(const Params& p, int l, size_t gt, size_t ngt, int gw, int ngw, int lane) {
    unsigned char* ws = p.ws;
    e1_lora((const float*)(ws + O_S), (bf16_t*)(ws + O_LA), (float*)(ws + O_LF), p.in[I_MU] + (size_t)l * 3200 + 3072, p.in[I_BF] + (size_t)l * 16, gt, ngt);
}
__device__ __forceinline__ void e_cumsum_wg(const Params& p, int l, int bh, int wave, int lane, volatile LAS float* wsum) {
    const int b = bh >> 4, h = bh & 15;
    const float* SF = (const float*)(p.ws + O_S) + ((size_t)b * SEQ) * 256 + 128 + h; float* CB = (float*)(p.ws + O_CB) + (size_t)bh * SEQ; const float bfh = p.in[I_BF][(size_t)l * 16 + h];
    const int s0 = (wave * 64 + lane) * 16;
    float v[16], loc = 0.f;
#pragma unroll
    for (int i = 0; i < 16; ++i) { const float x = SF[(size_t)(s0 + i) * 256] + bfh; v[i] = fminf(x, 0.f) - __logf(1.0f + __expf(-fabsf(x))); }
#pragma unroll
    for (int i = 0; i < 16; ++i) loc += v[i];
    float inc = loc;
#pragma unroll
    for (int o = 1; o < 64; o <<= 1) { const float n = __int_as_float(__builtin_amdgcn_ds_bpermute(((lane >= o) ? lane - o : lane) << 2, __float_as_int(inc))); if (lane >= o) inc += n; }
    if (lane == 63) wsum[wave] = inc;
    asm volatile("s_waitcnt lgkmcnt(0)" ::: "memory"); __builtin_amdgcn_s_barrier(); asm volatile("" ::: "memory");
    float run = inc - loc;
#pragma unroll
    for (int w = 0; w < 7; ++w) run += (w < wave) ? wsum[w] : 0.f;
#pragma unroll
    for (int i = 0; i < 4; ++i) { f32x4 o;
#pragma unroll
        for (int e = 0; e < 4; ++e) { run += v[4 * i + e]; o[e] = run * LOG2E; }
        *(f32x4*)(CB + s0 + 4 * i) = o; }
}
constexpr int LDS_LA = 131072 + 8192;
constexpr int CB_APT = 0, CB_RTT = 2048, CB_G1T = 4096, CB_ARBT = 4608, CB_ARKT = 5120, CB_WC = 5632, CB_BB = 6144, CB_KB = 8192, CB_VT = 10240, CB_BYTES = 12288;
constexpr int GRP = 36;
constexpr int EL_X = 0, EL_Y = 4608, EL_ATT = 9216, EL_GR = 11264, EL_TM = 0, EL_G1 = 1088, EL_BYTES = 16384;
__device__ __forceinline__ unsigned pkbf(float lo, float hi) { return pg8::cvt_pk_bf16(lo, hi); }
__device__ __forceinline__ void e2c_phase(const Params& p, int l, LAS unsigned char* lds, int bx, int wave, int lane) {
    unsigned char* ws = p.ws;
    const bf16_t* UB = (const bf16_t*)(ws + O_UB); const bf16_t* WTL = (const bf16_t*)(ws + O_WTLORA) + (size_t)l * 2048 * 256;
    const float* w0p = p.in[I_W0] + (size_t)l * W; const float* a0p = p.in[I_A0] + (size_t)l * W;
    unsigned char* BLOB = ws + O_SCN; float* BON = (float*)(ws + O_VS);
    const float* mu = p.in[I_MU] + (size_t)l * 3200; const float* kkp = p.in[I_KK] + (size_t)l * W; const float* kap = p.in[I_KA] + (size_t)l * W;
    LAS unsigned char* L = lds + wave * EL_BYTES;
    const int r32 = lane & 31, hh = lane >> 5, l16 = lane & 15, rg = lane >> 4;
    for (int k_ = 0; k_ < 8; ++k_) {
        const int jr = k_ >> 1, cr = bx * 4 + jr, b = cr >> 9, c = cr & 511, h = wave * 2 + (k_ & 1), bh = b * 16 + h, ch = h * 64 + lane;
        const size_t tok0 = (size_t)b * SEQ + c * 16;
        const float mr = mu[ch], mk = mu[1024 + ch], mv = mu[2048 + ch], kkc = kkp[ch], kac = kap[ch], rkc = p.in[I_RK][(size_t)l * W + ch];
        float pr = 0.f, pk = 0.f, pv = 0.f;
        if (c > 0) { pr = bf2f(UB[(tok0 - 1) * 3072 + ch]); pk = bf2f(UB[(tok0 - 1) * 3072 + 1024 + ch]); pv = bf2f(UB[(tok0 - 1) * 3072 + 2048 + ch]); }
        float At[16], Rt[16], Bh[16], Kh[16], Vv[16];
        float Wc = 1.0f;
        float wdv[16], asv[16];
        { attn_body::f32x16 xw0 = attn_body::f32x16{}, xw1 = xw0, xa0 = xw0, xa1 = xw0;
          const int arow = jr * 16 + (lane & 15); const LAS unsigned char* ap = lds + LDS_LA + arow * 256; const bf16_t* bw = WTL + (size_t)(h * 64 + r32) * 256 + hh * 8; const bf16_t* ba = bw + (size_t)1024 * 256 + 64;
#pragma unroll
          for (int ks = 0; ks < 4; ++ks) {
              u32x4 aw = {0u, 0u, 0u, 0u}, aa = {0u, 0u, 0u, 0u};
              if (r32 < 16) { aw = *(const LAS u32x4*)(ap + (((ks * 2 + hh) ^ (arow & 15)) * 16)); aa = *(const LAS u32x4*)(ap + (((8 + ks * 2 + hh) ^ (arow & 15)) * 16)); }
              const bf16x8 fw = __builtin_bit_cast(bf16x8, aw), fa = __builtin_bit_cast(bf16x8, aa);
              xw0 = __builtin_amdgcn_mfma_f32_32x32x16_bf16(fw, *(const bf16x8*)(bw + ks * 16), xw0, 0, 0, 0);
              xw1 = __builtin_amdgcn_mfma_f32_32x32x16_bf16(fw, *(const bf16x8*)(bw + 32 * 256 + ks * 16), xw1, 0, 0, 0);
              xa0 = __builtin_amdgcn_mfma_f32_32x32x16_bf16(fa, *(const bf16x8*)(ba + ks * 16), xa0, 0, 0, 0);
              xa1 = __builtin_amdgcn_mfma_f32_32x32x16_bf16(fa, *(const bf16x8*)(ba + 32 * 256 + ks * 16), xa1, 0, 0, 0);
          }
          const float w0c = w0p[ch], a0c = a0p[ch];
#pragma unroll
          for (int r = 0; r < 8; ++r) { const int t = (r & 3) + 8 * (r >> 2);
              auto rw = __builtin_amdgcn_permlane32_swap(__float_as_uint(xw0[r]), __float_as_uint(xw1[r]), false, false);
              auto ra = __builtin_amdgcn_permlane32_swap(__float_as_uint(xa0[r]), __float_as_uint(xa1[r]), false, false);
              wdv[t] = __builtin_amdgcn_exp2f(-0.6065306597126334f * LOG2E * sigmoidf_(__builtin_bit_cast(float, (unsigned)rw[0]) + w0c));
              wdv[t + 4] = __builtin_amdgcn_exp2f(-0.6065306597126334f * LOG2E * sigmoidf_(__builtin_bit_cast(float, (unsigned)rw[1]) + w0c));
              asv[t] = sigmoidf_(__builtin_bit_cast(float, (unsigned)ra[0]) + a0c); asv[t + 4] = sigmoidf_(__builtin_bit_cast(float, (unsigned)ra[1]) + a0c); }
        }
        float invn_l;
        { LAS float* PT = (LAS float*)(L + EL_X); float pk2_ = pk;
#pragma unroll
          for (int t = 0; t < 16; ++t) { const float ck = bf2f(UB[(tok0 + t) * 3072 + 1024 + ch]); const float kr = (ck + (pk2_ - ck) * mk) * kkc; pk2_ = ck; PT[t * 68 + lane] = kr * kr; }
          asm volatile("s_waitcnt lgkmcnt(0)" ::: "memory");
          const LAS float* pr_ = PT + l16 * 68 + rg * 16; float n2 = 0.f;
#pragma unroll
          for (int i = 0; i < 4; ++i) { const f32x4 q4 = *(const LAS f32x4*)(pr_ + 4 * i); n2 += (q4[0] + q4[1]) + (q4[2] + q4[3]); }
          n2 += __builtin_bit_cast(float, __builtin_amdgcn_ds_swizzle(__builtin_bit_cast(int, n2), 0x401F));
          { const unsigned ub_ = __float_as_uint(n2); auto rr = __builtin_amdgcn_permlane32_swap(ub_, ub_, false, false); n2 = __uint_as_float(rr[0]) + __uint_as_float(rr[1]); }
          invn_l = 1.0f / fmaxf(sqrtf(n2), 1e-12f);
          asm volatile("s_waitcnt lgkmcnt(0)" ::: "memory"); }
#pragma unroll
        for (int t = 0; t < 16; ++t) {
            const size_t tok = tok0 + t;
            const float cr = bf2f(UB[tok * 3072 + ch]), ck = bf2f(UB[tok * 3072 + 1024 + ch]), cv = bf2f(UB[tok * 3072 + 2048 + ch]);
            const float wd = wdv[t], as = asv[t];
            const float r = cr + (pr - cr) * mr, k = ck + (pk - ck) * mk, v = cv + (pv - cv) * mv;
            pr = cr; pk = ck; pv = cv;
            const float kkr = k * kkc, k2 = k * (1.0f + (as - 1.0f) * kac);
            const float kk = kkr * rdlane(invn_l, t);
            const float Wprev = Wc; Wc *= wd; const float iW = __builtin_amdgcn_rcpf(Wc);
            At[t] = -kk * Wprev; Rt[t] = r * Wc; Bh[t] = kk * as * iW; Kh[t] = k2 * iW; Vv[t] = v; ((LAS float*)(L + EL_X))[t * 68 + lane] = r * k2 * rkc;
        }
        { LAS float* PT = (LAS float*)(L + EL_X);
          asm volatile("s_waitcnt lgkmcnt(0)" ::: "memory");
          const LAS float* pr_ = PT + l16 * 68 + rg * 16; float bs = 0.f;
#pragma unroll
          for (int i = 0; i < 4; ++i) { const f32x4 q4 = *(const LAS f32x4*)(pr_ + 4 * i); bs += (q4[0] + q4[1]) + (q4[2] + q4[3]); }
          bs += __builtin_bit_cast(float, __builtin_amdgcn_ds_swizzle(__builtin_bit_cast(int, bs), 0x401F));
          { const unsigned ub_ = __builtin_bit_cast(unsigned, bs); auto rr = __builtin_amdgcn_permlane32_swap(ub_, ub_, false, false); bs = __builtin_bit_cast(float, (unsigned)rr[0]) + __builtin_bit_cast(float, (unsigned)rr[1]); }
          if (lane < 16) BON[(tok0 + lane) * 16 + h] = bs;
          asm volatile("s_waitcnt lgkmcnt(0)" ::: "memory"); }
        { LAS bf16_t* X = (LAS bf16_t*)(L + EL_X); LAS bf16_t* Y = (LAS bf16_t*)(L + EL_Y);
#pragma unroll
          for (int t = 0; t < 16; ++t) { const unsigned ux = pkbf(Bh[t], Kh[t]), uy = pkbf(At[t], Rt[t]);
              X[t * 72 + lane] = (bf16_t)(ux & 0xffffu); X[(16 + t) * 72 + lane] = (bf16_t)(ux >> 16); Y[t * 72 + lane] = (bf16_t)(uy & 0xffffu); Y[(16 + t) * 72 + lane] = (bf16_t)(uy >> 16); }
          u32x4 w0, w1;
#pragma unroll
          for (int i = 0; i < 4; ++i) { w0[i] = pkbf(At[2 * i], At[2 * i + 1]); w1[i] = pkbf(At[8 + 2 * i], At[8 + 2 * i + 1]); }
          *(LAS u32x4*)(L + EL_ATT + lane * 32) = w0; *(LAS u32x4*)(L + EL_ATT + lane * 32 + 16) = w1; }
        asm volatile("s_waitcnt lgkmcnt(0)" ::: "memory");
        attn_body::f32x16 gram = attn_body::f32x16{};
#pragma unroll
        for (int s4 = 0; s4 < 4; ++s4) {
            const bf16x8 fa = *(const LAS bf16x8*)(L + EL_X + r32 * 144 + s4 * 32 + hh * 16), fb = *(const LAS bf16x8*)(L + EL_Y + r32 * 144 + s4 * 32 + hh * 16);
            gram = __builtin_amdgcn_mfma_f32_32x32x16_bf16(fa, fb, gram, 0, 0, 0);
        }
        { LAS float* GR = (LAS float*)(L + EL_GR);
#pragma unroll
          for (int i = 0; i < 16; ++i) GR[((i & 3) + 8 * (i >> 2) + 4 * hh) * GRP + r32] = gram[i]; }
        asm volatile("s_waitcnt lgkmcnt(0)" ::: "memory");
        { const LAS float* GR = (const LAS float*)(L + EL_GR); float x[16];
          int l16o = l16; asm volatile("" : "+v"(l16o));
#pragma unroll
          for (int t = 0; t < 16; ++t) x[t] = (l16o == t) ? 1.0f : 0.f;
#pragma unroll
          for (int s_ = 0; s_ < 15; ++s_) { f32x4 n4[4];
#pragma unroll
              for (int g = (s_ + 1) >> 2; g < 4; ++g) n4[g] = *(const LAS f32x4*)(GR + s_ * GRP + 4 * g);
              if ((s_ & 1) == 1) asm volatile("" ::: "memory");
#pragma unroll
              for (int g = (s_ + 1) >> 2; g < 4; ++g)
#pragma unroll
                  for (int e = 0; e < 4; ++e) if (4 * g + e > s_) x[4 * g + e] += x[s_] * n4[g][e]; }
          asm volatile("s_waitcnt lgkmcnt(0)" ::: "memory");
          LAS float* TM = (LAS float*)(L + EL_TM);
          if (rg == 0) {
#pragma unroll
              for (int t = 0; t < 16; ++t) TM[l16 * 17 + t] = x[t]; } }
        asm volatile("s_waitcnt lgkmcnt(0)" ::: "memory");
        attn_body::f32x16 ap0, ap1, g1;
        { const LAS float* TM = (const LAS float*)(L + EL_TM); const LAS float* GR = (const LAS float*)(L + EL_GR);
          u32x4 tb, ga;
#pragma unroll
          for (int i = 0; i < 4; ++i) {
              const float t0 = (r32 < 16) ? TM[(8 * hh + 2 * i) * 17 + r32] : 0.f, t1 = (r32 < 16) ? TM[(8 * hh + 2 * i + 1) * 17 + r32] : 0.f; tb[i] = pkbf(t0, t1);
              const int s0 = 8 * hh + 2 * i, s1 = s0 + 1;
              const float a0 = (r32 < 16 && r32 < s0) ? GR[(16 + r32) * GRP + s0] : 0.f, a1 = (r32 < 16 && r32 < s1) ? GR[(16 + r32) * GRP + s1] : 0.f; ga[i] = pkbf(a0, a1); }
          const bf16x8 ftm = __builtin_bit_cast(bf16x8, tb);
          const bf16x8 fa0 = *(const LAS bf16x8*)(L + EL_ATT + r32 * 32 + hh * 16), fa1 = *(const LAS bf16x8*)(L + EL_ATT + (32 + r32) * 32 + hh * 16);
          const attn_body::f32x16 z16 = attn_body::f32x16{};
          ap0 = __builtin_amdgcn_mfma_f32_32x32x16_bf16(fa0, ftm, z16, 0, 0, 0);
          ap1 = __builtin_amdgcn_mfma_f32_32x32x16_bf16(fa1, ftm, z16, 0, 0, 0);
          g1 = __builtin_amdgcn_mfma_f32_32x32x16_bf16(__builtin_bit_cast(bf16x8, ga), ftm, z16, 0, 0, 0);
          LAS float* G1L = (LAS float*)(L + EL_G1);
          if (r32 < 16) {
#pragma unroll
              for (int i = 0; i < 8; ++i) G1L[((i & 3) + 8 * (i >> 2) + 4 * hh) * 17 + r32] = g1[i]; } }
        asm volatile("s_waitcnt lgkmcnt(0)" ::: "memory");
        unsigned char* out = BLOB + ((size_t)(bh >> 1) * 512 + c) * (2 * CB_BYTES) + (size_t)(bh & 1) * CB_BYTES;
        { const LAS float* GR = (const LAS float*)(L + EL_GR); const LAS float* G1L = (const LAS float*)(L + EL_G1); const LAS unsigned char* Yb = L + EL_Y;
          if (r32 < 16) {
              const int t = r32, slot = (t + 16 * hh) * 16;
#pragma unroll
              for (int s = 0; s < 2; ++s) {
                  u32x4 w0, w1;
#pragma unroll
                  for (int i = 0; i < 4; ++i) { w0[i] = pkbf(ap0[8 * s + 2 * i], ap0[8 * s + 2 * i + 1]); w1[i] = pkbf(ap1[8 * s + 2 * i], ap1[8 * s + 2 * i + 1]); }
                  *(u32x4*)(out + CB_APT + s * 512 + slot) = w0; *(u32x4*)(out + CB_APT + (2 + s) * 512 + slot) = w1;
#pragma unroll
                  for (int kt = 0; kt < 2; ++kt) { const LAS unsigned char* yr = Yb + (16 + t) * 144 + (32 * kt + 16 * s + 4 * hh) * 2;
                      const u32x2 lo = *(const LAS u32x2*)(yr), hi2 = *(const LAS u32x2*)(yr + 16); u32x4 w; w.x = lo.x; w.y = lo.y; w.z = hi2.x; w.w = hi2.y;
                      *(u32x4*)(out + CB_RTT + (kt * 2 + s) * 512 + slot) = w; }
              }
              u32x4 wg, wb, wk;
#pragma unroll
              for (int i = 0; i < 4; ++i) {
                  const int j0 = 2 * i, j1 = 2 * i + 1;
                  wg[i] = pkbf(G1L[(8 * hh + j0) * 17 + t], G1L[(8 * hh + j1) * 17 + t]);
                  const int sa = 8 * (j0 >> 2) + 4 * hh + (j0 & 3), sb = sa + 1;
                  wb[i] = pkbf((sa <= t) ? GR[sa * GRP + 16 + t] : 0.f, (sb <= t) ? GR[sb * GRP + 16 + t] : 0.f);
                  const int ka = 8 * hh + j0, kb = ka + 1;
                  wk[i] = pkbf((ka <= t) ? GR[(16 + ka) * GRP + 16 + t] : 0.f, (kb <= t) ? GR[(16 + kb) * GRP + 16 + t] : 0.f); }
              *(u32x4*)(out + CB_G1T + slot) = wg; *(u32x4*)(out + CB_ARBT + slot) = wb; *(u32x4*)(out + CB_ARKT + slot) = wk;
          }
          *(float*)(out + CB_WC + lane * 4) = Wc;
          u32x4 bP0, bP1, kP0, kP1, vP0, vP1;
#pragma unroll
          for (int i = 0; i < 2; ++i) {
              bP0[i] = pkbf(Bh[2 * i] * Wc, Bh[2 * i + 1] * Wc); bP0[2 + i] = pkbf(Bh[8 + 2 * i] * Wc, Bh[9 + 2 * i] * Wc);
              bP1[i] = pkbf(Bh[4 + 2 * i] * Wc, Bh[5 + 2 * i] * Wc); bP1[2 + i] = pkbf(Bh[12 + 2 * i] * Wc, Bh[13 + 2 * i] * Wc); }
#pragma unroll
          for (int i = 0; i < 4; ++i) { kP0[i] = pkbf(Kh[2 * i] * Wc, Kh[2 * i + 1] * Wc); kP1[i] = pkbf(Kh[8 + 2 * i] * Wc, Kh[9 + 2 * i] * Wc); vP0[i] = pkbf(Vv[2 * i], Vv[2 * i + 1]); vP1[i] = pkbf(Vv[8 + 2 * i], Vv[9 + 2 * i]); }
          u32x4 f0, f1;
#pragma unroll
          for (int i = 0; i < 4; ++i) { auto rr = __builtin_amdgcn_permlane32_swap(bP0[i], bP1[i], false, false); f0[i] = rr[0]; f1[i] = rr[1]; }
          *(u32x4*)(out + CB_BB + lane * 16) = f0; *(u32x4*)(out + CB_BB + 1024 + lane * 16) = f1;
#pragma unroll
          for (int i = 0; i < 4; ++i) { auto rr = __builtin_amdgcn_permlane32_swap(kP0[i], kP1[i], false, false); f0[i] = rr[0]; f1[i] = rr[1]; }
          *(u32x4*)(out + CB_KB + lane * 16) = f0; *(u32x4*)(out + CB_KB + 1024 + lane * 16) = f1;
#pragma unroll
          for (int i = 0; i < 4; ++i) { auto rr = __builtin_amdgcn_permlane32_swap(vP0[i], vP1[i], false, false); f0[i] = rr[0]; f1[i] = rr[1]; }
          *(u32x4*)(out + CB_VT + lane * 16) = f0; *(u32x4*)(out + CB_VT + 1024 + lane * 16) = f1;
        }
        asm volatile("s_waitcnt lgkmcnt(0)" ::: "memory");
    }
}
constexpr int SC_SLOT = 2 * CB_BYTES, SC_NCH = SEQ / 16;
__device__ __forceinline__ void scan_block(LAS unsigned char* lds, const unsigned char* BLOB, bf16_t* YS, int blk, int wid, int lane) {
    if (wid >= 4) {
        const int lw = wid - 4;
        const unsigned char* gS = BLOB + (size_t)blk * 512 * SC_SLOT + lane * 16;
#define SC_ISSUE(c) do { const int sl_ = ((c) & 3) * SC_SLOT; const unsigned char* s_ = gS + (size_t)(c) * SC_SLOT; \
        _Pragma("unroll") for (int i_ = 0; i_ < 6; ++i_) __builtin_amdgcn_global_load_lds((const unsigned*)(s_ + (lw + 4 * i_) * 1024), (LAS unsigned*)(lds + sl_ + (lw + 4 * i_) * 1024), 16, 0, 0); } while (0)
        SC_ISSUE(0); SC_ISSUE(1); SC_ISSUE(2);
        for (int c = 0; c < SC_NCH; ++c) {
            if (c + 2 < SC_NCH) asm volatile("s_waitcnt vmcnt(12)" ::: "memory"); else asm volatile("s_waitcnt vmcnt(0)" ::: "memory");
            __builtin_amdgcn_s_barrier();
            asm volatile("" ::: "memory");
            if (c + 3 < SC_NCH) SC_ISSUE(c + 3);
        }
#undef SC_ISSUE
    } else {
        typedef attn_body::f32x16 f32x16;
        const int hsel = wid >> 1, vh = wid & 1, bh = blk * 2 + hsel, r32 = lane & 31, hi = lane >> 5, slot16 = ((lane & 15) + 16 * hi) * 16;
        bf16_t* yp = YS + ((size_t)bh * (SEQ / 4) * 64 + vh * 32 + r32) * 4;
        f32x16 Z0 = f32x16{}, Z1 = f32x16{};
        const f32x16 z16 = f32x16{};
#define SC_CVT(dst, src, s_) do { u32x4 w_; _Pragma("unroll") for (int i_ = 0; i_ < 4; ++i_) w_[i_] = pkbf(src[8 * (s_) + 2 * i_], src[8 * (s_) + 2 * i_ + 1]); dst = __builtin_bit_cast(bf16x8, w_); } while (0)
#define SC_M16(off) (*(const LAS bf16x8*)(base + (off) + slot16))
#define SC_M32(off) (*(const LAS bf16x8*)(base + (off) + lane * 16))
#define MF(a_, b_, c_) __builtin_amdgcn_mfma_f32_32x32x16_bf16(a_, b_, c_, 0, 0, 0)
        for (int c = 0; c < SC_NCH; ++c) {
            __builtin_amdgcn_s_barrier();
            asm volatile("" ::: "memory");
            const LAS unsigned char* base = lds + (c & 3) * SC_SLOT + hsel * CB_BYTES;
            bf16x8 zb00, zb01, zb10, zb11, ub;
            SC_CVT(zb00, Z0, 0); SC_CVT(zb01, Z0, 1); SC_CVT(zb10, Z1, 0); SC_CVT(zb11, Z1, 1);
            const bf16x8 vt = SC_M32(CB_VT + vh * 1024);
            f32x16 U = MF(SC_M16(CB_APT + 0), zb00, z16); U = MF(SC_M16(CB_APT + 512), zb01, U); U = MF(SC_M16(CB_APT + 1024), zb10, U); U = MF(SC_M16(CB_APT + 1536), zb11, U);
            U = MF(SC_M16(CB_G1T), vt, U);
            f32x16 Y = MF(SC_M16(CB_RTT + 0), zb00, z16); Y = MF(SC_M16(CB_RTT + 512), zb01, Y); Y = MF(SC_M16(CB_RTT + 1024), zb10, Y); Y = MF(SC_M16(CB_RTT + 1536), zb11, Y);
            Y = MF(SC_M16(CB_ARKT), vt, Y);
            SC_CVT(ub, U, 0);
            Y = MF(SC_M16(CB_ARBT), ub, Y);
            {
                const LAS float* wc = (const LAS float*)(base + CB_WC) + 4 * hi;
#pragma unroll
                for (int g = 0; g < 4; ++g) { const f32x4 w0 = *(const LAS f32x4*)(wc + 8 * g), w1 = *(const LAS f32x4*)(wc + 32 + 8 * g);
#pragma unroll
                    for (int e = 0; e < 4; ++e) { Z0[4 * g + e] *= w0[e]; Z1[4 * g + e] *= w1[e]; } }
            }
            Z0 = MF(SC_M32(CB_BB), ub, Z0); Z1 = MF(SC_M32(CB_BB + 1024), ub, Z1);
            Z0 = MF(SC_M32(CB_KB), vt, Z0); Z1 = MF(SC_M32(CB_KB + 1024), vt, Z1);
            { u32x2 w_; w_.x = pkbf(Y[0], Y[1]); w_.y = pkbf(Y[2], Y[3]); *(u32x2*)(yp + (size_t)(c * 4 + hi) * 256) = w_; }
            { u32x2 w_; w_.x = pkbf(Y[4], Y[5]); w_.y = pkbf(Y[6], Y[7]); *(u32x2*)(yp + (size_t)(c * 4 + 2 + hi) * 256) = w_; }
        }
#undef SC_CVT
#undef SC_M16
#undef SC_M32
#undef MF
    }
    asm volatile("s_waitcnt vmcnt(0) lgkmcnt(0)" ::: "memory"); __builtin_amdgcn_s_barrier();
}
__device__ __forceinline__ void e3_items(const bf16_t* __restrict__ YS, const float* __restrict__ BON, const bf16_t* __restrict__ GB, const bf16_t* __restrict__ UBv0, bf16_t* __restrict__ Y,
                                         const float* __restrict__ lg, const float* __restrict__ lb, const float* __restrict__ muv, int it0, int it1, int lane) {
#pragma unroll 2
    for (int it = it0; it < it1; ++it) {
        const int t0 = (it >> 2) * 4, hq = it & 3, s0 = t0 & (SEQ - 1), b = t0 >> 13;
        const int head = hq * 4 + (lane >> 4), l16 = lane & 15, c = head * 64 + l16 * 4, bh = b * 16 + head;
        const size_t off = (((size_t)bh * (SEQ / 4) + (s0 >> 2)) * 64 + l16 * 4) * 4;
        u32x2 y4[4];
#pragma unroll
        for (int i = 0; i < 4; ++i) y4[i] = *(const u32x2*)(YS + off + i * 4);
        const bf16_t* UBv = UBv0 + c;
        const f32x4 mv4 = *(const f32x4*)(muv + c);
        float pv[4];
        if (s0 > 0) ld4bf(UBv + (size_t)(t0 - 1) * 3072, pv);
        else {
#pragma unroll
            for (int i = 0; i < 4; ++i) pv[i] = 0.f; }
        const f32x4 lg4 = *(const f32x4*)(lg + c), lb4 = *(const f32x4*)(lb + c);
        u32x2 cvw[4], gw_[4]; float bonv[4];
#pragma unroll
        for (int j = 0; j < 4; ++j) { cvw[j] = *(const u32x2*)(UBv + (size_t)(t0 + j) * 3072); gw_[j] = *(const u32x2*)(GB + (size_t)(t0 + j) * W + c); bonv[j] = BON[(size_t)(t0 + j) * 16 + head]; }
#pragma unroll
        for (int j = 0; j < 4; ++j) {
            const int t = t0 + j;
            float y[4], g[4], cv[4], vm[4], sm = 0.f;
            cv[0] = __uint_as_float(cvw[j].x << 16); cv[1] = __uint_as_float(cvw[j].x & 0xffff0000u); cv[2] = __uint_as_float(cvw[j].y << 16); cv[3] = __uint_as_float(cvw[j].y & 0xffff0000u);
            g[0] = __uint_as_float(gw_[j].x << 16); g[1] = __uint_as_float(gw_[j].x & 0xffff0000u); g[2] = __uint_as_float(gw_[j].y << 16); g[3] = __uint_as_float(gw_[j].y & 0xffff0000u);
            const float bon = bonv[j];
#pragma unroll
            for (int i = 0; i < 4; ++i) { const unsigned wv = (j & 2) ? y4[i].y : y4[i].x; y[i] = __builtin_bit_cast(float, (j & 1) ? (wv & 0xffff0000u) : (wv << 16)); sm += y[i];
                vm[i] = cv[i] + (pv[i] - cv[i]) * mv4[i]; pv[i] = cv[i]; }
            const float mean = allred16(sm) * (1.0f / 64.0f);
            float q = 0.f;
#pragma unroll
            for (int i = 0; i < 4; ++i) { y[i] -= mean; q += y[i] * y[i]; }
            const float rstd = rsqrtf(allred16(q) * (1.0f / 64.0f) + 64e-5f);
            float o[4];
#pragma unroll
            for (int i = 0; i < 4; ++i) o[i] = (y[i] * rstd * lg4[i] + lb4[i] + bon * vm[i]) * siluf_(g[i]);
            u32x2 w; w.x = pk2(o[0], o[1]); w.y = pk2(o[2], o[3]);
            *(u32x2*)(Y + (size_t)t * W + c) = w;
        }
    }
}
__device__ __forceinline__ void e3_phase(const Params& p, int l, int it0, int it1, int lane) {
    unsigned char* ws = p.ws;
    e3_items((const bf16_t*)(ws + O_YS), (const float*)(ws + O_VS), (const bf16_t*)(ws + O_GB), (const bf16_t*)(ws + O_UB) + 2048, (bf16_t*)(ws + O_Y) + (size_t)1 * T * W,
             p.in[I_LG] + (size_t)l * W, p.in[I_LB] + (size_t)l * W, p.in[I_MU] + (size_t)l * 3200 + 2048, it0, it1, lane);
}
constexpr int NWAVES = 8;
constexpr int RING_BYTES = 131072;
constexpr int LDSCTL_OFF = RING_BYTES, MISC_OFF = LDSCTL_OFF + 320;
constexpr int LDS_BYTES = 155648;
constexpr int CW_BAR = 1024;
constexpr int CW_QUEUE = 200000;
constexpr int CW_QK = 204800;
constexpr int CW_E3 = 205312;
constexpr int CW_E2A = 205568;
constexpr int CW_GRP = 205824;
constexpr int NPH = 43;
#ifndef MK_PER_PHASE
#define MK_PER_PHASE 0
#endif
static_assert(attn_body::LDS_BYTES <= RING_BYTES && 4 * SC_SLOT <= RING_BYTES && 8 * EL_BYTES <= RING_BYTES && pg8::STAGE_BYTES <= RING_BYTES && 8 * 9216 <= RING_BYTES, "LDS map");
static_assert((CW_BAR + NPH * XCD_BAR_WORDS) <= CW_QUEUE && (CW_QUEUE + 32 * 64) <= CW_QK && (CW_QK + 4 * 64) <= CW_E3 && (CW_E3 + 4 * 64) <= CW_E2A && (CW_E2A + 4 * 64) <= CW_GRP && (CW_GRP + 4 * 3 * 64 * 32) * 4 <= (int)MiB, "barrier regions inside the zeroed control MiB");

__global__ void __launch_bounds__(NWAVES * 64, 2) fwd(Params p) {
    extern __shared__ __attribute__((aligned(16))) unsigned char lds_[];
    LAS unsigned char* lds = (LAS unsigned char*)lds_;
    volatile LAS unsigned* MISC = (volatile LAS unsigned*)(lds + MISC_OFF);
    const int G = gridDim.x; const int wave_k = __builtin_amdgcn_readfirstlane((int)threadIdx.x >> 6);
    for (int u = threadIdx.x; u < (LDS_BYTES - LDSCTL_OFF) / 4; u += NWAVES * 64) ((LAS unsigned*)(lds + LDSCTL_OFF))[u] = 0u;
    __syncthreads();
    unsigned* ctl = (unsigned*)(p.ws + O_CTL);
    XcdBarrier bar = xcd_barrier_post(ctl + CW_BAR + p.li * XCD_BAR_WORDS, MISC + 8);
    const int lo = p.ph_lo, hi = p.ph_hi;
    const int ngw = G * NWAVES; const size_t ngt = (size_t)G * (NWAVES * 64);
#define BX() int bx = blockIdx.x; asm volatile("" : "+s"(bx))
#define WSQ() Params q = p; __attribute__((address_space(1))) unsigned char* wsg_ = (__attribute__((address_space(1))) unsigned char*)p.ws; asm volatile("" : "+s"(wsg_)); q.ws = (unsigned char*)wsg_; unsigned char* ws = q.ws
#define IDS() int wave_o = wave_k, bx_o = blockIdx.x; asm volatile("" : "+s"(wave_o), "+s"(bx_o)); const int lane = lane_opaque(), wave = wave_o, tid_ = wave * 64 + lane, gw = bx_o * NWAVES + wave; \
    const size_t gt = (size_t)bx_o * (NWAVES * 64) + tid_; (void)lane; (void)wave; (void)gw; (void)gt
#define IN(id) (lo <= (id) && (id) < hi)
#define SEAM(id) do { if ((id) + 1 < hi) xcd_barrier(bar, wave_k == 0 && lane_opaque() == 0); } while (0)
    if (IN(1)) { WSQ(); (void)ws; IDS(); p1_weights(q, lds, gw, ngw, wave, lane, gt, ngt); SEAM(1); }
    for (int l = 0; l < DEPTH; ++l) {
        const int pb = 2 + 10 * l;
#define GRP_CTR(seam_) ((unsigned*)(ws + O_CTL) + CW_GRP + ((l * 3 + (seam_)) * 64 + pmg) * 32)
#define GRP_PUB(ptr_) do { asm volatile("s_waitcnt vmcnt(0) lgkmcnt(0)" ::: "memory"); __builtin_amdgcn_s_barrier(); asm volatile("" ::: "memory"); \
            int wv_ = wave_k; asm volatile("" : "+s"(wv_)); if (wv_ == 0 && lane_opaque() == 0) { __builtin_amdgcn_fence(__ATOMIC_RELEASE, "agent"); asm volatile("s_waitcnt vmcnt(0)" ::: "memory"); __hip_atomic_fetch_add((ptr_), 1u, __ATOMIC_RELAXED, __HIP_MEMORY_SCOPE_AGENT); } } while (0)
#define GRP_POLL(ptr_, n_) do { int wv_ = wave_k; asm volatile("" : "+s"(wv_)); if (wv_ == 0) { unsigned polls_ = 0; \
                while ((unsigned)__builtin_amdgcn_readfirstlane(__hip_atomic_load((ptr_), __ATOMIC_RELAXED, __HIP_MEMORY_SCOPE_AGENT)) < (unsigned)(n_)) { if (++polls_ > (1u << 20)) break; __builtin_amdgcn_s_sleep(4); } \
                __builtin_amdgcn_fence(__ATOMIC_ACQUIRE, "agent"); asm volatile("s_waitcnt vmcnt(0)" ::: "memory"); } \
            asm volatile("s_waitcnt vmcnt(0) lgkmcnt(0)" ::: "memory"); __builtin_amdgcn_s_barrier(); asm volatile("" ::: "memory"); } while (0)
        if (IN(pb + 0)) { WSQ(); IDS(); const int pmg = 8 * (bx_o & 7) + ((bx_o >> 3) & 7), r0 = pmg * 256 + (bx_o >> 6) * 64 + wave * 8;
            if (l == 0) e_rmsnorm(q.in[I_X], p.in[I_NG] + (size_t)l * D, (bf16_t*)(ws + O_H), nullptr, r0, 1, lane, r0 + 8);
            else { { const int l_ = l; const int l = l_ - 1; GRP_POLL(GRP_CTR(1), 4); }
                   e_rmsnorm_bf((const bf16_t*)(ws + O_X), p.in[I_NG] + (size_t)l * D, (bf16_t*)(ws + O_H), nullptr, r0, 1, lane, r0 + 8); }
            GRP_PUB(GRP_CTR(2)); }
        if (IN(pb + 1)) { WSQ(); { BX(); const int pmg = 8 * (bx & 7) + ((bx >> 3) & 7); GRP_POLL(GRP_CTR(2), 4); }
            pg8::Gemm g{(const bf16_t*)(ws + O_H), (const bf16_t*)(ws + O_WTIN) + (size_t)l * NP * D, T, PML + 768, D}; pg8::StaticOrder S; BX(); S.init(T, PML + 768, G, bx);
            EpiG1 E{ws};
            pg8::gemm_phase<EpiG1, pg8::StaticOrder, false, true>(lds, g, S, E, wave_k);
            SEAM(pb + 1);
        }
        if (IN(pb + 4)) { WSQ(); IDS();
            {
                const bf16_t* Qp = (const bf16_t*)(ws + O_Q) + lane * 16; const bf16_t* Kp = (const bf16_t*)(ws + O_K) + lane * 16; unsigned* qkm = (unsigned*)(ws + O_CTL) + CW_QK + l * 64;
                volatile LAS float* qs = (volatile LAS float*)(lds + LDSCTL_OFF + 1024);
                for (int bb = 0; bb < BATCH; ++bb) { float mq = 0.f, mk = 0.f;
                    static_assert(SEQ / (256 * NWAVES) == 4, "four tokens per wave and batch");
                    u32x4 qv[4][2], kv[4][2];
#pragma unroll
                    for (int k = 0; k < 4; ++k) { const size_t t = (size_t)(bb * SEQ + gw + k * (256 * NWAVES));
                        qv[k][0] = *(const u32x4*)(Qp + t * W); qv[k][1] = *(const u32x4*)(Qp + t * W + 8); kv[k][0] = *(const u32x4*)(Kp + t * W); kv[k][1] = *(const u32x4*)(Kp + t * W + 8); }
#pragma unroll
                    for (int k = 0; k < 4; ++k) { float sq = 0.f, sk = 0.f;
#pragma unroll
                        for (int j = 0; j < 2; ++j)
#pragma unroll
                            for (int e = 0; e < 4; ++e) { const float q0 = __uint_as_float(qv[k][j][e] << 16), q1 = __uint_as_float(qv[k][j][e] & 0xffff0000u), k0 = __uint_as_float(kv[k][j][e] << 16), k1 = __uint_as_float(kv[k][j][e] & 0xffff0000u);
                                sq += q0 * q0 + q1 * q1; sk += k0 * k0 + k1 * k1; }
                        sq += dppf<0xB1>(sq); sq += dppf<0x4E>(sq); sk += dppf<0xB1>(sk); sk += dppf<0x4E>(sk);
                        mq = fmaxf(mq, sq); mk = fmaxf(mk, sk); }
                    if ((lane & 3) == 0) { qs[(wave * 2 + bb) * 32 + (lane >> 2) * 2] = mq; qs[(wave * 2 + bb) * 32 + (lane >> 2) * 2 + 1] = mk; } }
                asm volatile("s_waitcnt lgkmcnt(0)" ::: "memory"); __builtin_amdgcn_s_barrier(); asm volatile("" ::: "memory");
                if (wave == 0) { float m = 0.f;
#pragma unroll
                    for (int w = 0; w < 8; ++w) m = fmaxf(m, qs[(w * 2 + (lane >> 5)) * 32 + (lane & 31)]);
                    __hip_atomic_fetch_max(qkm + lane, __float_as_uint(m), __ATOMIC_RELAXED, __HIP_MEMORY_SCOPE_AGENT); }
            }
            if (bx_o < 32) e_cumsum_wg(q, l, bx_o, wave, lane, (volatile LAS float*)(lds + LDSCTL_OFF + 4096));
            {
                const float* S = (const float*)(ws + O_S); const float* mu = p.in[I_MU] + (size_t)l * 3200 + 3072;
                const int r = tid_ >> 3, tok = bx_o * 64 + r, s_ = tok & (SEQ - 1);
#pragma unroll
                for (int hf = 0; hf < 2; ++hf) { const int qc = (tid_ & 7) * 2 + hf, j = qc * 8; u32x4 w;
#pragma unroll
                    for (int i2 = 0; i2 < 2; ++i2) {
                        const f32x4 cur = *(const f32x4*)(S + (size_t)tok * 256 + j + 4 * i2), prv = (s_ > 0) ? *(const f32x4*)(S + (size_t)(tok - 1) * 256 + j + 4 * i2) : (f32x4){0.f, 0.f, 0.f, 0.f}, m4 = *(const f32x4*)(mu + j + 4 * i2);
                        float o[4];
#pragma unroll
                        for (int e = 0; e < 4; ++e) { const float xm = cur[e] + (prv[e] - cur[e]) * m4[e]; o[e] = (j < 64) ? (1.0f - 2.0f * __builtin_amdgcn_rcpf(__expf(2.0f * xm) + 1.0f)) : xm; }
                        w[2 * i2] = pk2(o[0], o[1]); w[2 * i2 + 1] = pk2(o[2], o[3]); }
                    *(LAS u32x4*)(lds + LDS_LA + r * 256 + ((qc ^ (r & 15)) * 16)) = w; }
                asm volatile("s_waitcnt lgkmcnt(0)" ::: "memory"); __builtin_amdgcn_s_barrier(); asm volatile("" ::: "memory");
            }
            e2c_phase(q, l, lds, bx_o, wave, lane);
            asm volatile("s_waitcnt vmcnt(0) lgkmcnt(0)" ::: "memory"); __builtin_amdgcn_s_barrier(); asm volatile("" ::: "memory");
            if (wave == 0 && lane == 0) { __builtin_amdgcn_fence(__ATOMIC_RELEASE, "agent"); asm volatile("s_waitcnt vmcnt(0)" ::: "memory");
                __hip_atomic_fetch_add((unsigned*)(ws + O_CTL) + CW_E2A + l * 64, 1u, __ATOMIC_RELAXED, __HIP_MEMORY_SCOPE_AGENT); } }
#define POLL_GE(ptr_, n_) do { if (wave == 0) { unsigned polls_ = 0; \
                while ((unsigned)__builtin_amdgcn_readfirstlane(__hip_atomic_load((ptr_), __ATOMIC_RELAXED, __HIP_MEMORY_SCOPE_AGENT)) < (unsigned)(n_)) { if (++polls_ > (1u << 20)) break; __builtin_amdgcn_s_sleep(8); } \
                __builtin_amdgcn_fence(__ATOMIC_ACQUIRE, "agent"); asm volatile("s_waitcnt vmcnt(0)" ::: "memory"); } \
            asm volatile("s_waitcnt vmcnt(0) lgkmcnt(0)" ::: "memory"); __builtin_amdgcn_s_barrier(); asm volatile("" ::: "memory"); } while (0)
        if (IN(pb + 5)) { WSQ(); { int bx_o = blockIdx.x; asm volatile("" : "+s"(bx_o));
#define X_SIDE() do { IDS();     \
                e1_conv((const bf16_t*)(ws + O_UA), (bf16_t*)(ws + O_Y), p.in[I_CW] + (size_t)l * 3 * W, gt, ngt); \
                e1_pool((const bf16_t*)(ws + O_UD), (bf16_t*)(ws + O_PG), ((size_t)((bx_o & 63) * 16 + (tid_ >> 5)) << 7) | (size_t)((bx_o >> 6) * 32 + (tid_ & 31)), (size_t)1 << 40); \
                asm volatile("s_waitcnt vmcnt(0) lgkmcnt(0)" ::: "memory"); __builtin_amdgcn_s_barrier(); asm volatile("" ::: "memory");     \
                pg8::Gemm g2{(const bf16_t*)(ws + O_PG), (const bf16_t*)(ws + O_WD) + (size_t)l * 4 * 65536, 4 * T, 1024, 256}; PoolOrder S2{G, bx_o}; \
                EpiPool E2{ws, p.in[I_PS] + (size_t)l * W}; \
                pg8::gemm_phase<EpiPool, PoolOrder, true, true>(lds, g2, S2, E2, wave_k); } while (0)
            if (bx_o >= 240) { IDS(); POLL_GE((unsigned*)(ws + O_CTL) + CW_E2A + l * 64, G); scan_block(lds, ws + O_SCN, (bf16_t*)(ws + O_YS), bx_o - 240, wave, lane);
                if (wave == 0 && lane == 0) { __builtin_amdgcn_fence(__ATOMIC_RELEASE, "agent"); asm volatile("s_waitcnt vmcnt(0)" ::: "memory");
                    __hip_atomic_fetch_add((unsigned*)(ws + O_CTL) + CW_E3 + l * 64, 1u, __ATOMIC_RELAXED, __HIP_MEMORY_SCOPE_AGENT); }
                X_SIDE(); }
            else {
                { BX(); pg8::Gemm g{(const bf16_t*)(ws + O_H), (const bf16_t*)(ws + O_WTIN) + ((size_t)l * NP + PML + 768) * D, T, 29 * 256, D};
                  RangeOrder R; R.S.init(T, 29 * 256, 240, bx); R.i0 = 0; R.i1 = (bx >> 3) & 7; EpiML E{ws};
                  pg8::gemm_phase<EpiML, RangeOrder, false, true>(lds, g, R, E, wave_k); }
                X_SIDE();
                { BX(); pg8::Gemm g{(const bf16_t*)(ws + O_H), (const bf16_t*)(ws + O_WTIN) + ((size_t)l * NP + PML + 768) * D, T, 29 * 256, D};
                  RangeOrder R; R.S.init(T, 29 * 256, 240, bx); R.i0 = (bx >> 3) & 7; R.i1 = 64; EpiML E{ws};
                  pg8::gemm_phase<EpiML, RangeOrder, false, true>(lds, g, R, E, wave_k); }
            }
            }
            { IDS(); POLL_GE((unsigned*)(ws + O_CTL) + CW_E2A + l * 64, G);
                unsigned* qctr = (unsigned*)(ws + O_CTL) + CW_QUEUE + (l * 8) * 64;
                volatile LAS unsigned* qw = MISC + 16;
                int label = bx_o & 7, tries = 0;
                for (;;) {
                    if (wave == 0 && lane == 0) qw[0] = __hip_atomic_fetch_add(qctr + label * 64, 1u, __ATOMIC_RELAXED, __HIP_MEMORY_SCOPE_AGENT);
                    asm volatile("s_waitcnt vmcnt(0) lgkmcnt(0)" ::: "memory"); __builtin_amdgcn_s_barrier(); asm volatile("" ::: "memory");
                    const unsigned idx = qw[0];
                    asm volatile("s_waitcnt lgkmcnt(0)" ::: "memory"); __builtin_amdgcn_s_barrier(); asm volatile("" ::: "memory");
                    if (idx >= 128u) { label = (label + 1) & 7; if (++tries == 8) break; continue; }
                    const int qb = 31 - (int)(idx >> 2), bh = label + 8 * (int)(idx & 3u);
                    attn_body::attn_unit<8>(bh >> 4, bh & 15, qb, (const attn_body::bf16*)(ws + O_Q), (const attn_body::bf16*)(ws + O_K), (const attn_body::bf16*)(ws + O_V), (const float*)(ws + O_CB), (const unsigned*)(ws + O_CTL) + CW_QK + l * 64,
                                            (const attn_body::bf16*)(ws + O_GC), (attn_body::bf16*)(ws + O_Y) + (size_t)2 * T * W, (char*)lds_, wave_k);
                }
                unsigned* e3c = (unsigned*)(ws + O_CTL) + CW_E3 + l * 64;
                if (wave == 0) { unsigned polls = 0;
                    while ((unsigned)__builtin_amdgcn_readfirstlane(__hip_atomic_load(e3c, __ATOMIC_RELAXED, __HIP_MEMORY_SCOPE_AGENT)) < 16u) { if (++polls > (1u << 20)) break; __builtin_amdgcn_s_sleep(8); }
                    __builtin_amdgcn_fence(__ATOMIC_ACQUIRE, "agent"); asm volatile("s_waitcnt vmcnt(0)" ::: "memory"); }
                asm volatile("s_waitcnt vmcnt(0) lgkmcnt(0)" ::: "memory"); __builtin_amdgcn_s_barrier(); asm volatile("" ::: "memory");
                for (;;) {
                    if (wave == 0 && lane == 0) qw[0] = __hip_atomic_fetch_add(e3c + 32, 64u, __ATOMIC_RELAXED, __HIP_MEMORY_SCOPE_AGENT);
                    asm volatile("s_waitcnt vmcnt(0) lgkmcnt(0)" ::: "memory"); __builtin_amdgcn_s_barrier(); asm volatile("" ::: "memory");
                    const unsigned base = qw[0];
                    asm volatile("s_waitcnt lgkmcnt(0)" ::: "memory"); __builtin_amdgcn_s_barrier(); asm volatile("" ::: "memory");
                    if (base >= (unsigned)T) break;
                    e3_phase(q, l, (int)base + wave * 8, (int)base + wave * 8 + 8, lane);
                }
            }
            SEAM(pb + 5);
#undef POLL_GE
#undef X_SIDE
        }
        if (IN(pb + 8)) { WSQ();
            pg8::Gemm g{(const bf16_t*)(ws + O_Y), (const bf16_t*)(ws + O_WTBR) + (size_t)l * 4 * D * W, 4 * T, 4 * D, W}; BranchOrder S; BX(); S.init(G, bx);
            EpiG3Q E{ws, p.in[I_BM] + (size_t)l * NB * D, bx};
            pg8::gemm_phase<EpiG3Q, BranchOrder, true, true>(lds, g, S, E, wave_k);
            { const int pmg = 8 * (bx & 7) + ((bx >> 3) & 7); GRP_PUB(GRP_CTR(0)); }
        }
        if (IN(pb + 9)) { WSQ(); { BX(); const int pmg = 8 * (bx & 7) + ((bx >> 3) & 7); GRP_POLL(GRP_CTR(0), 4); }
            pg8::Gemm g{(const bf16_t*)(ws + O_MG), (const bf16_t*)(ws + O_WTOUT) + (size_t)l * D * D, T, D, D}; pg8::StaticOrder S; BX(); S.init(T, D, G, bx);
            EpiG4 E{(l == 0) ? q.in[I_X] : (const float*)nullptr, (const bf16_t*)(ws + O_X), (bf16_t*)(ws + O_X)};
            pg8::gemm_phase<EpiG4, pg8::StaticOrder, true, true>(lds, g, S, E, wave_k);
            if (l == DEPTH - 1) SEAM(pb + 9); else { const int pmg = 8 * (bx & 7) + ((bx >> 3) & 7); GRP_PUB(GRP_CTR(1)); }
        }
    }
    int lo2 = p.ph_lo, hi2 = p.ph_hi; asm volatile("" : "+s"(lo2), "+s"(hi2));
    if (lo2 <= 42 && 42 < hi2) { WSQ(); IDS(); e_rmsnorm_bf((const bf16_t*)(ws + O_X), p.in[I_FG], nullptr, p.out, gw, ngw, lane); }
#undef IN
#undef SEAM
}

extern "C" void kernel_launch(void* const* d_in, const int* in_sizes, int n_in, void* d_out, int out_size, void* d_ws, size_t ws_size, hipStream_t stream) {
    static int state = 0;
    if (state == 0) {
        if (n_in != 21 || in_sizes[0] != T * D || out_size != T * D || ws_size < WS_END) {
            fprintf(stderr, "kernel_launch: unexpected shapes (n_in %d, in0 %d, out %d, ws %zu < %zu); nothing launched\n", n_in, n_in > 0 ? in_sizes[0] : -1, out_size, ws_size, (size_t)WS_END);
            state = -1; return; }
        int dev = 0, cus = 0, per_cu = 0;
        if (hipGetDevice(&dev) != hipSuccess || hipDeviceGetAttribute(&cus, hipDeviceAttributeMultiprocessorCount, dev) != hipSuccess) { fprintf(stderr, "kernel_launch: device query failed\n"); state = -1; return; }
        if (hipFuncSetAttribute((const void*)fwd, hipFuncAttributeMaxDynamicSharedMemorySize, LDS_BYTES) != hipSuccess) { fprintf(stderr, "kernel_launch: hipFuncSetAttribute failed\n"); state = -1; return; }
        if (hipOccupancyMaxActiveBlocksPerMultiprocessor(&per_cu, (const void*)fwd, NWAVES * 64, LDS_BYTES) != hipSuccess || per_cu < 1)
            fprintf(stderr, "kernel_launch: note: occupancy query reports %d workgroups per CU\n", per_cu);
        (void)hipGetLastError();
        if (cus != 256) fprintf(stderr, "kernel_launch: note: %d CUs reported; this kernel launches 256 workgroups (one per CU of a 256-CU device)\n", cus);
        state = 1;
    }
    if (state < 0) return;
    if (hipMemsetAsync((char*)d_ws + O_CTL, 0, 1 * MiB, stream) != hipSuccess) { fprintf(stderr, "kernel_launch: memset failed\n"); return; }
    Params p{};
    for (int i = 0; i < 21; ++i) p.in[i] = (const float*)d_in[i];
    p.out = (float*)d_out; p.ws = (unsigned char*)d_ws;
#if MK_PER_PHASE
    for (int id = 0; id < NPH; ++id) { p.ph_lo = id; p.ph_hi = id + 1; p.li = id; p.pad = 0; hipLaunchKernelGGL(fwd, dim3(256), dim3(NWAVES * 64), LDS_BYTES, stream, p); }
#else
    p.ph_lo = 0; p.ph_hi = NPH; p.li = 0; p.pad = 0;
    hipLaunchKernelGGL(fwd, dim3(256), dim3(NWAVES * 64), LDS_BYTES, stream, p);
#endif
    const hipError_t le = hipPeekAtLastError();
    if (le != hipSuccess) fprintf(stderr, "kernel_launch: launch failed: %s\n", hipGetErrorName(le));
}
```

```cpp
#include <hip/hip_runtime.h>
#include <hip/hip_bf16.h>
#include <cstdio>
#include <cstdint>
#include <cmath>

__device__ __forceinline__ int lane_opaque() { int r; asm volatile("v_mbcnt_lo_u32_b32 %0, -1, 0\n\tv_mbcnt_hi_u32_b32 %0, -1, %0" : "=v"(r)); return r; }
constexpr int D = 2048, BATCH = 2, SEQ = 8192, T = BATCH * SEQ, DEPTH = 4, W = 1024, NB = 4;
constexpr int NIN = 22672;
constexpr int NP = 22784;
constexpr int OA = 0, OB = 4096, OWL = 7168, OAL = 7232, OBG = 7296, OCQ = 8320, OCF = 11392, OCG = 11408, ODI = 12432, ODG = 13456, OML = 14480;
constexpr int PA = 0, PB = 4096, PGB = 7168, PQ = 8192, PK = 9216, PV = 10240, PGC = 11264, PUD = 12288, PGD = 13312, PS = 14336, PML = 14592;
constexpr float C2 = 0.125f * 1.4426950408889634f;
constexpr float LOG2E = 1.4426950408889634f;

constexpr size_t MiB = 1u << 20;
constexpr size_t O_CTL = 0;
constexpr size_t O_WTIN = 1 * MiB;
constexpr size_t O_WTBR = O_WTIN + 356 * MiB;
constexpr size_t O_WTOUT = O_WTBR + 64 * MiB;
constexpr size_t O_WTLORA = O_WTOUT + 32 * MiB;
constexpr size_t O_WD = O_WTLORA + 4 * MiB;
constexpr size_t O_H = O_WD + 32 * MiB;
constexpr size_t O_UA = O_H + 64 * MiB;
constexpr size_t O_UB = O_UA + 128 * MiB;
constexpr size_t O_GB = O_UB + 96 * MiB;
constexpr size_t O_Q = O_GB + 32 * MiB;
constexpr size_t O_K = O_Q + 32 * MiB;
constexpr size_t O_V = O_K + 32 * MiB;
constexpr size_t O_GC = O_V + 32 * MiB;
constexpr size_t O_UD = O_GC + 32 * MiB;
constexpr size_t O_GD = O_UD + 32 * MiB;
constexpr size_t O_ML = O_GD + 32 * MiB;
constexpr size_t O_S = O_ML + 256 * MiB;
constexpr size_t O_LA = O_S + 16 * MiB;
constexpr size_t O_LF = O_LA + 8 * MiB;
constexpr size_t O_CB = O_LF + 1 * MiB;
constexpr size_t O_BON = O_CB + 1 * MiB;
constexpr size_t O_WDEC = O_BON + 1 * MiB;
constexpr size_t O_ASIG = O_WDEC + 64 * MiB;
constexpr size_t O_SCN = O_ASIG + 64 * MiB;
constexpr size_t O_VS = O_SCN + 320 * MiB;
constexpr size_t O_YS = O_VS + 64 * MiB;
constexpr size_t O_Y = O_YS + 64 * MiB;
constexpr size_t O_MG = O_Y + 128 * MiB;
constexpr size_t O_MACC = O_MG + 64 * MiB;
constexpr size_t O_X = O_MACC + 64 * MiB;
constexpr size_t O_GP = O_X + 128 * MiB;
constexpr size_t O_PG = O_GP + 256 * MiB;
constexpr size_t WS_END = O_PG + 32 * MiB;

struct Params { const float* in[21]; float* out; unsigned char* ws; int ph_lo, ph_hi, li, pad; };
enum { I_X = 0, I_NG, I_WIN, I_BM, I_CW, I_MU, I_W0, I_W2, I_A0, I_A2, I_KK, I_KA, I_RK, I_LG, I_LB, I_BF, I_PW, I_PS, I_WB, I_WO, I_FG };

namespace pg8 {
#define PG8_LAS __attribute__((address_space(3)))
typedef unsigned short bf16_t;
typedef short bf16x8 __attribute__((ext_vector_type(8)));
typedef float f32x4 __attribute__((ext_vector_type(4)));
typedef unsigned u32x4 __attribute__((ext_vector_type(4)));
constexpr int BM = 256, BK = 64, HALF = 128, HTB = HALF * BK * 2  , STAGE_BYTES = 8 * HTB, NXCD = 8, WGM = 8;

__host__ __device__ __forceinline__ int lds_byte(int r, int c) { const int st = (r >> 4) * 2 + (c >> 5), rr = r & 15, cc = c & 31, ob = rr * 64 + cc * 2; return st * 1024 + (ob ^ (((ob >> 9) & 1) << 5)); }
__host__ __device__ __forceinline__ void stage_rc(int b, int& R, int& C) { const int st = b / 1024, sb = b % 1024, swz = sb ^ (((sb >> 9) & 1) << 5); R = (st >> 1) * 16 + swz / 64; C = (st & 1) * 32 + (swz % 64) / 2; }
__host__ __device__ __forceinline__ int perm32(int rho) { const int n = rho >> 4, i = rho & 15; return 8 * (i >> 2) + 4 * n + (i & 3); }

struct Unit { int pm, pn; };
struct Gemm { const bf16_t* A; const bf16_t* Bt; int M, N, K; };

struct StaticOrder {
    int nM, nN, nwg, G, c;
    __host__ __device__ void init(int M, int N, int G_, int c_) { nM = M / BM; nN = N / BM; nwg = nM * nN; G = G_; c = c_; }
    __host__ __device__ bool next(int i, Unit& u) const {
        const long L = (long)i * G + c; if (L >= nwg) return false;
        int wgid = (int)L; { const int q = nwg / NXCD, r = nwg % NXCD, xcd = wgid % NXCD, off = wgid / NXCD; wgid = (xcd < r ? xcd * (q + 1) : r * (q + 1) + (xcd - r) * q) + off; }
        const int nig = WGM * nN, gid = wgid / nig, fm = gid * WGM, gsz = (nM - fm) < WGM ? (nM - fm) : WGM;
        u.pm = fm + ((wgid % nig) % gsz); u.pn = (wgid % nig) / gsz; return true;
    }
    __device__ __forceinline__ void a_ready(const Unit&) const {}
    __device__ __forceinline__ void done(const Unit&) const {}
};

__device__ __forceinline__ unsigned cvt_pk_bf16(float lo, float hi) { unsigned r; asm volatile("v_cvt_pk_bf16_f32 %0, %1, %2" : "=v"(r) : "v"(lo), "v"(hi)); return r; }

template <class Epi, class Sched, bool ALIGN_EPI = false, bool SP2 = false>
__device__ __forceinline__ void gemm_phase(PG8_LAS unsigned char* lds, const Gemm g, const Sched& S, const Epi& E, const int wave_k) {
    int wid_o = wave_k; asm volatile("" : "+s"(wid_o));
    const int lane = lane_opaque(), wid = wid_o, tid = wid * 64 + lane,
    wr = wid >> 2, wc = wid & 3, fr = lane & 15, fq = lane >> 4;
    const int K = g.K, nt = K / BK;
    unsigned voffA[2], voffB[2];
#pragma unroll
    for (int i = 0; i < 2; ++i) { int R, C; stage_rc(tid * 16 + i * 8192, R, C); const int Rb = Epi::PERM ? ((R & ~31) + perm32(R & 31)) : R;
        voffA[i] = (unsigned)(R * K + C) * 2u; voffB[i] = (unsigned)(Rb * K + C) * 2u; }
    const size_t kstep = (size_t)(BK * 2);
    const size_t hstep = (size_t)HALF * K * 2;
    const size_t tstep = 2 * hstep;
    const unsigned ldsw = (unsigned)wid * 1024u;
    const int aoff = lds_byte(wr * 64 + fr, fq * 8), boff = lds_byte(wc * 32 + fr, fq * 8);
#define PG8_SA(b, h) (((b) * 2 + (h)) * HTB)
#define PG8_SB(b, h) ((4 + (b) * 2 + (h)) * HTB)
#define PG8_STAGE(bufoff, gbase, voff) do { _Pragma("unroll") for (int _i = 0; _i < 2; ++_i) \
        __builtin_amdgcn_global_load_lds((const unsigned*)((const char*)(gbase) + (voff)[_i]), (PG8_LAS unsigned*)(lds + (bufoff) + ldsw + _i * 8192), 16, 0, 0); } while (0)
#define PG8_LDA(dst, b, h) do { _Pragma("unroll") for (int m = 0; m < 4; ++m) _Pragma("unroll") for (int k = 0; k < 2; ++k) dst[m][k] = *(const PG8_LAS bf16x8*)(lds + PG8_SA(b, h) + aoff + m * 2048 + k * 1024); } while (0)
#define PG8_LDB(dst, b, h) do { _Pragma("unroll") for (int n = 0; n < 2; ++n) _Pragma("unroll") for (int k = 0; k < 2; ++k) dst[n][k] = *(const PG8_LAS bf16x8*)(lds + PG8_SB(b, h) + boff + n * 2048 + k * 1024); } while (0)
#define PG8_MMA(ai, bj, At, Bt) do { __builtin_amdgcn_s_setprio(1); _Pragma("unroll") for (int m = 0; m < 4; ++m) _Pragma("unroll") for (int n = 0; n < 2; ++n) _Pragma("unroll") for (int k = 0; k < 2; ++k) \
        acc[ai][bj][m][n] = __builtin_amdgcn_mfma_f32_16x16x32_bf16(Bt[n][k], At[m][k], acc[ai][bj][m][n], 0, 0, 0); __builtin_amdgcn_s_setprio(0); } while (0)
#define PG8_WAIT_V(n) asm volatile("s_waitcnt vmcnt(" #n ")" ::: "memory")
#define PG8_WAIT_L(n) asm volatile("s_waitcnt lgkmcnt(" #n ")" ::: "memory")
#define PG8_WAIT_VR(rx, n) asm volatile("s_cmp_lg_u32 %0, 0\n\ts_cbranch_scc1 1f\n\ts_waitcnt vmcnt(8)\n1:\n\ts_waitcnt vmcnt(%1)" :: "s"(rx), "n"(n) : "memory", "scc")
#define PG8_BAR __builtin_amdgcn_s_barrier()
#define PG8_SCHED __builtin_amdgcn_sched_barrier(0)
    Unit cur, nxt; int ui = 0;
    if (!S.next(0, cur)) return;
    f32x4 acc[2][2][4][2];
#pragma unroll
    for (int a = 0; a < 2; ++a)
#pragma unroll
        for (int b = 0; b < 2; ++b)
#pragma unroll
            for (int m = 0; m < 4; ++m)
#pragma unroll
                for (int n = 0; n < 2; ++n) acc[a][b][m][n] = (f32x4){0.f, 0.f, 0.f, 0.f};
    bf16x8 At[4][2], B0[2][2], B1[2][2];
    const char* cA = (const char*)g.A + (size_t)cur.pm * tstep; const char* cB = (const char*)g.Bt + (size_t)cur.pn * tstep;
    S.a_ready(cur);
    if constexpr (SP2) {
        PG8_STAGE(PG8_SB(0, 0), cB, voffB); PG8_STAGE(PG8_SB(0, 1), cB + hstep, voffB); PG8_STAGE(PG8_SA(0, 0), cA, voffA); PG8_STAGE(PG8_SA(0, 1), cA + hstep, voffA);
        if (wr == 1) PG8_BAR;
        PG8_WAIT_V(2); PG8_BAR;
        PG8_STAGE(PG8_SB(1, 0), cB + kstep, voffB); PG8_STAGE(PG8_SA(1, 0), cA + kstep, voffA); PG8_STAGE(PG8_SB(1, 1), cB + hstep + kstep, voffB);
        PG8_WAIT_V(6); PG8_BAR;
    } else {
        PG8_STAGE(PG8_SB(0, 0), cB, voffB); PG8_STAGE(PG8_SA(0, 0), cA, voffA); PG8_STAGE(PG8_SB(0, 1), cB + hstep, voffB); PG8_STAGE(PG8_SA(0, 1), cA + hstep, voffA);
        if (wr == 1) PG8_BAR;
        PG8_WAIT_V(4); PG8_BAR;
        PG8_STAGE(PG8_SB(1, 0), cB + kstep, voffB); PG8_STAGE(PG8_SA(1, 0), cA + kstep, voffA); PG8_STAGE(PG8_SB(1, 1), cB + hstep + kstep, voffB);
        PG8_WAIT_V(6); PG8_BAR;
    }
    for (;;) {
        const bool has_next = S.next(ui + 1, nxt);
        const char* nA = has_next ? (const char*)g.A + (size_t)nxt.pm * tstep : cA; const char* nB = has_next ? (const char*)g.Bt + (size_t)nxt.pn * tstep : cB;
        for (int t = 0; t < nt; t += 2) {
            const bool last = (t == nt - 2);
            const char* a1 = cA + (size_t)(t + 1) * kstep;
            const char* a2 = last ? nA : cA + (size_t)(t + 2) * kstep; const char* b2 = last ? nB : cB + (size_t)(t + 2) * kstep;
            const char* a3 = a2 + kstep; const char* b3 = b2 + kstep;
            if (last && has_next) S.a_ready(nxt);
            const int relax = __builtin_amdgcn_readfirstlane((t == 0 && ui > 0) ? 1 : 0);
            if constexpr (SP2) {
            PG8_LDB(B0, 0, 0); PG8_LDB(B1, 0, 1); PG8_SCHED; PG8_LDA(At, 0, 0); PG8_STAGE(PG8_SA(1, 1), a1 + hstep, voffA);
            PG8_WAIT_VR(relax, 8 + Epi::NST); PG8_WAIT_L(0); PG8_BAR; PG8_MMA(0, 0, At, B0); PG8_MMA(0, 1, At, B1); PG8_BAR; PG8_SCHED;
            PG8_LDA(At, 0, 1); PG8_STAGE(PG8_SB(0, 0), b2, voffB); PG8_STAGE(PG8_SB(0, 1), b2 + hstep, voffB); PG8_STAGE(PG8_SA(0, 0), a2, voffA);
            PG8_WAIT_VR(relax, 8 + Epi::NST); PG8_WAIT_L(0); PG8_BAR; PG8_MMA(1, 0, At, B0); PG8_MMA(1, 1, At, B1); PG8_BAR; PG8_SCHED;
            PG8_LDB(B0, 1, 0); PG8_LDB(B1, 1, 1); PG8_SCHED; PG8_LDA(At, 1, 0); PG8_STAGE(PG8_SA(0, 1), a2 + hstep, voffA);
            PG8_WAIT_V(8); PG8_WAIT_L(0); PG8_BAR; PG8_MMA(0, 0, At, B0); PG8_MMA(0, 1, At, B1); PG8_BAR; PG8_SCHED;
            PG8_LDA(At, 1, 1); PG8_STAGE(PG8_SB(1, 0), b3, voffB); PG8_STAGE(PG8_SB(1, 1), b3 + hstep, voffB); PG8_STAGE(PG8_SA(1, 0), a3, voffA);
            PG8_WAIT_V(8); PG8_WAIT_L(0); PG8_BAR; PG8_MMA(1, 0, At, B0); PG8_MMA(1, 1, At, B1); PG8_BAR; PG8_SCHED;
            } else {
            PG8_LDB(B0, 0, 0); PG8_SCHED; PG8_LDA(At, 0, 0); PG8_STAGE(PG8_SA(1, 1), a1 + hstep, voffA);
            PG8_WAIT_L(8); PG8_BAR; PG8_WAIT_L(0); PG8_MMA(0, 0, At, B0); PG8_BAR; PG8_SCHED;
            PG8_LDB(B1, 0, 1); PG8_STAGE(PG8_SB(0, 0), b2, voffB);
            PG8_BAR; PG8_WAIT_L(0); PG8_MMA(0, 1, At, B1); PG8_BAR;
            PG8_LDA(At, 0, 1); PG8_STAGE(PG8_SA(0, 0), a2, voffA);
            PG8_BAR; PG8_WAIT_L(0); PG8_MMA(1, 0, At, B0); PG8_BAR; PG8_SCHED;
            PG8_STAGE(PG8_SB(0, 1), b2 + hstep, voffB);
            PG8_WAIT_V(6); PG8_BAR; PG8_MMA(1, 1, At, B1); PG8_BAR;
            PG8_LDB(B0, 1, 0); PG8_SCHED; PG8_LDA(At, 1, 0); PG8_STAGE(PG8_SA(0, 1), a2 + hstep, voffA);
            PG8_WAIT_L(8); PG8_BAR; PG8_WAIT_L(0); PG8_MMA(0, 0, At, B0); PG8_BAR; PG8_SCHED;
            PG8_LDB(B1, 1, 1); PG8_STAGE(PG8_SB(1, 0), b3, voffB);
            PG8_BAR; PG8_WAIT_L(0); PG8_MMA(0, 1, At, B1); PG8_BAR;
            PG8_LDA(At, 1, 1); PG8_STAGE(PG8_SA(1, 0), a3, voffA);
            PG8_BAR; PG8_WAIT_L(0); PG8_MMA(1, 0, At, B0); PG8_BAR; PG8_SCHED;
            PG8_STAGE(PG8_SB(1, 1), b3 + hstep, voffB);
            PG8_WAIT_V(6); PG8_BAR; PG8_MMA(1, 1, At, B1); PG8_BAR;
            }
        }
        if constexpr (ALIGN_EPI) { if (wr == 0) PG8_BAR; }
        if constexpr (!Epi::AFTER_DRAIN) { E(acc, cur, wr, wc, fr, fq); S.done(cur); }
        if (!has_next) break;
#pragma unroll
        for (int a = 0; a < 2; ++a)
#pragma unroll
            for (int b = 0; b < 2; ++b)
#pragma unroll
                for (int m = 0; m < 4; ++m)
#pragma unroll
                    for (int n = 0; n < 2; ++n) acc[a][b][m][n] = (f32x4){0.f, 0.f, 0.f, 0.f};
        cur = nxt; cA = nA; cB = nB; ++ui;
        if constexpr (ALIGN_EPI) { if (wr == 1) PG8_BAR; }
    }
    PG8_WAIT_V(0);
    if constexpr (!ALIGN_EPI) { if (wr == 0) PG8_BAR; }
    PG8_BAR;
    if constexpr (Epi::AFTER_DRAIN) { E.fused(acc, cur, wr, wc, fr, fq, lds, wid, lane); S.done(cur); }
#undef PG8_SA
#undef PG8_SB
#undef PG8_STAGE
#undef PG8_LDA
#undef PG8_LDB
#undef PG8_MMA
#undef PG8_WAIT_V
#undef PG8_WAIT_L
#undef PG8_WAIT_VR
#undef PG8_BAR
#undef PG8_SCHED
}
}

namespace attn_body {
using bf16=__hip_bfloat16;
using bf16x8=__attribute__((ext_vector_type(8)))short;
using s16x4=__attribute__((ext_vector_type(4)))short;
using f32x16=__attribute__((ext_vector_type(16)))float;
using u32x4=__attribute__((ext_vector_type(4)))unsigned;
constexpr int BATCH=2,NHEAD=16,SEQ=8192,D=64,DM=NHEAD*D;
constexpr int NW=8,QBLK=32,QB=QBLK*NW,KVBLK=64,NQB=SEQ/QB;
constexpr int ATTN_PITCH=DM, ATTN_UNIT_ROWS=QB;
__device__ __forceinline__ int crow(int r,int hi){return (r&3)+8*(r>>2)+4*hi;}
#define SBAR() __builtin_amdgcn_sched_barrier(0)
__device__ __forceinline__ void cmask(f32x16&p0,f32x16&p1,int jb,int qrel,int hi){
  const float NEG=-INFINITY; int kb=64*jb+4*hi;
  #pragma unroll
  for(int r=0;r<16;++r){int kv=kb+(r&3)+8*(r>>2); if(kv>qrel)p0[r]=NEG; if(kv+32>qrel)p1[r]=NEG;}
}

constexpr int NSLOT=3, SLOTB=8192;
constexpr int LDS_K=0, LDS_V=NSLOT*SLOTB, LDS_WS=2*NSLOT*SLOTB, LDS_OST=LDS_WS+NW*64*4, LDS_CB=LDS_OST+NW*4096, LDS_BYTES=LDS_CB+SEQ*4;
constexpr int PRUNE_THR=40;
constexpr float C2=0.125f*1.4426950408889634f;
__device__ __forceinline__ void glds16(const void*gsrc,unsigned lds_dst){unsigned keep;
  asm volatile("s_mov_b32 %0, m0\n\ts_mov_b32 m0, %2\n\ts_nop 0\n\tglobal_load_lds_dwordx4 %1, off\n\ts_mov_b32 m0, %0":"=&s"(keep):"v"(gsrc),"s"(lds_dst):"memory");}
__device__ __forceinline__ float max3f(float a,float b,float c){float r;asm("v_max3_f32 %0, %1, %2, %3":"=v"(r):"v"(a),"v"(b),"v"(c));return r;}
__device__ __forceinline__ float max2f(float a,float b){float r;asm("v_max_f32_e32 %0, %1, %2":"=v"(r):"v"(a),"v"(b));return r;}
__device__ __forceinline__ float fadd_s(float a,float b){float r;asm("v_add_f32_e32 %0, %1, %2":"=v"(r):"v"(a),"v"(b));return r;}
__device__ __forceinline__ float fsub_s(float a,float b){float r;asm("v_sub_f32_e32 %0, %1, %2":"=v"(r):"v"(a),"v"(b));return r;}
typedef float f32x2_t __attribute__((ext_vector_type(2))); typedef __bf16 bf16x2_t __attribute__((ext_vector_type(2)));
__device__ __forceinline__ unsigned cvtpk_s(float lo,float hi){f32x2_t v={lo,hi};bf16x2_t b=__builtin_convertvector(v,bf16x2_t);return __builtin_bit_cast(unsigned,b);}
#define WAIT_BAR(N) asm volatile("s_waitcnt vmcnt(" #N ") lgkmcnt(0)\n\ts_barrier":::"memory")

__device__ __forceinline__ void split3(float x,unsigned&w0,unsigned&w1){
  const unsigned hb=__float_as_uint(x)&0xffff0000u; const float r1=x-__uint_as_float(hb);
  const unsigned mb=__float_as_uint(r1)&0xffff0000u; const float r2=r1-__uint_as_float(mb);
  w0=(hb>>16)|mb; w1=__float_as_uint(r2)>>16; }
__device__ __forceinline__ bf16x8 mk8(unsigned a,unsigned b,unsigned c,unsigned d){ u32x4 v={a,b,c,d}; return __builtin_bit_cast(bf16x8,v); }
__device__ __forceinline__ void qkt(f32x16&p0,f32x16&p1,const char*Kslot,const bf16x8*qr,int r32,int hi){
  const char*kb=Kslot+hi*1024+r32*16;
  #pragma unroll
  for(int d0=0;d0<4;++d0){
    const bf16x8 b0=*reinterpret_cast<const bf16x8*>(kb+d0*2048);
    const bf16x8 b1=*reinterpret_cast<const bf16x8*>(kb+d0*2048+512);
    p0=__builtin_amdgcn_mfma_f32_32x32x16_bf16(b0,qr[d0],p0,0,0,0);p1=__builtin_amdgcn_mfma_f32_32x32x16_bf16(b1,qr[d0],p1,0,0,0);}
}
typedef __attribute__((address_space(3))) const char* lds_cptr;
typedef short v4i16_t __attribute__((ext_vector_type(4)));
__device__ __forceinline__ void kload8(bf16x8*kf,lds_cptr kp){
  kf[0]=*(const __attribute__((address_space(3))) bf16x8*)(kp);      kf[1]=*(const __attribute__((address_space(3))) bf16x8*)(kp+512);
  kf[2]=*(const __attribute__((address_space(3))) bf16x8*)(kp+2048); kf[3]=*(const __attribute__((address_space(3))) bf16x8*)(kp+2560);
  kf[4]=*(const __attribute__((address_space(3))) bf16x8*)(kp+4096); kf[5]=*(const __attribute__((address_space(3))) bf16x8*)(kp+4608);
  kf[6]=*(const __attribute__((address_space(3))) bf16x8*)(kp+6144); kf[7]=*(const __attribute__((address_space(3))) bf16x8*)(kp+6656);
}
__device__ __forceinline__ void kload2(bf16x8*kf,lds_cptr kp,int j){ kf[2*j]=*(const __attribute__((address_space(3))) bf16x8*)(kp+j*2048); kf[2*j+1]=*(const __attribute__((address_space(3))) bf16x8*)(kp+j*2048+512); }
__device__ __forceinline__ s16x4 vtr(lds_cptr p){ return __builtin_bit_cast(s16x4,__builtin_amdgcn_ds_read_tr16_b64_v4i16((__attribute__((address_space(3))) v4i16_t*)p)); }
__device__ __forceinline__ float rowmax(const f32x16&p0,const f32x16&p1){
  float a=max3f(p0[0],p0[1],p1[0]),b=max3f(p0[2],p0[3],p1[1]);a=max3f(a,p1[2],p1[3]);
  #pragma unroll
  for(int r=4;r<16;r+=4){a=max3f(a,p0[r],p0[r+1]);b=max3f(b,p0[r+2],p0[r+3]);a=max3f(a,p1[r],p1[r+1]);b=max3f(b,p1[r+2],p1[r+3]);}
  const float m=max2f(a,b);
  auto rr=__builtin_amdgcn_permlane32_swap(__float_as_uint(m),__float_as_uint(m),false,false);
  return max2f(__uint_as_float(rr[0]),__uint_as_float(rr[1]));
}
__device__ __forceinline__ void pv(f32x16*o,int vb,bf16x8 pa0,bf16x8 pa1,bf16x8 pa2,bf16x8 pa3){
  #pragma unroll
  for(int d0=0;d0<2;++d0){s16x4 lo[4],hi[4];
    #pragma unroll
    for(int ks=0;ks<4;++ks){
      asm volatile("ds_read_b64_tr_b16 %0,%1 offset:%c2":"=&v"(lo[ks]):"v"(vb),"i"(d0*4096+ks*1024):"memory");
      asm volatile("ds_read_b64_tr_b16 %0,%1 offset:%c2":"=&v"(hi[ks]):"v"(vb),"i"(d0*4096+ks*1024+512):"memory");}
    asm volatile("s_waitcnt lgkmcnt(0)":::"memory");SBAR();
    #define PK(k) (bf16x8){lo[k][0],lo[k][1],lo[k][2],lo[k][3],hi[k][0],hi[k][1],hi[k][2],hi[k][3]}
    o[d0]=__builtin_amdgcn_mfma_f32_32x32x16_bf16(pa0,PK(0),o[d0],0,0,0);
    o[d0]=__builtin_amdgcn_mfma_f32_32x32x16_bf16(pa1,PK(1),o[d0],0,0,0);
    o[d0]=__builtin_amdgcn_mfma_f32_32x32x16_bf16(pa2,PK(2),o[d0],0,0,0);
    o[d0]=__builtin_amdgcn_mfma_f32_32x32x16_bf16(pa3,PK(3),o[d0],0,0,0);
    #undef PK
  }
}

#ifndef ATTN_STORE16
#define ATTN_STORE16(p,v) (*(u32x4*)(p)=(v))
#endif
template<int THRL> __device__ __forceinline__ void attn_unit(int b,int h,int qb,const bf16*Q,const bf16*__restrict__ K,const bf16*__restrict__ V,const float*__restrict__ CB,const unsigned*__restrict__ QKM,const bf16*__restrict__ Gt,bf16*O,char*shm,const int wave_k){
  int wid_o=wave_k; asm volatile("":"+s"(wid_o)); const int lane=lane_opaque(),r32=lane&31,hi=lane>>5; const int wid=wid_o; const int tid=wid*64+lane; (void)tid;
  const long rowbase=(long)b*SEQ; const int q0=qb*QB;
  const bf16*Qw=Q+(rowbase+q0+wid*QBLK)*DM+h*D;
  const bf16*Kh=K+rowbase*DM+h*D,*Vh=V+rowbase*DM+h*D;
  const unsigned lds0=(unsigned)(uintptr_t)shm;
  float*wsf=(float*)(shm+LDS_WS)+wid*64;
  const bf16* ksrc=Kh+(long)lane*DM+wid*8;
  const bf16* vsrc=Vh+(long)(16*(wid&3)+(lane>>2))*DM+(wid>>2)*32+(lane&3)*8;
  const unsigned kdst=lds0+LDS_K+wid*1024, vdst=lds0+LDS_V+wid*1024;
  #define DMA_K(t,slot) glds16(ksrc+(long)(t)*KVBLK*DM,(unsigned)__builtin_amdgcn_readfirstlane(kdst+(slot)))
  #define DMA_V(t,slot) glds16(vsrc+(long)(t)*KVBLK*DM,(unsigned)__builtin_amdgcn_readfirstlane(vdst+(slot)))
  const int vb0=(int)(lds0+LDS_V)+((lane>>4)&1)*32+(lane&3)*8+(4*hi+((lane&15)>>2))*64;
  const char*Kbase=shm+LDS_K; bf16x8 kf[8];
  const lds_cptr shm3=(lds_cptr)shm; const lds_cptr kp0=shm3+LDS_K+hi*1024+r32*16; const lds_cptr vp0=shm3+LDS_V+((lane>>4)&1)*32+(lane&3)*8+(4*hi+((lane&15)>>2))*64;
  int NT=(q0+QB)/KVBLK;
  { const float*cbg=CB+(long)(b*NHEAD+h)*SEQ+lane*4;
    for(int pc=wid;pc<NT/4;pc+=NW) glds16(cbg+pc*256,(unsigned)__builtin_amdgcn_readfirstlane(lds0+LDS_CB+pc*1024)); }
  int t0=0;
  { asm volatile("s_waitcnt vmcnt(0)\n\ts_barrier":::"memory");
    typedef __attribute__((address_space(3))) const float* lds_fptr0; const lds_fptr0 cb0=(lds_fptr0)((lds_cptr)shm+LDS_CB);
    const float qk=sqrtf(__uint_as_float(QKM[(b*NHEAD+h)*2])*__uint_as_float(QKM[(b*NHEAD+h)*2+1]));
    const float lim=cb0[q0]+2.0f*qk*1.001f+1.0f+(float)PRUNE_THR;
    int cnt=0;
    for(int base=0;base<NT-4;base+=64){ const int tt=base+lane; const bool pr=(tt<NT-4)&&(cb0[64*(tt<NT-4?tt:0)+63]>=lim); cnt+=__popcll(__ballot(pr)); }
    t0=cnt&~1; }
  ksrc+=(long)t0*KVBLK*DM; vsrc+=(long)t0*KVBLK*DM; NT-=t0;
  DMA_K(0,0);DMA_V(0,0);DMA_K(1,SLOTB);
  bf16x8 qr[4];
  #pragma unroll
  for(int d0=0;d0<4;++d0)qr[d0]=*reinterpret_cast<const bf16x8*>(&Qw[(long)r32*DM+d0*16+hi*8]);
  float mhat=0.f,l_reg=0.f;f32x16 o[2];o[0]=f32x16{};o[1]=f32x16{};
  typedef __attribute__((address_space(3))) const float* lds_fptr;
  const lds_fptr cbl=(lds_fptr)(shm3+LDS_CB)+lane+t0*64; bf16x8 qm,kb0,kb1; float cref=0.f; const f32x16 z16=f32x16{};
  #define MKQM() do{ unsigned a_,b_; split3(-mhat,a_,b_); qm=hi?mk8(0u,0u,0u,0u):mk8(0x3F803F80u,0x3F80u|(a_<<16),(a_>>16)|(b_<<16),0u); }while(0)
  #define BIAS(t) do{ unsigned w0_,w1_; split3(cref-cbl[(t)*64],w0_,w1_); w1_|=0x3F800000u; \
    auto s0_=__builtin_amdgcn_permlane32_swap(w0_,w0_,false,false); auto s1_=__builtin_amdgcn_permlane32_swap(w1_,w1_,false,false); \
    kb0=mk8(w0_,w1_,0x3F803F80u,0u); kb1=mk8(s0_[1],s1_[1],0x3F803F80u,0u); }while(0)
  const int qrel=wid*QBLK+r32;
  #define CMASK(P0,P1,t) do{int jb_=(t)-(NT-4); if(jb_>=0)cmask(P0,P1,jb_,qrel,hi);}while(0)
  bool resc=false;
  #define START(P0,P1) do{ const float rm=rowmax(P0,P1); resc=false; \
    { const float dl=rm; mhat=fadd_s(mhat,dl); \
      _Pragma("unroll") for(int r=0;r<16;++r){P0[r]=fsub_s(P0[r],dl);P1[r]=fsub_s(P1[r],dl);} \
      } \
    _Pragma("unroll") for(int r=0;r<16;++r)P0[r]=__builtin_amdgcn_exp2f(P0[r]); }while(0)
  #define RESC() do{ if(resc){ asm volatile("s_waitcnt lgkmcnt(0)":::"memory"); \
      _Pragma("unroll") for(int d_=0;d_<2;++d_) _Pragma("unroll") for(int r=0;r<16;++r)o[d_][r]*=wsf[crow(r,hi)]; } }while(0)
  f32x16 pA0,pA1,pB0,pB1;
  int sl_prev=0,sl_cur=0,sl_next=SLOTB;
  #define ROT() do{sl_prev=sl_cur;sl_cur=sl_next;sl_next=(sl_next==(NSLOT-1)*SLOTB)?0:sl_next+SLOTB;}while(0)
  DMA_K(2,2*SLOTB);
  WAIT_BAR(3);
  cref=*((lds_fptr)(shm3+LDS_CB)+q0); MKQM(); BIAS(0);
  pA0=__builtin_amdgcn_mfma_f32_32x32x16_bf16(kb0,qm,z16,0,0,0); pA1=__builtin_amdgcn_mfma_f32_32x32x16_bf16(kb1,qm,z16,0,0,0);
  qkt(pA0,pA1,Kbase,qr,r32,hi);asm volatile("s_nop 15\n\ts_nop 7":"+v"(pA0),"+v"(pA1));CMASK(pA0,pA1,0);
  START(pA0,pA1);
  _Pragma("unroll") for(int r=0;r<16;++r)pA1[r]=__builtin_amdgcn_exp2f(pA1[r]);
  WAIT_BAR(0);
  DMA_K(3,0);DMA_V(1,SLOTB);
  ROT();
  kload8(kf,kp0+sl_cur);
  WAIT_BAR(2);
  s16x4 vlo[8],vhi[8]; u32x4 pw0,pw1,pw2,pw3;
  #define PKW(P,B) cvtpk_s(P[B],P[B+1])
  #define PAF(k) __builtin_bit_cast(bf16x8,pw##k)
  #define VFR(i) (bf16x8){vlo[i][0],vlo[i][1],vlo[i][2],vlo[i][3],vhi[i][0],vhi[i][1],vhi[i][2],vhi[i][3]}
  #define PIN(x) asm volatile("":"+v"(x))
  #define MX3(a,b,c) __builtin_fmaxf(__builtin_fmaxf((a),(b)),(c))
  #define GAPA(MF,A0,A1,A2,A3,W0,W1,PW) do{ MF; sacc+=A0; sacc+=A1; sacc+=A2; sacc+=A3; PIN(sacc); W0; W1; PIN(PW); SBAR(); }while(0)
  #define EX(v) __builtin_amdgcn_exp2f(v)
  #define GAPB(MF,X,B) do{ MF; X[B]=EX(X[B]); X[B+1]=EX(X[B+1]); X[B+2]=EX(X[B+2]); X[B+3]=EX(X[B+3]); PIN(X); SBAR(); }while(0)
  #define VRD(i) do{ vlo[i]=vtr(vp_+(((i)>>2)*4096+((i)&3)*1024)); vhi[i]=vtr(vp_+(((i)>>2)*4096+((i)&3)*1024+512)); }while(0)
  #define KRD(G,j) do{ if(G){ kload2(kf,kp0+sl_next,j); SBAR(); } }while(0)
  #define STEP(C0,C1,P0,P1,t,GK,GV,GL) do{ SBAR(); \
    MKQM(); BIAS(t); C0=__builtin_amdgcn_mfma_f32_32x32x16_bf16(kb0,qm,z16,0,0,0); C1=__builtin_amdgcn_mfma_f32_32x32x16_bf16(kb1,qm,z16,0,0,0); SBAR(); \
    const lds_cptr vp_=vp0+sl_prev; \
    VRD(0); SBAR(); float sacc=(P0[0]+P0[1]); \
    GAPA(C0=__builtin_amdgcn_mfma_f32_32x32x16_bf16(kf[0],qr[0],C0,0,0,0), P0[2],P0[3],P0[4],P0[5],     pw0[0]=PKW(P0,0), pw0[1]=PKW(P0,2), pw0); \
    VRD(4); SBAR(); GAPA(C1=__builtin_amdgcn_mfma_f32_32x32x16_bf16(kf[1],qr[0],C1,0,0,0), P0[6],P0[7],P0[8],P0[9],     pw0[2]=PKW(P0,4), pw0[3]=PKW(P0,6), pw0); \
    VRD(1); SBAR(); GAPA(C0=__builtin_amdgcn_mfma_f32_32x32x16_bf16(kf[2],qr[1],C0,0,0,0),   P0[10],P0[11],P0[12],P0[13], pw1[0]=PKW(P0,8), pw1[1]=PKW(P0,10), pw1); \
    VRD(5); SBAR(); GAPA(C1=__builtin_amdgcn_mfma_f32_32x32x16_bf16(kf[3],qr[1],C1,0,0,0),   P0[14],P0[15],P1[0],P1[1],   pw1[2]=PKW(P0,12),pw1[3]=PKW(P0,14), pw1); \
    VRD(2); SBAR(); GAPA(C0=__builtin_amdgcn_mfma_f32_32x32x16_bf16(kf[4],qr[2],C0,0,0,0),   P1[2],P1[3],P1[4],P1[5],     pw2[0]=PKW(P1,0), pw2[1]=PKW(P1,2), pw2); \
    VRD(6); SBAR(); GAPA(C1=__builtin_amdgcn_mfma_f32_32x32x16_bf16(kf[5],qr[2],C1,0,0,0),   P1[6],P1[7],P1[8],P1[9],     pw2[2]=PKW(P1,4), pw2[3]=PKW(P1,6), pw2); \
    VRD(3); SBAR(); GAPA(C0=__builtin_amdgcn_mfma_f32_32x32x16_bf16(kf[6],qr[3],C0,0,0,0),   P1[10],P1[11],P1[12],P1[13], pw3[0]=PKW(P1,8), pw3[1]=PKW(P1,10), pw3); \
    VRD(7); SBAR(); GAPA(C1=__builtin_amdgcn_mfma_f32_32x32x16_bf16(kf[7],qr[3],C1,0,0,0),   P1[14],P1[15],0.f,0.f,       pw3[2]=PKW(P1,12),pw3[3]=PKW(P1,14), pw3); \
    l_reg+=sacc; \
    if(GK){DMA_K((t)+3,sl_cur);} if(GV){DMA_V((t)+1,sl_next);} \
    CMASK(C0,C1,t); \
    { float a=MX3(C0[0],C0[1],C1[0]),b=MX3(C0[2],C0[3],C1[1]); a=MX3(a,C1[2],C1[3]); \
      _Pragma("unroll") for(int r=4;r<16;r+=4){a=MX3(a,C0[r],C0[r+1]);b=MX3(b,C0[r+2],C0[r+3]);a=MX3(a,C1[r],C1[r+1]);b=MX3(b,C1[r+2],C1[r+3]);} \
      float rm=__builtin_fmaxf(a,b); { auto rr=__builtin_amdgcn_permlane32_swap(__float_as_uint(rm),__float_as_uint(rm),false,false); rm=__builtin_fmaxf(__uint_as_float(rr[0]),__uint_as_float(rr[1])); } \
      resc=false; \
      if(__builtin_expect(__any(rm>(float)THRL),0)){ const float dl=__builtin_fmaxf(rm,0.f); mhat+=dl; \
        _Pragma("unroll") for(int r=0;r<16;++r){C0[r]-=dl;C1[r]-=dl;} \
        const float f=__builtin_amdgcn_exp2f(-dl); l_reg*=f; if(hi==0)wsf[r32]=f; resc=true; } } \
    SBAR(); \
    GAPB(o[0]=__builtin_amdgcn_mfma_f32_32x32x16_bf16(PAF(0),VFR(0),o[0],0,0,0), C0,0); \
    GAPB(o[1]=__builtin_amdgcn_mfma_f32_32x32x16_bf16(PAF(0),VFR(4),o[1],0,0,0), C0,4); \
    KRD(GL,0); GAPB(o[0]=__builtin_amdgcn_mfma_f32_32x32x16_bf16(PAF(1),VFR(1),o[0],0,0,0), C0,8); \
    KRD(GL,1); GAPB(o[1]=__builtin_amdgcn_mfma_f32_32x32x16_bf16(PAF(1),VFR(5),o[1],0,0,0), C0,12); \
    KRD(GL,2); GAPB(o[0]=__builtin_amdgcn_mfma_f32_32x32x16_bf16(PAF(2),VFR(2),o[0],0,0,0), C1,0); \
    KRD(GL,3); GAPB(o[1]=__builtin_amdgcn_mfma_f32_32x32x16_bf16(PAF(2),VFR(6),o[1],0,0,0), C1,4); \
    GAPB(o[0]=__builtin_amdgcn_mfma_f32_32x32x16_bf16(PAF(3),VFR(3),o[0],0,0,0), C1,8); \
    GAPB(o[1]=__builtin_amdgcn_mfma_f32_32x32x16_bf16(PAF(3),VFR(7),o[1],0,0,0), C1,12); \
    }while(0)
  int t=1;
  #undef CMASK
  #define CMASK(P0,P1,t) do{}while(0)
  for(;t+5<NT;t+=2){
    STEP(pB0,pB1,pA0,pA1,t,true,true,true);     WAIT_BAR(2); RESC(); ROT();
    STEP(pA0,pA1,pB0,pB1,t+1,true,true,true);   WAIT_BAR(2); RESC(); ROT();
  }
  #undef CMASK
  #define CMASK(P0,P1,t) do{int jb_=(t)-(NT-4); if(jb_>=0)cmask(P0,P1,jb_,qrel,hi);}while(0)
  #define ENDW(tt) do{ if((tt)+3<NT){WAIT_BAR(2);} else if((tt)+2<NT){WAIT_BAR(1);} else {WAIT_BAR(0);} }while(0)
  for(;t+1<NT;t+=2){
    STEP(pB0,pB1,pA0,pA1,t,(t+3<NT),(t+1<NT),(t+1<NT));       ENDW(t);   RESC(); ROT();
    STEP(pA0,pA1,pB0,pB1,t+1,(t+4<NT),(t+2<NT),(t+2<NT));     ENDW(t+1); RESC(); ROT();
  }
  STEP(pB0,pB1,pA0,pA1,NT-1,false,false,false); RESC();
  { float sacc=pB0[0]+pB0[1]; _Pragma("unroll") for(int r=2;r<16;++r)sacc+=pB0[r]; _Pragma("unroll") for(int r=0;r<16;++r)sacc+=pB1[r]; l_reg+=sacc;
    pw0=(u32x4){PKW(pB0,0),PKW(pB0,2),PKW(pB0,4),PKW(pB0,6)};pw1=(u32x4){PKW(pB0,8),PKW(pB0,10),PKW(pB0,12),PKW(pB0,14)};pw2=(u32x4){PKW(pB1,0),PKW(pB1,2),PKW(pB1,4),PKW(pB1,6)};pw3=(u32x4){PKW(pB1,8),PKW(pB1,10),PKW(pB1,12),PKW(pB1,14)};
    SBAR(); pv(o,vb0+sl_cur,PAF(0),PAF(1),PAF(2),PAF(3)); }
  #undef PKW
  #undef PAF
  #undef VFR
  #undef PIN
  #undef MX3
  #undef GAPA
  #undef GAPB
  #undef EX
  #undef VRD
  #undef KRD
  #undef STEP
  #undef ENDW
  {auto rr=__builtin_amdgcn_permlane32_swap(__float_as_uint(l_reg),__float_as_uint(l_reg),false,false);l_reg=__uint_as_float(rr[0])+__uint_as_float(rr[1]);}
  if(hi==0)wsf[32+r32]=l_reg;asm volatile("s_waitcnt lgkmcnt(0)":::"memory");
  float rli[16];
  #pragma unroll
  for(int r=0;r<16;++r)rli[r]=__builtin_amdgcn_rcpf(wsf[32+crow(r,hi)]);
  bf16*Ow=O+(rowbase+q0+wid*QBLK)*DM+h*D; const bf16*Gw=Gt+(rowbase+q0+wid*QBLK)*DM+h*D;
  { bf16*stg=(bf16*)(shm+LDS_OST)+wid*2048;
    #pragma unroll
    for(int r=0;r<16;++r){const int orow=crow(r,hi);
      #pragma unroll
      for(int d0=0;d0<2;++d0)stg[orow*64+d0*32+r32]=__float2bfloat16(o[d0][r]*rli[r]);}
    asm volatile("s_waitcnt lgkmcnt(0)":::"memory");
    #pragma unroll
    for(int i=0;i<4;++i){const int row=i*8+(lane>>3),ch=lane&7; const u32x4 v=*(const u32x4*)(stg+row*64+ch*8); const u32x4 g=*(const u32x4*)(Gw+(long)row*DM+ch*8); u32x4 w;
      #pragma unroll
      for(int e=0;e<4;++e){ const float o0=__uint_as_float(v[e]<<16),o1=__uint_as_float(v[e]&0xffff0000u),g0=__uint_as_float(g[e]<<16),g1=__uint_as_float(g[e]&0xffff0000u);
        w[e]=cvtpk_s(o0*g0*__builtin_amdgcn_rcpf(1.f+__expf(-g0)),o1*g1*__builtin_amdgcn_rcpf(1.f+__expf(-g1))); }
      ATTN_STORE16(Ow+(long)row*DM+ch*8,w);} }
  asm volatile("s_waitcnt lgkmcnt(0)\n\ts_barrier":::"memory");
  #undef DMA_K
  #undef DMA_V
  #undef CMASK
  #undef START
  #undef RESC
  #undef ROT
  #undef MKQM
  #undef BIAS
}
constexpr int ATTN_LDS_BYTES=LDS_BYTES;
struct AttnTensors { const bf16* Q; const bf16* K; const bf16* V; const float* CB; const unsigned* QKM; const bf16* G; bf16* O; };
struct AttnUnit { int bh; int qb; };
struct StaticOrder {
  int vcu;
  __device__ __forceinline__ explicit StaticOrder(int grid,int block):vcu((block%8)*(grid/8)+block/8){}
  __device__ __forceinline__ bool next(int i,AttnUnit&u)const{ if(i>=4)return false; const int s=vcu&7; u.bh=vcu>>3; u.qb=(i==0)?s:(i==1)?15-s:(i==2)?16+s:31-s; return true; }
  __device__ __forceinline__ void a_ready(const AttnUnit&)const{}
  __device__ __forceinline__ void done(const AttnUnit&)const{}
};
template<class Sched,int THRL=8> __device__ __forceinline__ void attn_phase(char*lds,const AttnTensors&T,const Sched&S,const int wave_k){
  AttnUnit u;
  for(int i=0;S.next(i,u);++i){ S.a_ready(u); attn_unit<THRL>(u.bh/NHEAD,u.bh%NHEAD,u.qb,T.Q,T.K,T.V,T.CB,T.QKM,T.G,T.O,lds,wave_k); S.done(u); }
}
#undef SBAR
#undef WAIT_BAR
}

#define LAS __attribute__((address_space(3)))
#define XB_TMO      128
#define XB_XCNT(j)  (256  + 64 * (j))
#define XB_XSUB(j)  (1280 + 64 * (j))
#define XB_XGEN(j)  (2304 + 64 * (j))
#define XB_TOP      3328
#define XB_TOPGEN   3392
#define XCD_BAR_WORDS 3456
#define XB_SPIN_CAP (1u << 18)

__device__ __forceinline__ unsigned xb_ld(unsigned* p)              { return __hip_atomic_load(p, __ATOMIC_RELAXED, __HIP_MEMORY_SCOPE_AGENT); }
__device__ __forceinline__ unsigned xb_add(unsigned* p, unsigned v) { return __hip_atomic_fetch_add(p, v, __ATOMIC_RELAXED, __HIP_MEMORY_SCOPE_AGENT); }
__device__ __forceinline__ unsigned xb_xcc_id() { return (unsigned)__builtin_amdgcn_s_getreg((3 << 11) | 20) & 0xFu; }
#define XB_SPIN(cond, bar) do { unsigned _sp = 0; while (cond) { __builtin_amdgcn_s_sleep(1); \
    if ((++_sp & 255u) == 0u) { if (xb_ld(&(bar)[XB_TMO])) break; if (_sp > XB_SPIN_CAP) { atomicAdd(&(bar)[XB_TMO], 1u); break; } } } } while (0)

struct XcdBarrier {
    unsigned* bar; unsigned x;
    volatile LAS unsigned* st;
};

__device__ __forceinline__ XcdBarrier xcd_barrier_post(unsigned* bar, volatile LAS unsigned* st) {
    XcdBarrier b; b.bar = bar; b.x = xb_xcc_id(); b.st = st;
    if (threadIdx.x == 0) (void)xb_add(&bar[XB_XCNT(b.x)], 1u);
    return b;
}
__device__ __forceinline__ void xcd_barrier_complete(unsigned* bar, unsigned x_in, unsigned& nloc, unsigned& nx) { unsigned x = x_in;
    const unsigned G = gridDim.x * gridDim.y * gridDim.z;
    asm volatile("" : "+s"(x));
    unsigned sum, cnt, mine, sp = 0u;
    for (;;) {
        sum = 0u; cnt = 0u; mine = 0u;
#pragma unroll
        for (unsigned j = 0; j < 16; ++j) { const unsigned c = xb_ld(&bar[XB_XCNT(j)]); sum += c; cnt += (c > 0u) ? 1u : 0u; mine = (j == x) ? c : mine; }
        if (sum == G) break;
        __builtin_amdgcn_s_sleep(1);
        if ((++sp & 255u) == 0u) { if (xb_ld(&bar[XB_TMO])) break; if (sp > XB_SPIN_CAP) { atomicAdd(&bar[XB_TMO], 1u); break; } }
    }
    nloc = mine > 0u ? mine : 1u; nx = cnt > 0u ? cnt : 1u;
}

__device__ __forceinline__ void xcd_barrier(const XcdBarrier& b, const bool t0  ) {
    asm volatile("s_waitcnt vmcnt(0)" ::: "memory");
    __syncthreads();
    if (t0) {
        unsigned* bar = b.bar;
        __builtin_amdgcn_s_waitcnt(0);
        unsigned nloc = b.st[0], nx = b.st[1];
        if (nloc == 0u) { xcd_barrier_complete(bar, b.x, nloc, nx); b.st[0] = nloc; b.st[1] = nx; }
        const unsigned old = xb_add(&bar[XB_XSUB(b.x)], 1u);
        const unsigned gen = old / nloc;
        if (old + 1u == (gen + 1u) * nloc) {
            __builtin_amdgcn_fence(__ATOMIC_RELEASE, "agent");
            asm volatile("s_waitcnt vmcnt(0)" ::: "memory");
            const unsigned og = xb_add(&bar[XB_TOP], 1u);
            const unsigned tg = og / nx;
            if (og + 1u == (tg + 1u) * nx) xb_add(&bar[XB_TOPGEN], 1u);
            else XB_SPIN(xb_ld(&bar[XB_TOPGEN]) == tg, bar);
            __builtin_amdgcn_fence(__ATOMIC_ACQUIRE, "agent");
            xb_add(&bar[XB_XGEN(b.x)], 1u);
            asm volatile("s_waitcnt vmcnt(0)" ::: "memory");
        } else {
            XB_SPIN(xb_ld(&bar[XB_XGEN(b.x)]) == gen, bar);
            __builtin_amdgcn_fence(__ATOMIC_ACQUIRE, "agent");
            asm volatile("s_waitcnt vmcnt(0)" ::: "memory");
        }
    }
    __syncthreads();
}

typedef unsigned short bf16_t;
typedef short bf16x8 __attribute__((ext_vector_type(8)));
typedef float f32x4 __attribute__((ext_vector_type(4)));
typedef unsigned u32x4 __attribute__((ext_vector_type(4)));
typedef unsigned u32x2 __attribute__((ext_vector_type(2)));
__device__ __forceinline__ float bf2f(bf16_t v) { return __uint_as_float((unsigned)v << 16); }
__device__ __forceinline__ unsigned f2bfu(float f) { unsigned u = __float_as_uint(f); return (u + 0x7fffu + ((u >> 16) & 1u)) >> 16; }
__device__ __forceinline__ bf16_t f2bf(float f) { return (bf16_t)f2bfu(f); }
__device__ __forceinline__ unsigned pk2(float lo, float hi) { return f2bfu(lo) | (f2bfu(hi) << 16); }
__device__ __forceinline__ float sigmoidf_(float x) { return __builtin_amdgcn_rcpf(1.0f + __expf(-x)); }
__device__ __forceinline__ float siluf_(float x) { return x * __builtin_amdgcn_rcpf(1.0f + __expf(-x)); }
template <int CTRL> __device__ __forceinline__ float dppf(float v) { return __int_as_float(__builtin_amdgcn_update_dpp(0, __float_as_int(v), CTRL, 0xf, 0xf, true)); }
__device__ __forceinline__ float allred16(float v) { v += dppf<0xB1>(v); v += dppf<0x4E>(v); v += dppf<0x141>(v); v += dppf<0x140>(v); return v; }
__device__ __forceinline__ float rdlane(float v, int l) { return __int_as_float(__builtin_amdgcn_readlane(__float_as_int(v), l)); }
__device__ __forceinline__ float wave_sum(float v) { v = allred16(v); return (rdlane(v, 0) + rdlane(v, 16)) + (rdlane(v, 32) + rdlane(v, 48)); }
__device__ __forceinline__ void ld8bf(const bf16_t* p, float (&o)[8]) {
    const u32x4 v = *(const u32x4*)p;
#pragma unroll
    for (int i = 0; i < 4; ++i) { o[2 * i] = __uint_as_float(v[i] << 16); o[2 * i + 1] = __uint_as_float(v[i] & 0xffff0000u); }
}
__device__ __forceinline__ void ld4bf(const bf16_t* p, float (&o)[4]) {
    const u32x2 v = *(const u32x2*)p;
#pragma unroll
    for (int i = 0; i < 2; ++i) { o[2 * i] = __uint_as_float(v[i] << 16); o[2 * i + 1] = __uint_as_float(v[i] & 0xffff0000u); }
}

__device__ __forceinline__ unsigned pk_expneg(float lo, float hi) {
    const float a = __builtin_amdgcn_exp2f(lo * -LOG2E), b = __builtin_amdgcn_exp2f(hi * -LOG2E); unsigned r;
    asm volatile("s_nop 1\n\tv_cvt_pk_bf16_f32 %0, %1, %2" : "=v"(r) : "v"(a), "v"(b)); return r;
}
struct EpiG1 {
    static constexpr bool PERM = true, AFTER_DRAIN = false; static constexpr int NST = 16; unsigned char* ws;
    __device__ __forceinline__ void operator()(const f32x4 (&acc)[2][2][4][2], const pg8::Unit& u, int wr, int wc, int fr, int fq) const {
        const int pn = u.pn, row0 = u.pm * 256 + wr * 64 + fr, cin = wc * 32 + 8 * fq;
        if (pn == 56) {
            float* S = (float*)(ws + O_S);
#pragma unroll
            for (int ai = 0; ai < 2; ++ai)
#pragma unroll
                for (int m = 0; m < 4; ++m) { float* rp = S + (size_t)(row0 + ai * 128 + m * 16) * 256 + cin;
#pragma unroll
                    for (int bj = 0; bj < 2; ++bj) { *(f32x4*)(rp + bj * 128) = acc[ai][bj][m][0]; *(f32x4*)(rp + bj * 128 + 4) = acc[ai][bj][m][1]; } }
            return;
        }
        size_t off; int ldc, coff; float sc = 1.f;
        if (pn < 16) { off = O_UA; ldc = 4096; coff = pn * 256; }
        else if (pn < 28) { off = O_UB; ldc = 3072; coff = (pn - 16) * 256; }
        else if (pn < 56) { const int sidx = (pn - 28) >> 2; off = O_GB + (size_t)sidx * (32 * MiB); ldc = 1024; coff = ((pn - 28) & 3) * 256; if (sidx == 1) sc = C2; }
        else { off = O_ML; ldc = 8192; coff = (pn - 57) * 256; }
        bf16_t* base = (bf16_t*)(ws + off) + coff + cin;
#pragma unroll
        for (int ai = 0; ai < 2; ++ai)
#pragma unroll
            for (int m = 0; m < 4; ++m) { bf16_t* rowp = base + (size_t)(row0 + ai * 128 + m * 16) * ldc;
#pragma unroll
                for (int bj = 0; bj < 2; ++bj) { const f32x4 v0 = acc[ai][bj][m][0] * sc, v1 = acc[ai][bj][m][1] * sc; u32x4 w;
                    if (pn >= 57) { w.x = pk_expneg(v0[0], v0[1]); w.y = pk_expneg(v0[2], v0[3]); w.z = pk_expneg(v1[0], v1[1]); w.w = pk_expneg(v1[2], v1[3]); }
                    else { w.x = pg8::cvt_pk_bf16(v0[0], v0[1]); w.y = pg8::cvt_pk_bf16(v0[2], v0[3]); w.z = pg8::cvt_pk_bf16(v1[0], v1[1]); w.w = pg8::cvt_pk_bf16(v1[2], v1[3]); }
                    *(u32x4*)(rowp + bj * 128) = w; } }
    }
};
struct EpiML {
    static constexpr bool PERM = true, AFTER_DRAIN = false; static constexpr int NST = 16; unsigned char* ws;
    __device__ __forceinline__ void operator()(const f32x4 (&acc)[2][2][4][2], const pg8::Unit& u, int wr, int wc, int fr, int fq) const {
        const int row0 = u.pm * 256 + wr * 64 + fr; bf16_t* base = (bf16_t*)(ws + O_ML) + (u.pn + 3) * 256 + wc * 32 + 8 * fq;
#pragma unroll
        for (int ai = 0; ai < 2; ++ai)
#pragma unroll
            for (int m = 0; m < 4; ++m) { bf16_t* rowp = base + (size_t)(row0 + ai * 128 + m * 16) * 8192;
#pragma unroll
                for (int bj = 0; bj < 2; ++bj) { const f32x4 v0 = acc[ai][bj][m][0], v1 = acc[ai][bj][m][1]; u32x4 w;
                    w.x = pk_expneg(v0[0], v0[1]); w.y = pk_expneg(v0[2], v0[3]); w.z = pk_expneg(v1[0], v1[1]); w.w = pk_expneg(v1[2], v1[3]);
                    *(u32x4*)(rowp + bj * 128) = w; } }
    }
};
struct PoolOrder {
    int G, c;
    __device__ bool next(int i, pg8::Unit& u) const { const int j = i * G + c; if (j >= 256) return false; u.pm = j; u.pn = j >> 6; return true; }
    __device__ __forceinline__ void a_ready(const pg8::Unit&) const {}
    __device__ __forceinline__ void done(const pg8::Unit&) const {}
};
struct RangeOrder {
    pg8::StaticOrder S; int i0, i1;
    __device__ bool next(int i, pg8::Unit& u) const { return (i0 + i < i1) && S.next(i0 + i, u); }
    __device__ __forceinline__ void a_ready(const pg8::Unit&) const {}
    __device__ __forceinline__ void done(const pg8::Unit&) const {}
};
struct EpiPool {
    static constexpr bool PERM = true, AFTER_DRAIN = false; static constexpr int NST = 16; unsigned char* ws; const float* ps;
    __device__ __forceinline__ void operator()(const f32x4 (&acc)[2][2][4][2], const pg8::Unit& u, int wr, int wc, int fr, int fq) const {
        const int g = u.pn, row0 = (u.pm & 63) * 256 + wr * 64 + fr, col0 = g * 256 + wc * 32 + 8 * fq;
        const bf16_t* GD = (const bf16_t*)(ws + O_GD) + col0; bf16_t* Y = (bf16_t*)(ws + O_Y) + (size_t)3 * T * W + col0; const float* psc = ps + col0;
#pragma unroll
        for (int ai = 0; ai < 2; ++ai)
#pragma unroll
            for (int m = 0; m < 4; ++m) { const size_t row = (size_t)(row0 + ai * 128 + m * 16);
#pragma unroll
                for (int bj = 0; bj < 2; ++bj) { float gd[8]; ld8bf(GD + row * W + bj * 128, gd);
                    const f32x4 p0 = *(const f32x4*)(psc + bj * 128), p1 = *(const f32x4*)(psc + bj * 128 + 4); float o[8];
#pragma unroll
                    for (int e = 0; e < 4; ++e) { o[e] = acc[ai][bj][m][0][e] * p0[e] * siluf_(gd[e]); o[4 + e] = acc[ai][bj][m][1][e] * p1[e] * siluf_(gd[4 + e]); }
                    u32x4 w; w.x = pg8::cvt_pk_bf16(o[0], o[1]); w.y = pg8::cvt_pk_bf16(o[2], o[3]); w.z = pg8::cvt_pk_bf16(o[4], o[5]); w.w = pg8::cvt_pk_bf16(o[6], o[7]);
                    *(u32x4*)(Y + row * W + bj * 128) = w; }
                if (m & 1) asm volatile("" ::: "memory"); }
    }
};
struct EpiG2 {
    static constexpr bool PERM = true, AFTER_DRAIN = false; static constexpr int NST = 16; unsigned char* ws; const float* w0; const float* a0;
    __device__ __forceinline__ void operator()(const f32x4 (&acc)[2][2][4][2], const pg8::Unit& u, int wr, int wc, int fr, int fq) const {
        const int row0 = u.pm * 256 + wr * 64 + fr; const bool dec = u.pn < 4; const int col0 = (u.pn & 3) * 256 + wc * 32 + 8 * fq;
        bf16_t* out = (bf16_t*)(ws + (dec ? O_WDEC : O_ASIG)) + col0; const float* bias = (dec ? w0 : a0) + col0;
        const float mul = dec ? 0.6065306597126334f : 1.0f;
#pragma unroll
        for (int ai = 0; ai < 2; ++ai)
#pragma unroll
            for (int m = 0; m < 4; ++m) { bf16_t* rp = out + (size_t)(row0 + ai * 128 + m * 16) * W;
#pragma unroll
                for (int bj = 0; bj < 2; ++bj) { float o[8]; const f32x4 b0 = *(const f32x4*)(bias + bj * 128), b1 = *(const f32x4*)(bias + bj * 128 + 4);
#pragma unroll
                    for (int e = 0; e < 4; ++e) { o[e] = mul * sigmoidf_(acc[ai][bj][m][0][e] + b0[e]); o[4 + e] = mul * sigmoidf_(acc[ai][bj][m][1][e] + b1[e]); }
                    u32x4 w; w.x = pg8::cvt_pk_bf16(o[0], o[1]); w.y = pg8::cvt_pk_bf16(o[2], o[3]); w.z = pg8::cvt_pk_bf16(o[4], o[5]); w.w = pg8::cvt_pk_bf16(o[6], o[7]);
                    *(u32x4*)(rp + bj * 128) = w; }
                asm volatile("" ::: "memory"); }
    }
};
struct EpiG3Q {
    static constexpr bool PERM = true, AFTER_DRAIN = false; static constexpr int NST = 16; unsigned char* ws; const float* bm; int wg;
    __device__ __forceinline__ void operator()(const f32x4 (&acc)[2][2][4][2], const pg8::Unit& u, int wr, int wc, int fr, int fq) const {
        const int kb = u.pn >> 3, pn = u.pn & 7, pm = u.pm & 63;
        const size_t slab = ((size_t)(wg >> 3) * 3) * (256 * D) + (size_t)(wg & 7) * 256 - ((size_t)pm * 256 * D + (size_t)pn * 256);
        const int row0 = pm * 256 + wr * 64 + fr, col0 = pn * 256 + wc * 32 + 8 * fq;
        const bf16_t* ML = (const bf16_t*)(ws + O_ML) + kb * 2048 + col0; const float* bmk = bm + kb * 2048 + col0;
        f32x4 bv[2][2];
#pragma unroll
        for (int bj = 0; bj < 2; ++bj) { bv[bj][0] = *(const f32x4*)(bmk + bj * 128); bv[bj][1] = *(const f32x4*)(bmk + bj * 128 + 4);
#pragma unroll
            for (int e = 0; e < 4; ++e) { bv[bj][0][e] = __builtin_amdgcn_exp2f(bv[bj][0][e] * -LOG2E); bv[bj][1][e] = __builtin_amdgcn_exp2f(bv[bj][1][e] * -LOG2E); } }
#define GATE_(e_, eb_) __builtin_amdgcn_rcpf(__builtin_fmaf((e_), (eb_), 1.0f))
        if (kb < 3) {
            bf16_t* GP = (bf16_t*)(ws + O_GP) + slab + (size_t)kb * (256 * D) + col0;
#pragma unroll
            for (int ai = 0; ai < 2; ++ai) {
                u32x4 mlv[4][2];
#pragma unroll
                for (int m = 0; m < 4; ++m)
#pragma unroll
                    for (int bj = 0; bj < 2; ++bj) mlv[m][bj] = *(const u32x4*)(ML + (size_t)(row0 + ai * 128 + m * 16) * 8192 + bj * 128);
#pragma unroll
                for (int m = 0; m < 4; ++m) { const size_t row = (size_t)(row0 + ai * 128 + m * 16);
#pragma unroll
                    for (int bj = 0; bj < 2; ++bj) {
                        float ml[8];
#pragma unroll
                        for (int i = 0; i < 4; ++i) { ml[2 * i] = __uint_as_float(mlv[m][bj][i] << 16); ml[2 * i + 1] = __uint_as_float(mlv[m][bj][i] & 0xffff0000u); }
                        f32x4 s0, s1;
#pragma unroll
                        for (int e = 0; e < 4; ++e) { s0[e] = GATE_(ml[e], bv[bj][0][e]) * acc[ai][bj][m][0][e]; s1[e] = GATE_(ml[4 + e], bv[bj][1][e]) * acc[ai][bj][m][1][e]; }
                        u32x4 w; w.x = pg8::cvt_pk_bf16(s0[0], s0[1]); w.y = pg8::cvt_pk_bf16(s0[2], s0[3]); w.z = pg8::cvt_pk_bf16(s1[0], s1[1]); w.w = pg8::cvt_pk_bf16(s1[2], s1[3]);
                        *(u32x4*)(GP + row * D + bj * 128) = w;
                    } }
                asm volatile("" ::: "memory"); }
        } else {
            const bf16_t* GP = (const bf16_t*)(ws + O_GP) + slab + col0; bf16_t* MG = (bf16_t*)(ws + O_MG) + col0;
#pragma unroll
            for (int ai = 0; ai < 2; ++ai)
#pragma unroll
                for (int mp = 0; mp < 2; ++mp) {
                    u32x4 mlv[2][2], gp[3][2][2];
#pragma unroll
                    for (int mm = 0; mm < 2; ++mm)
#pragma unroll
                        for (int bj = 0; bj < 2; ++bj) { const size_t row = (size_t)(row0 + ai * 128 + (2 * mp + mm) * 16);
                            mlv[mm][bj] = *(const u32x4*)(ML + row * 8192 + bj * 128);
#pragma unroll
                            for (int k = 0; k < 3; ++k) gp[k][mm][bj] = *(const u32x4*)(GP + (size_t)k * (256 * D) + row * D + bj * 128); }
#pragma unroll
                    for (int mm = 0; mm < 2; ++mm) { const int m = 2 * mp + mm; const size_t row = (size_t)(row0 + ai * 128 + m * 16);
#pragma unroll
                        for (int bj = 0; bj < 2; ++bj) { u32x4 w;
#pragma unroll
                            for (int i = 0; i < 4; ++i) { const int n = i >> 1, e = (i & 1) * 2;
                                float lo = GATE_(__uint_as_float(mlv[mm][bj][i] << 16), bv[bj][n][e]) * acc[ai][bj][m][n][e], hi = GATE_(__uint_as_float(mlv[mm][bj][i] & 0xffff0000u), bv[bj][n][e + 1]) * acc[ai][bj][m][n][e + 1];
#pragma unroll
                                for (int k = 0; k < 3; ++k) { lo += __uint_as_float(gp[k][mm][bj][i] << 16); hi += __uint_as_float(gp[k][mm][bj][i] & 0xffff0000u); }
                                w[i] = pg8::cvt_pk_bf16(lo, hi); }
                            *(u32x4*)(MG + row * D + bj * 128) = w; } }
                    asm volatile("" ::: "memory"); }
        }
#undef GATE_
    }
};
struct BranchOrder {
    pg8::StaticOrder S0;
    __device__ void init(int G, int c) { S0.init(T, D, G, c); }
    __device__ bool next(int i, pg8::Unit& u) const { pg8::Unit t; if (!S0.next(i >> 2, t)) return false; const int kb = i & 3; u.pm = kb * 64 + t.pm; u.pn = kb * 8 + t.pn; return true; }
    __device__ __forceinline__ void a_ready(const pg8::Unit&) const {}
    __device__ __forceinline__ void done(const pg8::Unit&) const {}
};
__device__ __forceinline__ void g3_sum(unsigned char* ws, const BranchOrder& S, int tid) {
    const bf16_t* GP = (const bf16_t*)(ws + O_GP); bf16_t* MG = (bf16_t*)(ws + O_MG);
    pg8::Unit t;
    for (int j = 0; S.S0.next(j, t); ++j)
        for (int i0 = tid; i0 < 256 * 32; i0 += 4 * 512) {
            u32x4 v[4][4];
#pragma unroll
            for (int q = 0; q < 4; ++q) { const int i = i0 + q * 512, r = i >> 5, c8 = (i & 31) * 8; const size_t off = (size_t)(t.pm * 256 + r) * D + t.pn * 256 + c8;
#pragma unroll
                for (int kb = 0; kb < 4; ++kb) v[q][kb] = *(const u32x4*)(GP + (size_t)kb * T * D + off); }
#pragma unroll
            for (int q = 0; q < 4; ++q) { const int i = i0 + q * 512, r = i >> 5, c8 = (i & 31) * 8; const size_t off = (size_t)(t.pm * 256 + r) * D + t.pn * 256 + c8; u32x4 w;
#pragma unroll
                for (int e = 0; e < 4; ++e) { float lo = 0.f, hi = 0.f;
#pragma unroll
                    for (int kb = 0; kb < 4; ++kb) { lo += __uint_as_float(v[q][kb][e] << 16); hi += __uint_as_float(v[q][kb][e] & 0xffff0000u); }
                    w[e] = pk2(lo, hi); }
                *(u32x4*)(MG + off) = w; }
        }
}
struct EpiG4 {
    static constexpr bool PERM = true, AFTER_DRAIN = false; static constexpr int NST = 32; const float* xin32; const bf16_t* xinb; bf16_t* xout;
    __device__ __forceinline__ void operator()(const f32x4 (&acc)[2][2][4][2], const pg8::Unit& u, int wr, int wc, int fr, int fq) const {
        const int row0 = u.pm * 256 + wr * 64 + fr, col0 = u.pn * 256 + wc * 32 + 8 * fq;
        if (xin32) {
#pragma unroll
            for (int q8 = 0; q8 < 4; ++q8) { const int ai = q8 >> 1, m0 = (q8 & 1) * 2;
                f32x4 xv[2][2][2];
#pragma unroll
                for (int mm = 0; mm < 2; ++mm) { const size_t off = (size_t)(row0 + ai * 128 + (m0 + mm) * 16) * D + col0;
#pragma unroll
                    for (int bj = 0; bj < 2; ++bj) { xv[mm][bj][0] = *(const f32x4*)(xin32 + off + bj * 128); xv[mm][bj][1] = *(const f32x4*)(xin32 + off + bj * 128 + 4); } }
#pragma unroll
                for (int mm = 0; mm < 2; ++mm) { const size_t off = (size_t)(row0 + ai * 128 + (m0 + mm) * 16) * D + col0;
#pragma unroll
                    for (int bj = 0; bj < 2; ++bj) { const f32x4 x0 = xv[mm][bj][0] + acc[ai][bj][m0 + mm][0], x1 = xv[mm][bj][1] + acc[ai][bj][m0 + mm][1]; u32x4 w;
                        w.x = pg8::cvt_pk_bf16(x0[0], x0[1]); w.y = pg8::cvt_pk_bf16(x0[2], x0[3]); w.z = pg8::cvt_pk_bf16(x1[0], x1[1]); w.w = pg8::cvt_pk_bf16(x1[2], x1[3]);
                        *(u32x4*)(xout + off + bj * 128) = w; } }
                asm volatile("" ::: "memory"); }
        } else {
#pragma unroll
            for (int ai = 0; ai < 2; ++ai) {
                u32x4 xv[4][2];
#pragma unroll
                for (int m = 0; m < 4; ++m)
#pragma unroll
                    for (int bj = 0; bj < 2; ++bj) xv[m][bj] = *(const u32x4*)(xinb + (size_t)(row0 + ai * 128 + m * 16) * D + col0 + bj * 128);
#pragma unroll
                for (int m = 0; m < 4; ++m) { const size_t off = (size_t)(row0 + ai * 128 + m * 16) * D + col0;
#pragma unroll
                    for (int bj = 0; bj < 2; ++bj) { u32x4 w;
#pragma unroll
                        for (int i = 0; i < 4; ++i) { const int n = i >> 1, e = (i & 1) * 2;
                            const float lo = __uint_as_float(xv[m][bj][i] << 16) + acc[ai][bj][m][n][e], hi = __uint_as_float(xv[m][bj][i] & 0xffff0000u) + acc[ai][bj][m][n][e + 1];
                            w[i] = pg8::cvt_pk_bf16(lo, hi); }
                        *(u32x4*)(xout + off + bj * 128) = w; } }
                asm volatile("" ::: "memory"); }
        }
    }
};
__device__ __forceinline__ int win_col(int n) {
    if (n < PGB) return n;
    if (n < PQ) return OBG + (n - PGB);
    if (n < PGC) return OCQ + (n - PQ);
    if (n < PUD) return OCG + (n - PGC);
    if (n < PGD) return ODI + (n - PUD);
    if (n < PS) return ODG + (n - PGD);
    if (n < PML) { const int j = n - PS; if (j < 64) return OWL + j; if (j < 128) return OAL + (j - 64); if (j < 144) return OCF + (j - 128); return -1; }
    return OML + (n - PML);
}
__device__ __forceinline__ void p1_weights(const Params& p, LAS unsigned char* lds, int gw, int ngw, int wave, int lane, size_t gt, size_t ngt) {
    LAS float* scr = (LAS float*)(lds + wave * 9216);
    constexpr int I0 = 4 * (NP / 32) * (D / 64), I1 = 16 * (D / 32) * (W / 64), I2 = 4 * (D / 32) * (D / 64), I3 = 16 * (256 / 32) * (256 / 64);
    for (int it = gw; it < I0 + I1 + I2 + I3; it += ngw) {
        int mode, r = it; if (r < I0) mode = 0; else if (r < I0 + I1) { mode = 1; r -= I0; } else if (r < I0 + I1 + I2) { mode = 2; r -= I0 + I1; } else { mode = 3; r -= I0 + I1 + I2; }
        const int N = (mode == 0) ? NP : (mode == 3 ? 256 : D), K = (mode == 1) ? W : (mode == 3 ? 256 : D), nb = N / 32, per = nb * (K / 64);
        const int mat = r / per, q = r % per, n0 = (q % nb) * 32, k0 = (q / nb) * 64, n4 = (lane & 7) * 4, kr = lane >> 3;
        const float* src; long ld; bf16_t* dst; int col;
        if (mode == 0) { col = win_col(n0 + n4); src = p.in[I_WIN] + (size_t)mat * D * NIN; ld = NIN; dst = (bf16_t*)(p.ws + O_WTIN) + (size_t)mat * NP * D; }
        else if (mode == 1) { src = p.in[I_WB] + (size_t)mat * W * D; ld = D; col = n0 + n4; dst = (bf16_t*)(p.ws + O_WTBR) + (size_t)mat * D * W; }
        else if (mode == 2) { src = p.in[I_WO] + (size_t)mat * D * D; ld = D; col = n0 + n4; dst = (bf16_t*)(p.ws + O_WTOUT) + (size_t)mat * D * D; }
        else { src = p.in[I_PW] + (size_t)mat * 65536; ld = 256; col = n0 + n4; dst = (bf16_t*)(p.ws + O_WD) + (size_t)mat * 65536; }
#pragma unroll
        for (int i = 0; i < 8; ++i) { const int kk = 8 * i + kr; const f32x4 v = (col >= 0) ? *(const f32x4*)(src + (size_t)(k0 + kk) * ld + col) : (f32x4){0.f, 0.f, 0.f, 0.f}; *(LAS f32x4*)(scr + kk * 36 + n4) = v; }
        asm volatile("s_waitcnt lgkmcnt(0)" ::: "memory");
        const int c = lane & 7;
#pragma unroll
        for (int j = 0; j < 4; ++j) { const int n = (lane >> 3) + 8 * j; const LAS float* sp = scr + (8 * c) * 36 + n; u32x4 o;
            o.x = pk2(sp[0 * 36], sp[1 * 36]); o.y = pk2(sp[2 * 36], sp[3 * 36]); o.z = pk2(sp[4 * 36], sp[5 * 36]); o.w = pk2(sp[6 * 36], sp[7 * 36]);
            *(u32x4*)(dst + (size_t)(n0 + n) * K + k0 + 8 * c) = o; }
        asm volatile("s_waitcnt lgkmcnt(0)" ::: "memory");
    }
    for (size_t i = gt; i < (size_t)4 * 2048 * 256; i += ngt) {
        const int k = (int)(i & 255), n = (int)((i >> 8) & 2047), l = (int)(i >> 19);
        float v = 0.f;
        if (n < 1024) { if (k < 64) v = p.in[I_W2][((size_t)l * 64 + k) * W + n]; }
        else { if (k >= 64 && k < 128) v = p.in[I_A2][((size_t)l * 64 + (k - 64)) * W + (n - 1024)]; }
        ((bf16_t*)(p.ws + O_WTLORA))[i] = f2bf(v);
    }
}
__device__ __forceinline__ void e_rmsnorm(const float* __restrict__ x, const float* __restrict__ g, bf16_t* __restrict__ h, float* __restrict__ outf, int gw, int ngw, int lane, int rend = T) {
    for (int m0 = gw; m0 < rend; m0 += 2 * ngw) {
        const int m1 = (m0 + ngw < rend) ? m0 + ngw : m0;
        const f32x4* xr0 = (const f32x4*)(x + (size_t)m0 * D); const f32x4* xr1 = (const f32x4*)(x + (size_t)m1 * D);
        f32x4 v0[8], v1[8]; float ss0 = 0.f, ss1 = 0.f;
#pragma unroll
        for (int j = 0; j < 8; ++j) { v0[j] = xr0[lane + 64 * j]; v1[j] = xr1[lane + 64 * j]; }
#pragma unroll
        for (int j = 0; j < 8; ++j) { ss0 += (v0[j].x * v0[j].x + v0[j].y * v0[j].y) + (v0[j].z * v0[j].z + v0[j].w * v0[j].w); ss1 += (v1[j].x * v1[j].x + v1[j].y * v1[j].y) + (v1[j].z * v1[j].z + v1[j].w * v1[j].w); }
        ss0 = wave_sum(ss0); ss1 = wave_sum(ss1);
        const float rs0 = rsqrtf(ss0 * (1.0f / D) + 1e-6f), rs1 = rsqrtf(ss1 * (1.0f / D) + 1e-6f);
#pragma unroll
        for (int j = 0; j < 8; ++j) {
            const f32x4 gg = ((const f32x4*)g)[lane + 64 * j];
            const f32x4 o0 = v0[j] * rs0 * gg, o1 = v1[j] * rs1 * gg;
            if (h) { u32x2 w; w.x = pk2(o0.x, o0.y); w.y = pk2(o0.z, o0.w); *(u32x2*)(h + (size_t)m0 * D + (lane + 64 * j) * 4) = w;
                     if (m1 != m0) { w.x = pk2(o1.x, o1.y); w.y = pk2(o1.z, o1.w); *(u32x2*)(h + (size_t)m1 * D + (lane + 64 * j) * 4) = w; } }
            else { ((f32x4*)(outf + (size_t)m0 * D))[lane + 64 * j] = o0; if (m1 != m0) ((f32x4*)(outf + (size_t)m1 * D))[lane + 64 * j] = o1; }
        }
    }
}
__device__ __forceinline__ void e_rmsnorm_bf(const bf16_t* __restrict__ x, const float* __restrict__ g, bf16_t* __restrict__ h, float* __restrict__ outf, int gw, int ngw, int lane, int rend = T) {
    for (int m0 = gw; m0 < rend; m0 += 2 * ngw) {
        const int m1 = (m0 + ngw < rend) ? m0 + ngw : m0;
        const u32x4* xr0 = (const u32x4*)(x + (size_t)m0 * D); const u32x4* xr1 = (const u32x4*)(x + (size_t)m1 * D);
        u32x4 r0[4], r1[4]; float v0[4][8], v1[4][8], ss0 = 0.f, ss1 = 0.f;
#pragma unroll
        for (int j = 0; j < 4; ++j) { r0[j] = xr0[lane + 64 * j]; r1[j] = xr1[lane + 64 * j]; }
#pragma unroll
        for (int j = 0; j < 4; ++j)
#pragma unroll
            for (int i = 0; i < 4; ++i) { v0[j][2 * i] = __uint_as_float(r0[j][i] << 16); v0[j][2 * i + 1] = __uint_as_float(r0[j][i] & 0xffff0000u); v1[j][2 * i] = __uint_as_float(r1[j][i] << 16); v1[j][2 * i + 1] = __uint_as_float(r1[j][i] & 0xffff0000u);
                ss0 += v0[j][2 * i] * v0[j][2 * i] + v0[j][2 * i + 1] * v0[j][2 * i + 1]; ss1 += v1[j][2 * i] * v1[j][2 * i] + v1[j][2 * i + 1] * v1[j][2 * i + 1]; }
        ss0 = wave_sum(ss0); ss1 = wave_sum(ss1);
        const float rs0 = rsqrtf(ss0 * (1.0f / D) + 1e-6f), rs1 = rsqrtf(ss1 * (1.0f / D) + 1e-6f);
#pragma unroll
        for (int j = 0; j < 4; ++j) {
            const f32x4 ga = *(const f32x4*)(g + (lane + 64 * j) * 8), gb = *(const f32x4*)(g + (lane + 64 * j) * 8 + 4);
            float o0[8], o1[8];
#pragma unroll
            for (int e = 0; e < 4; ++e) { o0[e] = v0[j][e] * rs0 * ga[e]; o0[4 + e] = v0[j][4 + e] * rs0 * gb[e]; o1[e] = v1[j][e] * rs1 * ga[e]; o1[4 + e] = v1[j][4 + e] * rs1 * gb[e]; }
            if (h) { u32x4 w; w.x = pk2(o0[0], o0[1]); w.y = pk2(o0[2], o0[3]); w.z = pk2(o0[4], o0[5]); w.w = pk2(o0[6], o0[7]); *(u32x4*)(h + (size_t)m0 * D + (lane + 64 * j) * 8) = w;
                     if (m1 != m0) { w.x = pk2(o1[0], o1[1]); w.y = pk2(o1[2], o1[3]); w.z = pk2(o1[4], o1[5]); w.w = pk2(o1[6], o1[7]); *(u32x4*)(h + (size_t)m1 * D + (lane + 64 * j) * 8) = w; } }
            else { float* p0 = outf + (size_t)m0 * D + (lane + 64 * j) * 8; *(f32x4*)p0 = (f32x4){o0[0], o0[1], o0[2], o0[3]}; *(f32x4*)(p0 + 4) = (f32x4){o0[4], o0[5], o0[6], o0[7]};
                   if (m1 != m0) { float* p1 = outf + (size_t)m1 * D + (lane + 64 * j) * 8; *(f32x4*)p1 = (f32x4){o1[0], o1[1], o1[2], o1[3]}; *(f32x4*)(p1 + 4) = (f32x4){o1[4], o1[5], o1[6], o1[7]}; } }
        }
    }
}
__device__ __forceinline__ void e1_conv(const bf16_t* __restrict__ UA, bf16_t* __restrict__ Y, const float* __restrict__ cw, size_t gt, size_t ngt) {
    for (size_t it = gt; it < (size_t)(T / 4) * 128; it += ngt) {
        const int t0 = (int)(it >> 7) * 4, c = (int)(it & 127) * 8, s0 = t0 & (SEQ - 1);
        float w0[8], w1[8], w2[8], cm2[8], cm1[8], a[8], b2[8];
#pragma unroll
        for (int i = 0; i < 8; ++i) { w0[i] = cw[c + i]; w1[i] = cw[W + c + i]; w2[i] = cw[2 * W + c + i]; cm2[i] = 0.f; cm1[i] = 0.f; }
        u32x4 vb[4], vg[4], va[4], vx[4];
#pragma unroll
        for (int j = 0; j < 4; ++j) { const size_t t = (size_t)(t0 + j); vb[j] = *(const u32x4*)(UA + t * 4096 + c); vg[j] = *(const u32x4*)(UA + t * 4096 + 3072 + c); va[j] = *(const u32x4*)(UA + t * 4096 + 1024 + c); vx[j] = *(const u32x4*)(UA + t * 4096 + 2048 + c); }
        if (s0 > 0) {
            ld8bf(UA + (size_t)(t0 - 2) * 4096 + 1024 + c, a); ld8bf(UA + (size_t)(t0 - 2) * 4096 + 2048 + c, b2);
#pragma unroll
            for (int i = 0; i < 8; ++i) cm2[i] = a[i] * b2[i];
            ld8bf(UA + (size_t)(t0 - 1) * 4096 + 1024 + c, a); ld8bf(UA + (size_t)(t0 - 1) * 4096 + 2048 + c, b2);
#pragma unroll
            for (int i = 0; i < 8; ++i) cm1[i] = a[i] * b2[i];
        }
#pragma unroll
        for (int j = 0; j < 4; ++j) {
            const size_t t = (size_t)(t0 + j);
            float bg[8], g[8], cx[8];
#pragma unroll
            for (int i = 0; i < 4; ++i) { bg[2 * i] = __uint_as_float(vb[j][i] << 16); bg[2 * i + 1] = __uint_as_float(vb[j][i] & 0xffff0000u); g[2 * i] = __uint_as_float(vg[j][i] << 16); g[2 * i + 1] = __uint_as_float(vg[j][i] & 0xffff0000u);
                a[2 * i] = __uint_as_float(va[j][i] << 16); a[2 * i + 1] = __uint_as_float(va[j][i] & 0xffff0000u); b2[2 * i] = __uint_as_float(vx[j][i] << 16); b2[2 * i + 1] = __uint_as_float(vx[j][i] & 0xffff0000u); }
            u32x4 o; float z[8];
#pragma unroll
            for (int i = 0; i < 8; ++i) { cx[i] = a[i] * b2[i]; z[i] = (w0[i] * cm2[i] + w1[i] * cm1[i] + w2[i] * cx[i]) * bg[i] * siluf_(g[i]); cm2[i] = cm1[i]; cm1[i] = cx[i]; }
#pragma unroll
            for (int i = 0; i < 4; ++i) o[i] = pk2(z[2 * i], z[2 * i + 1]);
            *(u32x4*)(Y + t * W + c) = o;
        }
    }
}
__device__ __forceinline__ void e1_pool(const bf16_t* __restrict__ UD, bf16_t* __restrict__ PG, size_t gt, size_t ngt) {
    for (size_t it = gt; it < (size_t)(T / 16) * 128; it += ngt) {
        const int t0 = (int)(it >> 7) * 16, c = (int)(it & 127) * 8, s0 = t0 & (SEQ - 1);
        const int win = 2 << (c >> 8);
        float sum[8], tmp[8], cur[8];
#pragma unroll
        for (int i = 0; i < 8; ++i) sum[i] = 0.f;
        u32x4 cv[16];
#pragma unroll
        for (int j = 0; j < 16; ++j) cv[j] = *(const u32x4*)(UD + (size_t)(t0 + j) * W + c);
        if (s0 > 0) {
#pragma unroll
            for (int j = 1; j < 16; ++j) if (j < win) { ld8bf(UD + (size_t)(t0 - j) * W + c, tmp);
#pragma unroll
                for (int i = 0; i < 8; ++i) sum[i] += tmp[i]; } }
        bf16_t* dst = PG + ((size_t)(c >> 8) * T + t0) * 256 + (c & 255);
#pragma unroll
        for (int j = 0; j < 16; ++j) {
            const int s = s0 + j;
#pragma unroll
            for (int i = 0; i < 4; ++i) { cur[2 * i] = __uint_as_float(cv[j][i] << 16); cur[2 * i + 1] = __uint_as_float(cv[j][i] & 0xffff0000u); }
#pragma unroll
            for (int i = 0; i < 8; ++i) sum[i] += cur[i];
            const int cnt = (s + 1 < win) ? s + 1 : win; const float inv = 1.0f / (float)cnt;
            u32x4 o;
#pragma unroll
            for (int i = 0; i < 4; ++i) o[i] = pk2(sum[2 * i] * inv - cur[2 * i], sum[2 * i + 1] * inv - cur[2 * i + 1]);
            *(u32x4*)(dst + (size_t)j * 256) = o;
            if (s + 1 >= win) {
                ld8bf(UD + ((size_t)(t0 + j) + 1 - win) * W + c, tmp);
#pragma unroll
                for (int i = 0; i < 8; ++i) sum[i] -= tmp[i]; }
        }
    }
}
__device__ __forceinline__ void e1_lora(const float* __restrict__ S, bf16_t* __restrict__ LA, float* __restrict__ LF, const float* __restrict__ mu, const float* __restrict__ bf, size_t gt, size_t ngt) {
#pragma unroll 4
    for (size_t it = gt; it < (size_t)T * 64; it += ngt) {
        const int t = (int)(it >> 6), j = (int)(it & 63) * 4, s = t & (SEQ - 1);
        f32x4 o = {0.f, 0.f, 0.f, 0.f};
        if (j < 128) {
            const f32x4 cur = *(const f32x4*)(S + (size_t)t * 256 + j), prv = (s > 0) ? *(const f32x4*)(S + (size_t)(t - 1) * 256 + j) : (f32x4){0.f, 0.f, 0.f, 0.f}, m4 = *(const f32x4*)(mu + j);
#pragma unroll
            for (int e = 0; e < 4; ++e) { const float xm = cur[e] + (prv[e] - cur[e]) * m4[e]; o[e] = (j < 64) ? (1.0f - 2.0f * __builtin_amdgcn_rcpf(__expf(2.0f * xm) + 1.0f)) : xm; }
        } else if (j < 144) {
            const f32x4 x4 = *(const f32x4*)(S + (size_t)t * 256 + j) + *(const f32x4*)(bf + (j - 128)); f32x4 lf;
#pragma unroll
            for (int e = 0; e < 4; ++e) lf[e] = fminf(x4[e], 0.f) - __logf(1.0f + __expf(-fabsf(x4[e])));
            *(f32x4*)(LF + (size_t)t * 16 + (j - 128)) = lf;
        }
        u32x2 w; w.x = pk2(o[0], o[1]); w.y = pk2(o[2], o[3]);
        *(u32x2*)(LA + (size_t)t * 256 + j) = w;
    }
}
__device__ __forceinline__ void e1_phase(const Params& p, int l, size_t gt, size_t ngt, int gw, int ngw, int lane) {
    unsigned char* ws = p.ws;
    e1_lora((const float*)(ws + O_S), (bf16_t*)(ws + O_LA), (float*)(ws + O_LF), p.in[I_MU] + (size_t)l * 3200 + 3072, p.in[I_BF] + (size_t)l * 16, gt, ngt);
}
__device__ __forceinline__ void e_cumsum_wg(const Params& p, int l, int bh, int wave, int lane, volatile LAS float* wsum) {
    const int b = bh >> 4, h = bh & 15;
    const float* SF = (const float*)(p.ws + O_S) + ((size_t)b * SEQ) * 256 + 128 + h; float* CB = (float*)(p.ws + O_CB) + (size_t)bh * SEQ; const float bfh = p.in[I_BF][(size_t)l * 16 + h];
    const int s0 = (wave * 64 + lane) * 16;
    float v[16], loc = 0.f;
#pragma unroll
    for (int i = 0; i < 16; ++i) { const float x = SF[(size_t)(s0 + i) * 256] + bfh; v[i] = fminf(x, 0.f) - __logf(1.0f + __expf(-fabsf(x))); }
#pragma unroll
    for (int i = 0; i < 16; ++i) loc += v[i];
    float inc = loc;
#pragma unroll
    for (int o = 1; o < 64; o <<= 1) { const float n = __int_as_float(__builtin_amdgcn_ds_bpermute(((lane >= o) ? lane - o : lane) << 2, __float_as_int(inc))); if (lane >= o) inc += n; }
    if (lane == 63) wsum[wave] = inc;
    asm volatile("s_waitcnt lgkmcnt(0)" ::: "memory"); __builtin_amdgcn_s_barrier(); asm volatile("" ::: "memory");
    float run = inc - loc;
#pragma unroll
    for (int w = 0; w < 7; ++w) run += (w < wave) ? wsum[w] : 0.f;
#pragma unroll
    for (int i = 0; i < 4; ++i) { f32x4 o;
#pragma unroll
        for (int e = 0; e < 4; ++e) { run += v[4 * i + e]; o[e] = run * LOG2E; }
        *(f32x4*)(CB + s0 + 4 * i) = o; }
}
constexpr int LDS_LA = 131072 + 8192;
constexpr int CB_APT = 0, CB_RTT = 2048, CB_G1T = 4096, CB_ARBT = 4608, CB_ARKT = 5120, CB_WC = 5632, CB_BB = 6144, CB_KB = 8192, CB_VT = 10240, CB_BYTES = 12288;
constexpr int GRP = 36;
constexpr int EL_X = 0, EL_Y = 4608, EL_ATT = 9216, EL_GR = 11264, EL_TM = 0, EL_G1 = 1088, EL_BYTES = 16384;
__device__ __forceinline__ unsigned pkbf(float lo, float hi) { return pg8::cvt_pk_bf16(lo, hi); }
__device__ __forceinline__ void e2c_phase(const Params& p, int l, LAS unsigned char* lds, int bx, int wave, int lane) {
    unsigned char* ws = p.ws;
    const bf16_t* UB = (const bf16_t*)(ws + O_UB); const bf16_t* WTL = (const bf16_t*)(ws + O_WTLORA) + (size_t)l * 2048 * 256;
    const float* w0p = p.in[I_W0] + (size_t)l * W; const float* a0p = p.in[I_A0] + (size_t)l * W;
    unsigned char* BLOB = ws + O_SCN; float* BON = (float*)(ws + O_VS);
    const float* mu = p.in[I_MU] + (size_t)l * 3200; const float* kkp = p.in[I_KK] + (size_t)l * W; const float* kap = p.in[I_KA] + (size_t)l * W;
    LAS unsigned char* L = lds + wave * EL_BYTES;
    const int r32 = lane & 31, hh = lane >> 5, l16 = lane & 15, rg = lane >> 4;
    for (int k_ = 0; k_ < 8; ++k_) {
        const int jr = k_ >> 1, cr = bx * 4 + jr, b = cr >> 9, c = cr & 511, h = wave * 2 + (k_ & 1), bh = b * 16 + h, ch = h * 64 + lane;
        const size_t tok0 = (size_t)b * SEQ + c * 16;
        const float mr = mu[ch], mk = mu[1024 + ch], mv = mu[2048 + ch], kkc = kkp[ch], kac = kap[ch], rkc = p.in[I_RK][(size_t)l * W + ch];
        float pr = 0.f, pk = 0.f, pv = 0.f;
        if (c > 0) { pr = bf2f(UB[(tok0 - 1) * 3072 + ch]); pk = bf2f(UB[(tok0 - 1) * 3072 + 1024 + ch]); pv = bf2f(UB[(tok0 - 1) * 3072 + 2048 + ch]); }
        float At[16], Rt[16], Bh[16], Kh[16], Vv[16];
        float Wc = 1.0f;
        float wdv[16], asv[16];
        { attn_body::f32x16 xw0 = attn_body::f32x16{}, xw1 = xw0, xa0 = xw0, xa1 = xw0;
          const int arow = jr * 16 + (lane & 15); const LAS unsigned char* ap = lds + LDS_LA + arow * 256; const bf16_t* bw = WTL + (size_t)(h * 64 + r32) * 256 + hh * 8; const bf16_t* ba = bw + (size_t)1024 * 256 + 64;
#pragma unroll
          for (int ks = 0; ks < 4; ++ks) {
              u32x4 aw = {0u, 0u, 0u, 0u}, aa = {0u, 0u, 0u, 0u};
              if (r32 < 16) { aw = *(const LAS u32x4*)(ap + (((ks * 2 + hh) ^ (arow & 15)) * 16)); aa = *(const LAS u32x4*)(ap + (((8 + ks * 2 + hh) ^ (arow & 15)) * 16)); }
              const bf16x8 fw = __builtin_bit_cast(bf16x8, aw), fa = __builtin_bit_cast(bf16x8, aa);
              xw0 = __builtin_amdgcn_mfma_f32_32x32x16_bf16(fw, *(const bf16x8*)(bw + ks * 16), xw0, 0, 0, 0);
              xw1 = __builtin_amdgcn_mfma_f32_32x32x16_bf16(fw, *(const bf16x8*)(bw + 32 * 256 + ks * 16), xw1, 0, 0, 0);
              xa0 = __builtin_amdgcn_mfma_f32_32x32x16_bf16(fa, *(const bf16x8*)(ba + ks * 16), xa0, 0, 0, 0);
              xa1 = __builtin_amdgcn_mfma_f32_32x32x16_bf16(fa, *(const bf16x8*)(ba + 32 * 256 + ks * 16), xa1, 0, 0, 0);
          }
          const float w0c = w0p[ch], a0c = a0p[ch];
#pragma unroll
          for (int r = 0; r < 8; ++r) { const int t = (r & 3) + 8 * (r >> 2);
              auto rw = __builtin_amdgcn_permlane32_swap(__float_as_uint(xw0[r]), __float_as_uint(xw1[r]), false, false);
              auto ra = __builtin_amdgcn_permlane32_swap(__float_as_uint(xa0[r]), __float_as_uint(xa1[r]), false, false);
              wdv[t] = __builtin_amdgcn_exp2f(-0.6065306597126334f * LOG2E * sigmoidf_(__builtin_bit_cast(float, (unsigned)rw[0]) + w0c));
              wdv[t + 4] = __builtin_amdgcn_exp2f(-0.6065306597126334f * LOG2E * sigmoidf_(__builtin_bit_cast(float, (unsigned)rw[1]) + w0c));
              asv[t] = sigmoidf_(__builtin_bit_cast(float, (unsigned)ra[0]) + a0c); asv[t + 4] = sigmoidf_(__builtin_bit_cast(float, (unsigned)ra[1]) + a0c); }
        }
        float invn_l;
        { LAS float* PT = (LAS float*)(L + EL_X); float pk2_ = pk;
#pragma unroll
          for (int t = 0; t < 16; ++t) { const float ck = bf2f(UB[(tok0 + t) * 3072 + 1024 + ch]); const float kr = (ck + (pk2_ - ck) * mk) * kkc; pk2_ = ck; PT[t * 68 + lane] = kr * kr; }
          asm volatile("s_waitcnt lgkmcnt(0)" ::: "memory");
          const LAS float* pr_ = PT + l16 * 68 + rg * 16; float n2 = 0.f;
#pragma unroll
          for (int i = 0; i < 4; ++i) { const f32x4 q4 = *(const LAS f32x4*)(pr_ + 4 * i); n2 += (q4[0] + q4[1]) + (q4[2] + q4[3]); }
          n2 += __builtin_bit_cast(float, __builtin_amdgcn_ds_swizzle(__builtin_bit_cast(int, n2), 0x401F));
          { const unsigned ub_ = __float_as_uint(n2); auto rr = __builtin_amdgcn_permlane32_swap(ub_, ub_, false, false); n2 = __uint_as_float(rr[0]) + __uint_as_float(rr[1]); }
          invn_l = 1.0f / fmaxf(sqrtf(n2), 1e-12f);
          asm volatile("s_waitcnt lgkmcnt(0)" ::: "memory"); }
#pragma unroll
        for (int t = 0; t < 16; ++t) {
            const size_t tok = tok0 + t;
            const float cr = bf2f(UB[tok * 3072 + ch]), ck = bf2f(UB[tok * 3072 + 1024 + ch]), cv = bf2f(UB[tok * 3072 + 2048 + ch]);
            const float wd = wdv[t], as = asv[t];
            const float r = cr + (pr - cr) * mr, k = ck + (pk - ck) * mk, v = cv + (pv - cv) * mv;
            pr = cr; pk = ck; pv = cv;
            const float kkr = k * kkc, k2 = k * (1.0f + (as - 1.0f) * kac);
            const float kk = kkr * rdlane(invn_l, t);
            const float Wprev = Wc; Wc *= wd; const float iW = __builtin_amdgcn_rcpf(Wc);
            At[t] = -kk * Wprev; Rt[t] = r * Wc; Bh[t] = kk * as * iW; Kh[t] = k2 * iW; Vv[t] = v; ((LAS float*)(L + EL_X))[t * 68 + lane] = r * k2 * rkc;
        }
        { LAS float* PT = (LAS float*)(L + EL_X);
          asm volatile("s_waitcnt lgkmcnt(0)" ::: "memory");
          const LAS float* pr_ = PT + l16 * 68 + rg * 16; float bs = 0.f;
#pragma unroll
          for (int i = 0; i < 4; ++i) { const f32x4 q4 = *(const LAS f32x4*)(pr_ + 4 * i); bs += (q4[0] + q4[1]) + (q4[2] + q4[3]); }
          bs += __builtin_bit_cast(float, __builtin_amdgcn_ds_swizzle(__builtin_bit_cast(int, bs), 0x401F));
          { const unsigned ub_ = __builtin_bit_cast(unsigned, bs); auto rr = __builtin_amdgcn_permlane32_swap(ub_, ub_, false, false); bs = __builtin_bit_cast(float, (unsigned)rr[0]) + __builtin_bit_cast(float, (unsigned)rr[1]); }
          if (lane < 16) BON[(tok0 + lane) * 16 + h] = bs;
          asm volatile("s_waitcnt lgkmcnt(0)" ::: "memory"); }
        { LAS bf16_t* X = (LAS bf16_t*)(L + EL_X); LAS bf16_t* Y = (LAS bf16_t*)(L + EL_Y);
#pragma unroll
          for (int t = 0; t < 16; ++t) { const unsigned ux = pkbf(Bh[t], Kh[t]), uy = pkbf(At[t], Rt[t]);
              X[t * 72 + lane] = (bf16_t)(ux & 0xffffu); X[(16 + t) * 72 + lane] = (bf16_t)(ux >> 16); Y[t * 72 + lane] = (bf16_t)(uy & 0xffffu); Y[(16 + t) * 72 + lane] = (bf16_t)(uy >> 16); }
          u32x4 w0, w1;
#pragma unroll
          for (int i = 0; i < 4; ++i) { w0[i] = pkbf(At[2 * i], At[2 * i + 1]); w1[i] = pkbf(At[8 + 2 * i], At[8 + 2 * i + 1]); }
          *(LAS u32x4*)(L + EL_ATT + lane * 32) = w0; *(LAS u32x4*)(L + EL_ATT + lane * 32 + 16) = w1; }
        asm volatile("s_waitcnt lgkmcnt(0)" ::: "memory");
        attn_body::f32x16 gram = attn_body::f32x16{};
#pragma unroll
        for (int s4 = 0; s4 < 4; ++s4) {
            const bf16x8 fa = *(const LAS bf16x8*)(L + EL_X + r32 * 144 + s4 * 32 + hh * 16), fb = *(const LAS bf16x8*)(L + EL_Y + r32 * 144 + s4 * 32 + hh * 16);
            gram = __builtin_amdgcn_mfma_f32_32x32x16_bf16(fa, fb, gram, 0, 0, 0);
        }
        { LAS float* GR = (LAS float*)(L + EL_GR);
#pragma unroll
          for (int i = 0; i < 16; ++i) GR[((i & 3) + 8 * (i >> 2) + 4 * hh) * GRP + r32] = gram[i]; }
        asm volatile("s_waitcnt lgkmcnt(0)" ::: "memory");
        { const LAS float* GR = (const LAS float*)(L + EL_GR); float x[16];
          int l16o = l16; asm volatile("" : "+v"(l16o));
#pragma unroll
          for (int t = 0; t < 16; ++t) x[t] = (l16o == t) ? 1.0f : 0.f;
#pragma unroll
          for (int s_ = 0; s_ < 15; ++s_) { f32x4 n4[4];
#pragma unroll
              for (int g = (s_ + 1) >> 2; g < 4; ++g) n4[g] = *(const LAS f32x4*)(GR + s_ * GRP + 4 * g);
              if ((s_ & 1) == 1) asm volatile("" ::: "memory");
#pragma unroll
              for (int g = (s_ + 1) >> 2; g < 4; ++g)
#pragma unroll
                  for (int e = 0; e < 4; ++e) if (4 * g + e > s_) x[4 * g + e] += x[s_] * n4[g][e]; }
          asm volatile("s_waitcnt lgkmcnt(0)" ::: "memory");
          LAS float* TM = (LAS float*)(L + EL_TM);
          if (rg == 0) {
#pragma unroll
              for (int t = 0; t < 16; ++t) TM[l16 * 17 + t] = x[t]; } }
        asm volatile("s_waitcnt lgkmcnt(0)" ::: "memory");
        attn_body::f32x16 ap0, ap1, g1;
        { const LAS float* TM = (const LAS float*)(L + EL_TM); const LAS float* GR = (const LAS float*)(L + EL_GR);
          u32x4 tb, ga;
#pragma unroll
          for (int i = 0; i < 4; ++i) {
              const float t0 = (r32 < 16) ? TM[(8 * hh + 2 * i) * 17 + r32] : 0.f, t1 = (r32 < 16) ? TM[(8 * hh + 2 * i + 1) * 17 + r32] : 0.f; tb[i] = pkbf(t0, t1);
              const int s0 = 8 * hh + 2 * i, s1 = s0 + 1;
              const float a0 = (r32 < 16 && r32 < s0) ? GR[(16 + r32) * GRP + s0] : 0.f, a1 = (r32 < 16 && r32 < s1) ? GR[(16 + r32) * GRP + s1] : 0.f; ga[i] = pkbf(a0, a1); }
          const bf16x8 ftm = __builtin_bit_cast(bf16x8, tb);
          const bf16x8 fa0 = *(const LAS bf16x8*)(L + EL_ATT + r32 * 32 + hh * 16), fa1 = *(const LAS bf16x8*)(L + EL_ATT + (32 + r32) * 32 + hh * 16);
          const attn_body::f32x16 z16 = attn_body::f32x16{};
          ap0 = __builtin_amdgcn_mfma_f32_32x32x16_bf16(fa0, ftm, z16, 0, 0, 0);
          ap1 = __builtin_amdgcn_mfma_f32_32x32x16_bf16(fa1, ftm, z16, 0, 0, 0);
          g1 = __builtin_amdgcn_mfma_f32_32x32x16_bf16(__builtin_bit_cast(bf16x8, ga), ftm, z16, 0, 0, 0);
          LAS float* G1L = (LAS float*)(L + EL_G1);
          if (r32 < 16) {
#pragma unroll
              for (int i = 0; i < 8; ++i) G1L[((i & 3) + 8 * (i >> 2) + 4 * hh) * 17 + r32] = g1[i]; } }
        asm volatile("s_waitcnt lgkmcnt(0)" ::: "memory");
        unsigned char* out = BLOB + ((size_t)(bh >> 1) * 512 + c) * (2 * CB_BYTES) + (size_t)(bh & 1) * CB_BYTES;
        { const LAS float* GR = (const LAS float*)(L + EL_GR); const LAS float* G1L = (const LAS float*)(L + EL_G1); const LAS unsigned char* Yb = L + EL_Y;
          if (r32 < 16) {
              const int t = r32, slot = (t + 16 * hh) * 16;
#pragma unroll
              for (int s = 0; s < 2; ++s) {
                  u32x4 w0, w1;
#pragma unroll
                  for (int i = 0; i < 4; ++i) { w0[i] = pkbf(ap0[8 * s + 2 * i], ap0[8 * s + 2 * i + 1]); w1[i] = pkbf(ap1[8 * s + 2 * i], ap1[8 * s + 2 * i + 1]); }
                  *(u32x4*)(out + CB_APT + s * 512 + slot) = w0; *(u32x4*)(out + CB_APT + (2 + s) * 512 + slot) = w1;
#pragma unroll
                  for (int kt = 0; kt < 2; ++kt) { const LAS unsigned char* yr = Yb + (16 + t) * 144 + (32 * kt + 16 * s + 4 * hh) * 2;
                      const u32x2 lo = *(const LAS u32x2*)(yr), hi2 = *(const LAS u32x2*)(yr + 16); u32x4 w; w.x = lo.x; w.y = lo.y; w.z = hi2.x; w.w = hi2.y;
                      *(u32x4*)(out + CB_RTT + (kt * 2 + s) * 512 + slot) = w; }
              }
              u32x4 wg, wb, wk;
#pragma unroll
              for (int i = 0; i < 4; ++i) {
                  const int j0 = 2 * i, j1 = 2 * i + 1;
                  wg[i] = pkbf(G1L[(8 * hh + j0) * 17 + t], G1L[(8 * hh + j1) * 17 + t]);
                  const int sa = 8 * (j0 >> 2) + 4 * hh + (j0 & 3), sb = sa + 1;
                  wb[i] = pkbf((sa <= t) ? GR[sa * GRP + 16 + t] : 0.f, (sb <= t) ? GR[sb * GRP + 16 + t] : 0.f);
                  const int ka = 8 * hh + j0, kb = ka + 1;
                  wk[i] = pkbf((ka <= t) ? GR[(16 + ka) * GRP + 16 + t] : 0.f, (kb <= t) ? GR[(16 + kb) * GRP + 16 + t] : 0.f); }
              *(u32x4*)(out + CB_G1T + slot) = wg; *(u32x4*)(out + CB_ARBT + slot) = wb; *(u32x4*)(out + CB_ARKT + slot) = wk;
          }
          *(float*)(out + CB_WC + lane * 4) = Wc;
          u32x4 bP0, bP1, kP0, kP1, vP0, vP1;
#pragma unroll
          for (int i = 0; i < 2; ++i) {
              bP0[i] = pkbf(Bh[2 * i] * Wc, Bh[2 * i + 1] * Wc); bP0[2 + i] = pkbf(Bh[8 + 2 * i] * Wc, Bh[9 + 2 * i] * Wc);
              bP1[i] = pkbf(Bh[4 + 2 * i] * Wc, Bh[5 + 2 * i] * Wc); bP1[2 + i] = pkbf(Bh[12 + 2 * i] * Wc, Bh[13 + 2 * i] * Wc); }
#pragma unroll
          for (int i = 0; i < 4; ++i) { kP0[i] = pkbf(Kh[2 * i] * Wc, Kh[2 * i + 1] * Wc); kP1[i] = pkbf(Kh[8 + 2 * i] * Wc, Kh[9 + 2 * i] * Wc); vP0[i] = pkbf(Vv[2 * i], Vv[2 * i + 1]); vP1[i] = pkbf(Vv[8 + 2 * i], Vv[9 + 2 * i]); }
          u32x4 f0, f1;
#pragma unroll
          for (int i = 0; i < 4; ++i) { auto rr = __builtin_amdgcn_permlane32_swap(bP0[i], bP1[i], false, false); f0[i] = rr[0]; f1[i] = rr[1]; }
          *(u32x4*)(out + CB_BB + lane * 16) = f0; *(u32x4*)(out + CB_BB + 1024 + lane * 16) = f1;
#pragma unroll
          for (int i = 0; i < 4; ++i) { auto rr = __builtin_amdgcn_permlane32_swap(kP0[i], kP1[i], false, false); f0[i] = rr[0]; f1[i] = rr[1]; }
          *(u32x4*)(out + CB_KB + lane * 16) = f0; *(u32x4*)(out + CB_KB + 1024 + lane * 16) = f1;
#pragma unroll
          for (int i = 0; i < 4; ++i) { auto rr = __builtin_amdgcn_permlane32_swap(vP0[i], vP1[i], false, false); f0[i] = rr[0]; f1[i] = rr[1]; }
          *(u32x4*)(out + CB_VT + lane * 16) = f0; *(u32x4*)(out + CB_VT + 1024 + lane * 16) = f1;
        }
        asm volatile("s_waitcnt lgkmcnt(0)" ::: "memory");
    }
}
constexpr int SC_SLOT = 2 * CB_BYTES, SC_NCH = SEQ / 16;
__device__ __forceinline__ void scan_block(LAS unsigned char* lds, const unsigned char* BLOB, bf16_t* YS, int blk, int wid, int lane) {
    if (wid >= 4) {
        const int lw = wid - 4;
        const unsigned char* gS = BLOB + (size_t)blk * 512 * SC_SLOT + lane * 16;
#define SC_ISSUE(c) do { const int sl_ = ((c) & 3) * SC_SLOT; const unsigned char* s_ = gS + (size_t)(c) * SC_SLOT; \
        _Pragma("unroll") for (int i_ = 0; i_ < 6; ++i_) __builtin_amdgcn_global_load_lds((const unsigned*)(s_ + (lw + 4 * i_) * 1024), (LAS unsigned*)(lds + sl_ + (lw + 4 * i_) * 1024), 16, 0, 0); } while (0)
        SC_ISSUE(0); SC_ISSUE(1); SC_ISSUE(2);
        for (int c = 0; c < SC_NCH; ++c) {
            if (c + 2 < SC_NCH) asm volatile("s_waitcnt vmcnt(12)" ::: "memory"); else asm volatile("s_waitcnt vmcnt(0)" ::: "memory");
            __builtin_amdgcn_s_barrier();
            asm volatile("" ::: "memory");
            if (c + 3 < SC_NCH) SC_ISSUE(c + 3);
        }
#undef SC_ISSUE
    } else {
        typedef attn_body::f32x16 f32x16;
        const int hsel = wid >> 1, vh = wid & 1, bh = blk * 2 + hsel, r32 = lane & 31, hi = lane >> 5, slot16 = ((lane & 15) + 16 * hi) * 16;
        bf16_t* yp = YS + ((size_t)bh * (SEQ / 4) * 64 + vh * 32 + r32) * 4;
        f32x16 Z0 = f32x16{}, Z1 = f32x16{};
        const f32x16 z16 = f32x16{};
#define SC_CVT(dst, src, s_) do { u32x4 w_; _Pragma("unroll") for (int i_ = 0; i_ < 4; ++i_) w_[i_] = pkbf(src[8 * (s_) + 2 * i_], src[8 * (s_) + 2 * i_ + 1]); dst = __builtin_bit_cast(bf16x8, w_); } while (0)
#define SC_M16(off) (*(const LAS bf16x8*)(base + (off) + slot16))
#define SC_M32(off) (*(const LAS bf16x8*)(base + (off) + lane * 16))
#define MF(a_, b_, c_) __builtin_amdgcn_mfma_f32_32x32x16_bf16(a_, b_, c_, 0, 0, 0)
        for (int c = 0; c < SC_NCH; ++c) {
            __builtin_amdgcn_s_barrier();
            asm volatile("" ::: "memory");
            const LAS unsigned char* base = lds + (c & 3) * SC_SLOT + hsel * CB_BYTES;
            bf16x8 zb00, zb01, zb10, zb11, ub;
            SC_CVT(zb00, Z0, 0); SC_CVT(zb01, Z0, 1); SC_CVT(zb10, Z1, 0); SC_CVT(zb11, Z1, 1);
            const bf16x8 vt = SC_M32(CB_VT + vh * 1024);
            f32x16 U = MF(SC_M16(CB_APT + 0), zb00, z16); U = MF(SC_M16(CB_APT + 512), zb01, U); U = MF(SC_M16(CB_APT + 1024), zb10, U); U = MF(SC_M16(CB_APT + 1536), zb11, U);
            U = MF(SC_M16(CB_G1T), vt, U);
            f32x16 Y = MF(SC_M16(CB_RTT + 0), zb00, z16); Y = MF(SC_M16(CB_RTT + 512), zb01, Y); Y = MF(SC_M16(CB_RTT + 1024), zb10, Y); Y = MF(SC_M16(CB_RTT + 1536), zb11, Y);
            Y = MF(SC_M16(CB_ARKT), vt, Y);
            SC_CVT(ub, U, 0);
            Y = MF(SC_M16(CB_ARBT), ub, Y);
            {
                const LAS float* wc = (const LAS float*)(base + CB_WC) + 4 * hi;
#pragma unroll
                for (int g = 0; g < 4; ++g) { const f32x4 w0 = *(const LAS f32x4*)(wc + 8 * g), w1 = *(const LAS f32x4*)(wc + 32 + 8 * g);
#pragma unroll
                    for (int e = 0; e < 4; ++e) { Z0[4 * g + e] *= w0[e]; Z1[4 * g + e] *= w1[e]; } }
            }
            Z0 = MF(SC_M32(CB_BB), ub, Z0); Z1 = MF(SC_M32(CB_BB + 1024), ub, Z1);
            Z0 = MF(SC_M32(CB_KB), vt, Z0); Z1 = MF(SC_M32(CB_KB + 1024), vt, Z1);
            { u32x2 w_; w_.x = pkbf(Y[0], Y[1]); w_.y = pkbf(Y[2], Y[3]); *(u32x2*)(yp + (size_t)(c * 4 + hi) * 256) = w_; }
            { u32x2 w_; w_.x = pkbf(Y[4], Y[5]); w_.y = pkbf(Y[6], Y[7]); *(u32x2*)(yp + (size_t)(c * 4 + 2 + hi) * 256) = w_; }
        }
#undef SC_CVT
#undef SC_M16
#undef SC_M32
#undef MF
    }
    asm volatile("s_waitcnt vmcnt(0) lgkmcnt(0)" ::: "memory"); __builtin_amdgcn_s_barrier();
}
__device__ __forceinline__ void e3_items(const bf16_t* __restrict__ YS, const float* __restrict__ BON, const bf16_t* __restrict__ GB, const bf16_t* __restrict__ UBv0, bf16_t* __restrict__ Y,
                                         const float* __restrict__ lg, const float* __restrict__ lb, const float* __restrict__ muv, int it0, int it1, int lane) {
#pragma unroll 2
    for (int it = it0; it < it1; ++it) {
        const int t0 = (it >> 2) * 4, hq = it & 3, s0 = t0 & (SEQ - 1), b = t0 >> 13;
        const int head = hq * 4 + (lane >> 4), l16 = lane & 15, c = head * 64 + l16 * 4, bh = b * 16 + head;
        const size_t off = (((size_t)bh * (SEQ / 4) + (s0 >> 2)) * 64 + l16 * 4) * 4;
        u32x2 y4[4];
#pragma unroll
        for (int i = 0; i < 4; ++i) y4[i] = *(const u32x2*)(YS + off + i * 4);
        const bf16_t* UBv = UBv0 + c;
        const f32x4 mv4 = *(const f32x4*)(muv + c);
        float pv[4];
        if (s0 > 0) ld4bf(UBv + (size_t)(t0 - 1) * 3072, pv);
        else {
#pragma unroll
            for (int i = 0; i < 4; ++i) pv[i] = 0.f; }
        const f32x4 lg4 = *(const f32x4*)(lg + c), lb4 = *(const f32x4*)(lb + c);
        u32x2 cvw[4], gw_[4]; float bonv[4];
#pragma unroll
        for (int j = 0; j < 4; ++j) { cvw[j] = *(const u32x2*)(UBv + (size_t)(t0 + j) * 3072); gw_[j] = *(const u32x2*)(GB + (size_t)(t0 + j) * W + c); bonv[j] = BON[(size_t)(t0 + j) * 16 + head]; }
#pragma unroll
        for (int j = 0; j < 4; ++j) {
            const int t = t0 + j;
            float y[4], g[4], cv[4], vm[4], sm = 0.f;
            cv[0] = __uint_as_float(cvw[j].x << 16); cv[1] = __uint_as_float(cvw[j].x & 0xffff0000u); cv[2] = __uint_as_float(cvw[j].y << 16); cv[3] = __uint_as_float(cvw[j].y & 0xffff0000u);
            g[0] = __uint_as_float(gw_[j].x << 16); g[1] = __uint_as_float(gw_[j].x & 0xffff0000u); g[2] = __uint_as_float(gw_[j].y << 16); g[3] = __uint_as_float(gw_[j].y & 0xffff0000u);
            const float bon = bonv[j];
#pragma unroll
            for (int i = 0; i < 4; ++i) { const unsigned wv = (j & 2) ? y4[i].y : y4[i].x; y[i] = __builtin_bit_cast(float, (j & 1) ? (wv & 0xffff0000u) : (wv << 16)); sm += y[i];
                vm[i] = cv[i] + (pv[i] - cv[i]) * mv4[i]; pv[i] = cv[i]; }
            const float mean = allred16(sm) * (1.0f / 64.0f);
            float q = 0.f;
#pragma unroll
            for (int i = 0; i < 4; ++i) { y[i] -= mean; q += y[i] * y[i]; }
            const float rstd = rsqrtf(allred16(q) * (1.0f / 64.0f) + 64e-5f);
            float o[4];
#pragma unroll
            for (int i = 0; i < 4; ++i) o[i] = (y[i] * rstd * lg4[i] + lb4[i] + bon * vm[i]) * siluf_(g[i]);
            u32x2 w; w.x = pk2(o[0], o[1]); w.y = pk2(o[2], o[3]);
            *(u32x2*)(Y + (size_t)t * W + c) = w;
        }
    }
}
__device__ __forceinline__ void e3_phase(const Params& p, int l, int it0, int it1, int lane) {
    unsigned char* ws = p.ws;
    e3_items((const bf16_t*)(ws + O_YS), (const float*)(ws + O_VS), (const bf16_t*)(ws + O_GB), (const bf16_t*)(ws + O_UB) + 2048, (bf16_t*)(ws + O_Y) + (size_t)1 * T * W,
             p.in[I_LG] + (size_t)l * W, p.in[I_LB] + (size_t)l * W, p.in[I_MU] + (size_t)l * 3200 + 2048, it0, it1, lane);
}
constexpr int NWAVES = 8;
constexpr int RING_BYTES = 131072;
constexpr int LDSCTL_OFF = RING_BYTES, MISC_OFF = LDSCTL_OFF + 320;
constexpr int LDS_BYTES = 155648;
constexpr int CW_BAR = 1024;
constexpr int CW_QUEUE = 200000;
constexpr int CW_QK = 204800;
constexpr int CW_E3 = 205312;
constexpr int CW_E2A = 205568;
constexpr int CW_GRP = 205824;
constexpr int NPH = 43;
#ifndef MK_PER_PHASE
#define MK_PER_PHASE 0
#endif
static_assert(attn_body::LDS_BYTES <= RING_BYTES && 4 * SC_SLOT <= RING_BYTES && 8 * EL_BYTES <= RING_BYTES && pg8::STAGE_BYTES <= RING_BYTES && 8 * 9216 <= RING_BYTES, "LDS map");
static_assert((CW_BAR + NPH * XCD_BAR_WORDS) <= CW_QUEUE && (CW_QUEUE + 32 * 64) <= CW_QK && (CW_QK + 4 * 64) <= CW_E3 && (CW_E3 + 4 * 64) <= CW_E2A && (CW_E2A + 4 * 64) <= CW_GRP && (CW_GRP + 4 * 3 * 64 * 32) * 4 <= (int)MiB, "barrier regions inside the zeroed control MiB");

__global__ void __launch_bounds__(NWAVES * 64, 2) fwd(Params p) {
    extern __shared__ __attribute__((aligned(16))) unsigned char lds_[];
    LAS unsigned char* lds = (LAS unsigned char*)lds_;
    volatile LAS unsigned* MISC = (volatile LAS unsigned*)(lds + MISC_OFF);
    const int G = gridDim.x; const int wave_k = __builtin_amdgcn_readfirstlane((int)threadIdx.x >> 6);
    for (int u = threadIdx.x; u < (LDS_BYTES - LDSCTL_OFF) / 4; u += NWAVES * 64) ((LAS unsigned*)(lds + LDSCTL_OFF))[u] = 0u;
    __syncthreads();
    unsigned* ctl = (unsigned*)(p.ws + O_CTL);
    XcdBarrier bar = xcd_barrier_post(ctl + CW_BAR + p.li * XCD_BAR_WORDS, MISC + 8);
    const int lo = p.ph_lo, hi = p.ph_hi;
    const int ngw = G * NWAVES; const size_t ngt = (size_t)G * (NWAVES * 64);
#define BX() int bx = blockIdx.x; asm volatile("" : "+s"(bx))
#define WSQ() Params q = p; __attribute__((address_space(1))) unsigned char* wsg_ = (__attribute__((address_space(1))) unsigned char*)p.ws; asm volatile("" : "+s"(wsg_)); q.ws = (unsigned char*)wsg_; unsigned char* ws = q.ws
#define IDS() int wave_o = wave_k, bx_o = blockIdx.x; asm volatile("" : "+s"(wave_o), "+s"(bx_o)); const int lane = lane_opaque(), wave = wave_o, tid_ = wave * 64 + lane, gw = bx_o * NWAVES + wave; \
    const size_t gt = (size_t)bx_o * (NWAVES * 64) + tid_; (void)lane; (void)wave; (void)gw; (void)gt
#define IN(id) (lo <= (id) && (id) < hi)
#define SEAM(id) do { if ((id) + 1 < hi) xcd_barrier(bar, wave_k == 0 && lane_opaque() == 0); } while (0)
    if (IN(1)) { WSQ(); (void)ws; IDS(); p1_weights(q, lds, gw, ngw, wave, lane, gt, ngt); SEAM(1); }
    for (int l = 0; l < DEPTH; ++l) {
        const int pb = 2 + 10 * l;
#define GRP_CTR(seam_) ((unsigned*)(ws + O_CTL) + CW_GRP + ((l * 3 + (seam_)) * 64 + pmg) * 32)
#define GRP_PUB(ptr_) do { asm volatile("s_waitcnt vmcnt(0) lgkmcnt(0)" ::: "memory"); __builtin_amdgcn_s_barrier(); asm volatile("" ::: "memory"); \
            int wv_ = wave_k; asm volatile("" : "+s"(wv_)); if (wv_ == 0 && lane_opaque() == 0) { __builtin_amdgcn_fence(__ATOMIC_RELEASE, "agent"); asm volatile("s_waitcnt vmcnt(0)" ::: "memory"); __hip_atomic_fetch_add((ptr_), 1u, __ATOMIC_RELAXED, __HIP_MEMORY_SCOPE_AGENT); } } while (0)
#define GRP_POLL(ptr_, n_) do { int wv_ = wave_k; asm volatile("" : "+s"(wv_)); if (wv_ == 0) { unsigned polls_ = 0; \
                while ((unsigned)__builtin_amdgcn_readfirstlane(__hip_atomic_load((ptr_), __ATOMIC_RELAXED, __HIP_MEMORY_SCOPE_AGENT)) < (unsigned)(n_)) { if (++polls_ > (1u << 20)) break; __builtin_amdgcn_s_sleep(4); } \
                __builtin_amdgcn_fence(__ATOMIC_ACQUIRE, "agent"); asm volatile("s_waitcnt vmcnt(0)" ::: "memory"); } \
            asm volatile("s_waitcnt vmcnt(0) lgkmcnt(0)" ::: "memory"); __builtin_amdgcn_s_barrier(); asm volatile("" ::: "memory"); } while (0)
        if (IN(pb + 0)) { WSQ(); IDS(); const int pmg = 8 * (bx_o & 7) + ((bx_o >> 3) & 7), r0 = pmg * 256 + (bx_o >> 6) * 64 + wave * 8;
            if (l == 0) e_rmsnorm(q.in[I_X], p.in[I_NG] + (size_t)l * D, (bf16_t*)(ws + O_H), nullptr, r0, 1, lane, r0 + 8);
            else { { const int l_ = l; const int l = l_ - 1; GRP_POLL(GRP_CTR(1), 4); }
                   e_rmsnorm_bf((const bf16_t*)(ws + O_X), p.in[I_NG] + (size_t)l * D, (bf16_t*)(ws + O_H), nullptr, r0, 1, lane, r0 + 8); }
            GRP_PUB(GRP_CTR(2)); }
        if (IN(pb + 1)) { WSQ(); { BX(); const int pmg = 8 * (bx & 7) + ((bx >> 3) & 7); GRP_POLL(GRP_CTR(2), 4); }
            pg8::Gemm g{(const bf16_t*)(ws + O_H), (const bf16_t*)(ws + O_WTIN) + (size_t)l * NP * D, T, PML + 768, D}; pg8::StaticOrder S; BX(); S.init(T, PML + 768, G, bx);
            EpiG1 E{ws};
            pg8::gemm_phase<EpiG1, pg8::StaticOrder, false, true>(lds, g, S, E, wave_k);
            SEAM(pb + 1);
        }
        if (IN(pb + 4)) { WSQ(); IDS();
            {
                const bf16_t* Qp = (const bf16_t*)(ws + O_Q) + lane * 16; const bf16_t* Kp = (const bf16_t*)(ws + O_K) + lane * 16; unsigned* qkm = (unsigned*)(ws + O_CTL) + CW_QK + l * 64;
                volatile LAS float* qs = (volatile LAS float*)(lds + LDSCTL_OFF + 1024);
                for (int bb = 0; bb < BATCH; ++bb) { float mq = 0.f, mk = 0.f;
                    static_assert(SEQ / (256 * NWAVES) == 4, "four tokens per wave and batch");
                    u32x4 qv[4][2], kv[4][2];
#pragma unroll
                    for (int k = 0; k < 4; ++k) { const size_t t = (size_t)(bb * SEQ + gw + k * (256 * NWAVES));
                        qv[k][0] = *(const u32x4*)(Qp + t * W); qv[k][1] = *(const u32x4*)(Qp + t * W + 8); kv[k][0] = *(const u32x4*)(Kp + t * W); kv[k][1] = *(const u32x4*)(Kp + t * W + 8); }
#pragma unroll
                    for (int k = 0; k < 4; ++k) { float sq = 0.f, sk = 0.f;
#pragma unroll
                        for (int j = 0; j < 2; ++j)
#pragma unroll
                            for (int e = 0; e < 4; ++e) { const float q0 = __uint_as_float(qv[k][j][e] << 16), q1 = __uint_as_float(qv[k][j][e] & 0xffff0000u), k0 = __uint_as_float(kv[k][j][e] << 16), k1 = __uint_as_float(kv[k][j][e] & 0xffff0000u);
                                sq += q0 * q0 + q1 * q1; sk += k0 * k0 + k1 * k1; }
                        sq += dppf<0xB1>(sq); sq += dppf<0x4E>(sq); sk += dppf<0xB1>(sk); sk += dppf<0x4E>(sk);
                        mq = fmaxf(mq, sq); mk = fmaxf(mk, sk); }
                    if ((lane & 3) == 0) { qs[(wave * 2 + bb) * 32 + (lane >> 2) * 2] = mq; qs[(wave * 2 + bb) * 32 + (lane >> 2) * 2 + 1] = mk; } }
                asm volatile("s_waitcnt lgkmcnt(0)" ::: "memory"); __builtin_amdgcn_s_barrier(); asm volatile("" ::: "memory");
                if (wave == 0) { float m = 0.f;
#pragma unroll
                    for (int w = 0; w < 8; ++w) m = fmaxf(m, qs[(w * 2 + (lane >> 5)) * 32 + (lane & 31)]);
                    __hip_atomic_fetch_max(qkm + lane, __float_as_uint(m), __ATOMIC_RELAXED, __HIP_MEMORY_SCOPE_AGENT); }
            }
            if (bx_o < 32) e_cumsum_wg(q, l, bx_o, wave, lane, (volatile LAS float*)(lds + LDSCTL_OFF + 4096));
            {
                const float* S = (const float*)(ws + O_S); const float* mu = p.in[I_MU] + (size_t)l * 3200 + 3072;
                const int r = tid_ >> 3, tok = bx_o * 64 + r, s_ = tok & (SEQ - 1);
#pragma unroll
                for (int hf = 0; hf < 2; ++hf) { const int qc = (tid_ & 7) * 2 + hf, j = qc * 8; u32x4 w;
#pragma unroll
                    for (int i2 = 0; i2 < 2; ++i2) {
                        const f32x4 cur = *(const f32x4*)(S + (size_t)tok * 256 + j + 4 * i2), prv = (s_ > 0) ? *(const f32x4*)(S + (size_t)(tok - 1) * 256 + j + 4 * i2) : (f32x4){0.f, 0.f, 0.f, 0.f}, m4 = *(const f32x4*)(mu + j + 4 * i2);
                        float o[4];
#pragma unroll
                        for (int e = 0; e < 4; ++e) { const float xm = cur[e] + (prv[e] - cur[e]) * m4[e]; o[e] = (j < 64) ? (1.0f - 2.0f * __builtin_amdgcn_rcpf(__expf(2.0f * xm) + 1.0f)) : xm; }
                        w[2 * i2] = pk2(o[0], o[1]); w[2 * i2 + 1] = pk2(o[2], o[3]); }
                    *(LAS u32x4*)(lds + LDS_LA + r * 256 + ((qc ^ (r & 15)) * 16)) = w; }
                asm volatile("s_waitcnt lgkmcnt(0)" ::: "memory"); __builtin_amdgcn_s_barrier(); asm volatile("" ::: "memory");
            }
            e2c_phase(q, l, lds, bx_o, wave, lane);
            asm volatile("s_waitcnt vmcnt(0) lgkmcnt(0)" ::: "memory"); __builtin_amdgcn_s_barrier(); asm volatile("" ::: "memory");
            if (wave == 0 && lane == 0) { __builtin_amdgcn_fence(__ATOMIC_RELEASE, "agent"); asm volatile("s_waitcnt vmcnt(0)" ::: "memory");
                __hip_atomic_fetch_add((unsigned*)(ws + O_CTL) + CW_E2A + l * 64, 1u, __ATOMIC_RELAXED, __HIP_MEMORY_SCOPE_AGENT); } }
#define POLL_GE(ptr_, n_) do { if (wave == 0) { unsigned polls_ = 0; \
                while ((unsigned)__builtin_amdgcn_readfirstlane(__hip_atomic_load((ptr_), __ATOMIC_RELAXED, __HIP_MEMORY_SCOPE_AGENT)) < (unsigned)(n_)) { if (++polls_ > (1u << 20)) break; __builtin_amdgcn_s_sleep(8); } \
                __builtin_amdgcn_fence(__ATOMIC_ACQUIRE, "agent"); asm volatile("s_waitcnt vmcnt(0)" ::: "memory"); } \
            asm volatile("s_waitcnt vmcnt(0) lgkmcnt(0)" ::: "memory"); __builtin_amdgcn_s_barrier(); asm volatile("" ::: "memory"); } while (0)
        if (IN(pb + 5)) { WSQ(); { int bx_o = blockIdx.x; asm volatile("" : "+s"(bx_o));
#define X_SIDE() do { IDS();     \
                e1_conv((const bf16_t*)(ws + O_UA), (bf16_t*)(ws + O_Y), p.in[I_CW] + (size_t)l * 3 * W, gt, ngt); \
                e1_pool((const bf16_t*)(ws + O_UD), (bf16_t*)(ws + O_PG), ((size_t)((bx_o & 63) * 16 + (tid_ >> 5)) << 7) | (size_t)((bx_o >> 6) * 32 + (tid_ & 31)), (size_t)1 << 40); \
                asm volatile("s_waitcnt vmcnt(0) lgkmcnt(0)" ::: "memory"); __builtin_amdgcn_s_barrier(); asm volatile("" ::: "memory");     \
                pg8::Gemm g2{(const bf16_t*)(ws + O_PG), (const bf16_t*)(ws + O_WD) + (size_t)l * 4 * 65536, 4 * T, 1024, 256}; PoolOrder S2{G, bx_o}; \
                EpiPool E2{ws, p.in[I_PS] + (size_t)l * W}; \
                pg8::gemm_phase<EpiPool, PoolOrder, true, true>(lds, g2, S2, E2, wave_k); } while (0)
            if (bx_o >= 240) { IDS(); POLL_GE((unsigned*)(ws + O_CTL) + CW_E2A + l * 64, G); scan_block(lds, ws + O_SCN, (bf16_t*)(ws + O_YS), bx_o - 240, wave, lane);
                if (wave == 0 && lane == 0) { __builtin_amdgcn_fence(__ATOMIC_RELEASE, "agent"); asm volatile("s_waitcnt vmcnt(0)" ::: "memory");
                    __hip_atomic_fetch_add((unsigned*)(ws + O_CTL) + CW_E3 + l * 64, 1u, __ATOMIC_RELAXED, __HIP_MEMORY_SCOPE_AGENT); }
                X_SIDE(); }
            else {
                { BX(); pg8::Gemm g{(const bf16_t*)(ws + O_H), (const bf16_t*)(ws + O_WTIN) + ((size_t)l * NP + PML + 768) * D, T, 29 * 256, D};
                  RangeOrder R; R.S.init(T, 29 * 256, 240, bx); R.i0 = 0; R.i1 = (bx >> 3) & 7; EpiML E{ws};
                  pg8::gemm_phase<EpiML, RangeOrder, false, true>(lds, g, R, E, wave_k); }
                X_SIDE();
                { BX(); pg8::Gemm g{(const bf16_t*)(ws + O_H), (const bf16_t*)(ws + O_WTIN) + ((size_t)l * NP + PML + 768) * D, T, 29 * 256, D};
                  RangeOrder R; R.S.init(T, 29 * 256, 240, bx); R.i0 = (bx >> 3) & 7; R.i1 = 64; EpiML E{ws};
                  pg8::gemm_phase<EpiML, RangeOrder, false, true>(lds, g, R, E, wave_k); }
            }
            }
            { IDS(); POLL_GE((unsigned*)(ws + O_CTL) + CW_E2A + l * 64, G);
                unsigned* qctr = (unsigned*)(ws + O_CTL) + CW_QUEUE + (l * 8) * 64;
                volatile LAS unsigned* qw = MISC + 16;
                int label = bx_o & 7, tries = 0;
                for (;;) {
                    if (wave == 0 && lane == 0) qw[0] = __hip_atomic_fetch_add(qctr + label * 64, 1u, __ATOMIC_RELAXED, __HIP_MEMORY_SCOPE_AGENT);
                    asm volatile("s_waitcnt vmcnt(0) lgkmcnt(0)" ::: "memory"); __builtin_amdgcn_s_barrier(); asm volatile("" ::: "memory");
                    const unsigned idx = qw[0];
                    asm volatile("s_waitcnt lgkmcnt(0)" ::: "memory"); __builtin_amdgcn_s_barrier(); asm volatile("" ::: "memory");
                    if (idx >= 128u) { label = (label + 1) & 7; if (++tries == 8) break; continue; }
                    const int qb = 31 - (int)(idx >> 2), bh = label + 8 * (int)(idx & 3u);
                    attn_body::attn_unit<8>(bh >> 4, bh & 15, qb, (const attn_body::bf16*)(ws + O_Q), (const attn_body::bf16*)(ws + O_K), (const attn_body::bf16*)(ws + O_V), (const float*)(ws + O_CB), (const unsigned*)(ws + O_CTL) + CW_QK + l * 64,
                                            (const attn_body::bf16*)(ws + O_GC), (attn_body::bf16*)(ws + O_Y) + (size_t)2 * T * W, (char*)lds_, wave_k);
                }
                unsigned* e3c = (unsigned*)(ws + O_CTL) + CW_E3 + l * 64;
                if (wave == 0) { unsigned polls = 0;
                    while ((unsigned)__builtin_amdgcn_readfirstlane(__hip_atomic_load(e3c, __ATOMIC_RELAXED, __HIP_MEMORY_SCOPE_AGENT)) < 16u) { if (++polls > (1u << 20)) break; __builtin_amdgcn_s_sleep(8); }
                    __builtin_amdgcn_fence(__ATOMIC_ACQUIRE, "agent"); asm volatile("s_waitcnt vmcnt(0)" ::: "memory"); }
                asm volatile("s_waitcnt vmcnt(0) lgkmcnt(0)" ::: "memory"); __builtin_amdgcn_s_barrier(); asm volatile("" ::: "memory");
                for (;;) {
                    if (wave == 0 && lane == 0) qw[0] = __hip_atomic_fetch_add(e3c + 32, 64u, __ATOMIC_RELAXED, __HIP_MEMORY_SCOPE_AGENT);
                    asm volatile("s_waitcnt vmcnt(0) lgkmcnt(0)" ::: "memory"); __builtin_amdgcn_s_barrier(); asm volatile("" ::: "memory");
                    const unsigned base = qw[0];
                    asm volatile("s_waitcnt lgkmcnt(0)" ::: "memory"); __builtin_amdgcn_s_barrier(); asm volatile("" ::: "memory");
                    if (base >= (unsigned)T) break;
                    e3_phase(q, l, (int)base + wave * 8, (int)base + wave * 8 + 8, lane);
                }
            }
            SEAM(pb + 5);
#undef POLL_GE
#undef X_SIDE
        }
        if (IN(pb + 8)) { WSQ();
            pg8::Gemm g{(const bf16_t*)(ws + O_Y), (const bf16_t*)(ws + O_WTBR) + (size_t)l * 4 * D * W, 4 * T, 4 * D, W}; BranchOrder S; BX(); S.init(G, bx);
            EpiG3Q E{ws, p.in[I_BM] + (size_t)l * NB * D, bx};
            pg8::gemm_phase<EpiG3Q, BranchOrder, true, true>(lds, g, S, E, wave_k);
            { const int pmg = 8 * (bx & 7) + ((bx >> 3) & 7); GRP_PUB(GRP_CTR(0)); }
        }
        if (IN(pb + 9)) { WSQ(); { BX(); const int pmg = 8 * (bx & 7) + ((bx >> 3) & 7); GRP_POLL(GRP_CTR(0), 4); }
            pg8::Gemm g{(const bf16_t*)(ws + O_MG), (const bf16_t*)(ws + O_WTOUT) + (size_t)l * D * D, T, D, D}; pg8::StaticOrder S; BX(); S.init(T, D, G, bx);
            EpiG4 E{(l == 0) ? q.in[I_X] : (const float*)nullptr, (const bf16_t*)(ws + O_X), (bf16_t*)(ws + O_X)};
            pg8::gemm_phase<EpiG4, pg8::StaticOrder, true, true>(lds, g, S, E, wave_k);
            if (l == DEPTH - 1) SEAM(pb + 9); else { const int pmg = 8 * (bx & 7) + ((bx >> 3) & 7); GRP_PUB(GRP_CTR(1)); }
        }
    }
    int lo2 = p.ph_lo, hi2 = p.ph_hi; asm volatile("" : "+s"(lo2), "+s"(hi2));
    if (lo2 <= 42 && 42 < hi2) { WSQ(); IDS(); e_rmsnorm_bf((const bf16_t*)(ws + O_X), p.in[I_FG], nullptr, p.out, gw, ngw, lane); }
#undef IN
#undef SEAM
}

extern "C" void kernel_launch(void* const* d_in, const int* in_sizes, int n_in, void* d_out, int out_size, void* d_ws, size_t ws_size, hipStream_t stream) {
    static int state = 0;
    if (state == 0) {
        if (n_in != 21 || in_sizes[0] != T * D || out_size != T * D || ws_size < WS_END) {
            fprintf(stderr, "kernel_launch: unexpected shapes (n_in %d, in0 %d, out %d, ws %zu < %zu); nothing launched\n", n_in, n_in > 0 ? in_sizes[0] : -1, out_size, ws_size, (size_t)WS_END);
            state = -1; return; }
        int dev = 0, cus = 0, per_cu = 0;
        if (hipGetDevice(&dev) != hipSuccess || hipDeviceGetAttribute(&cus, hipDeviceAttributeMultiprocessorCount, dev) != hipSuccess) { fprintf(stderr, "kernel_launch: device query failed\n"); state = -1; return; }
        if (hipFuncSetAttribute((const void*)fwd, hipFuncAttributeMaxDynamicSharedMemorySize, LDS_BYTES) != hipSuccess) { fprintf(stderr, "kernel_launch: hipFuncSetAttribute failed\n"); state = -1; return; }
        if (hipOccupancyMaxActiveBlocksPerMultiprocessor(&per_cu, (const void*)fwd, NWAVES * 64, LDS_BYTES) != hipSuccess || per_cu < 1)
            fprintf(stderr, "kernel_launch: note: occupancy query reports %d workgroups per CU\n", per_cu);
        (void)hipGetLastError();
        if (cus != 256) fprintf(stderr, "kernel_launch: note: %d CUs reported; this kernel launches 256 workgroups (one per CU of a 256-CU device)\n", cus);
        state = 1;
    }
    if (state < 0) return;
    if (hipMemsetAsync((char*)d_ws + O_CTL, 0, 1 * MiB, stream) != hipSuccess) { fprintf(stderr, "kernel_launch: memset failed\n"); return; }
    Params p{};
    for (int i = 0; i < 21; ++i) p.in[i] = (const float*)d_in[i];
    p.out = (float*)d_out; p.ws = (unsigned char*)d_ws;
#if MK_PER_PHASE
    for (int id = 0; id < NPH; ++id) { p.ph_lo = id; p.ph_hi = id + 1; p.li = id; p.pad = 0; hipLaunchKernelGGL(fwd, dim3(256), dim3(NWAVES * 64), LDS_BYTES, stream, p); }
#else
    p.ph_lo = 0; p.ph_hi = NPH; p.li = 0; p.pad = 0;
    hipLaunchKernelGGL(fwd, dim3(256), dim3(NWAVES * 64), LDS_BYTES, stream, p);
#endif
    const hipError_t le = hipPeekAtLastError();
    if (le != hipSuccess) fprintf(stderr, "kernel_launch: launch failed: %s\n", hipGetErrorName(le));
}
```

```cpp
#include <hip/hip_runtime.h>
#include <hip/hip_bf16.h>
#include <cstdio>
#include <cstdint>
#include <cmath>

__device__ __forceinline__ int lane_opaque() { int r; asm volatile("v_mbcnt_lo_u32_b32 %0, -1, 0\n\tv_mbcnt_hi_u32_b32 %0, -1, %0" : "=v"(r)); return r; }
constexpr int D = 2048, BATCH = 2, SEQ = 8192, T = BATCH * SEQ, DEPTH = 4, W = 1024, NB = 4;
constexpr int NIN = 22672;
constexpr int NP = 22784;
constexpr int OA = 0, OB = 4096, OWL = 7168, OAL = 7232, OBG = 7296, OCQ = 8320, OCF = 11392, OCG = 11408, ODI = 12432, ODG = 13456, OML = 14480;
constexpr int PA = 0, PB = 4096, PGB = 7168, PQ = 8192, PK = 9216, PV = 10240, PGC = 11264, PUD = 12288, PGD = 13312, PS = 14336, PML = 14592;
constexpr float C2 = 0.125f * 1.4426950408889634f;
constexpr float LOG2E = 1.4426950408889634f;

constexpr size_t MiB = 1u << 20;
constexpr size_t O_CTL = 0;
constexpr size_t O_WTIN = 1 * MiB;
constexpr size_t O_WTBR = O_WTIN + 356 * MiB;
constexpr size_t O_WTOUT = O_WTBR + 64 * MiB;
constexpr size_t O_WTLORA = O_WTOUT + 32 * MiB;
constexpr size_t O_WD = O_WTLORA + 4 * MiB;
constexpr size_t O_H = O_WD + 32 * MiB;
constexpr size_t O_UA = O_H + 64 * MiB;
constexpr size_t O_UB = O_UA + 128 * MiB;
constexpr size_t O_GB = O_UB + 96 * MiB;
constexpr size_t O_Q = O_GB + 32 * MiB;
constexpr size_t O_K = O_Q + 32 * MiB;
constexpr size_t O_V = O_K + 32 * MiB;
constexpr size_t O_GC = O_V + 32 * MiB;
constexpr size_t O_UD = O_GC + 32 * MiB;
constexpr size_t O_GD = O_UD + 32 * MiB;
constexpr size_t O_ML = O_GD + 32 * MiB;
constexpr size_t O_S = O_ML + 256 * MiB;
constexpr size_t O_LA = O_S + 16 * MiB;
constexpr size_t O_LF = O_LA + 8 * MiB;
constexpr size_t O_CB = O_LF + 1 * MiB;
constexpr size_t O_BON = O_CB + 1 * MiB;
constexpr size_t O_WDEC = O_BON + 1 * MiB;
constexpr size_t O_ASIG = O_WDEC + 64 * MiB;
constexpr size_t O_SCN = O_ASIG + 64 * MiB;
constexpr size_t O_VS = O_SCN + 320 * MiB;
constexpr size_t O_YS = O_VS + 64 * MiB;
constexpr size_t O_Y = O_YS + 64 * MiB;
constexpr size_t O_MG = O_Y + 128 * MiB;
constexpr size_t O_MACC = O_MG + 64 * MiB;
constexpr size_t O_HQ = O_MACC;
constexpr size_t O_WQ = O_WDEC;
constexpr size_t O_X = O_MACC + 64 * MiB;
constexpr size_t O_GP = O_X + 128 * MiB;
constexpr size_t O_PG = O_GP + 256 * MiB;
constexpr size_t WS_END = O_PG + 32 * MiB;

struct Params { const float* in[21]; float* out; unsigned char* ws; int ph_lo, ph_hi, li, pad; };
enum { I_X = 0, I_NG, I_WIN, I_BM, I_CW, I_MU, I_W0, I_W2, I_A0, I_A2, I_KK, I_KA, I_RK, I_LG, I_LB, I_BF, I_PW, I_PS, I_WB, I_WO, I_FG };

namespace pg8 {
#define PG8_LAS __attribute__((address_space(3)))
typedef unsigned short bf16_t;
typedef short bf16x8 __attribute__((ext_vector_type(8)));
typedef float f32x4 __attribute__((ext_vector_type(4)));
typedef unsigned u32x4 __attribute__((ext_vector_type(4)));
constexpr int BM = 256, BK = 64, HALF = 128, HTB = HALF * BK * 2  , STAGE_BYTES = 8 * HTB, NXCD = 8, WGM = 8;

__host__ __device__ __forceinline__ int lds_byte(int r, int c) { const int st = (r >> 4) * 2 + (c >> 5), rr = r & 15, cc = c & 31, ob = rr * 64 + cc * 2; return st * 1024 + (ob ^ (((ob >> 9) & 1) << 5)); }
__host__ __device__ __forceinline__ void stage_rc(int b, int& R, int& C) { const int st = b / 1024, sb = b % 1024, swz = sb ^ (((sb >> 9) & 1) << 5); R = (st >> 1) * 16 + swz / 64; C = (st & 1) * 32 + (swz % 64) / 2; }
__host__ __device__ __forceinline__ int perm32(int rho) { const int n = rho >> 4, i = rho & 15; return 8 * (i >> 2) + 4 * n + (i & 3); }

struct Unit { int pm, pn; };
struct Gemm { const bf16_t* A; const bf16_t* Bt; int M, N, K; };

struct StaticOrder {
    int nM, nN, nwg, G, c;
    __host__ __device__ void init(int M, int N, int G_, int c_) { nM = M / BM; nN = N / BM; nwg = nM * nN; G = G_; c = c_; }
    __host__ __device__ bool next(int i, Unit& u) const {
        const long L = (long)i * G + c; if (L >= nwg) return false;
        int wgid = (int)L; { const int q = nwg / NXCD, r = nwg % NXCD, xcd = wgid % NXCD, off = wgid / NXCD; wgid = (xcd < r ? xcd * (q + 1) : r * (q + 1) + (xcd - r) * q) + off; }
        const int nig = WGM * nN, gid = wgid / nig, fm = gid * WGM, gsz = (nM - fm) < WGM ? (nM - fm) : WGM;
        u.pm = fm + ((wgid % nig) % gsz); u.pn = (wgid % nig) / gsz; return true;
    }
    __device__ __forceinline__ void a_ready(const Unit&) const {}
    __device__ __forceinline__ void done(const Unit&) const {}
};

__device__ __forceinline__ unsigned cvt_pk_bf16(float lo, float hi) { unsigned r; asm volatile("v_cvt_pk_bf16_f32 %0, %1, %2" : "=v"(r) : "v"(lo), "v"(hi)); return r; }

template <class Epi, class Sched, bool ALIGN_EPI = false, bool SP2 = false, bool FP8 = false>
__device__ __forceinline__ void gemm_phase(PG8_LAS unsigned char* lds, const Gemm g, const Sched& S, const Epi& E, const int wave_k) {
    int wid_o = wave_k; asm volatile("" : "+s"(wid_o));
    const int lane = lane_opaque(), wid = wid_o, tid = wid * 64 + lane,
    wr = wid >> 2, wc = wid & 3, fr = lane & 15, fq = lane >> 4;
    const int K = g.K, nt = K / BK;
    unsigned voffA[2], voffB[2];
#pragma unroll
    for (int i = 0; i < 2; ++i) { int R, C; stage_rc(tid * 16 + i * 8192, R, C); const int Rb = Epi::PERM ? ((R & ~31) + perm32(R & 31)) : R;
        voffA[i] = (unsigned)(R * K + C) * 2u; voffB[i] = (unsigned)(Rb * K + C) * 2u; }
    const size_t kstep = (size_t)(BK * 2);
    const size_t hstep = (size_t)HALF * K * 2;
    const size_t tstep = 2 * hstep;
    const unsigned ldsw = (unsigned)wid * 1024u;
    const int aoff = lds_byte(wr * 64 + fr, fq * 8), boff = lds_byte(wc * 32 + fr, fq * 8);
#define PG8_SA(b, h) (((b) * 2 + (h)) * HTB)
#define PG8_SB(b, h) ((4 + (b) * 2 + (h)) * HTB)
#define PG8_STAGE(bufoff, gbase, voff) do { _Pragma("unroll") for (int _i = 0; _i < 2; ++_i) \
        __builtin_amdgcn_global_load_lds((const unsigned*)((const char*)(gbase) + (voff)[_i]), (PG8_LAS unsigned*)(lds + (bufoff) + ldsw + _i * 8192), 16, 0, 0); } while (0)
#define PG8_LDA(dst, b, h) do { _Pragma("unroll") for (int m = 0; m < 4; ++m) _Pragma("unroll") for (int k = 0; k < 2; ++k) dst[m][k] = *(const PG8_LAS bf16x8*)(lds + PG8_SA(b, h) + aoff + m * 2048 + k * 1024); } while (0)
#define PG8_LDB(dst, b, h) do { _Pragma("unroll") for (int n = 0; n < 2; ++n) _Pragma("unroll") for (int k = 0; k < 2; ++k) dst[n][k] = *(const PG8_LAS bf16x8*)(lds + PG8_SB(b, h) + boff + n * 2048 + k * 1024); } while (0)
#define PG8_MMA(ai, bj, At, Bt) do { __builtin_amdgcn_s_setprio(1); _Pragma("unroll") for (int m = 0; m < 4; ++m) _Pragma("unroll") for (int n = 0; n < 2; ++n) { \
        if constexpr (FP8) { typedef int v8i_ __attribute__((ext_vector_type(8))); typedef int v4i_ __attribute__((ext_vector_type(4))); \
            const v4i_ b0_ = __builtin_bit_cast(v4i_, Bt[n][0]), b1_ = __builtin_bit_cast(v4i_, Bt[n][1]), a0_ = __builtin_bit_cast(v4i_, At[m][0]), a1_ = __builtin_bit_cast(v4i_, At[m][1]); \
            const v8i_ bb_ = {b0_[0], b0_[1], b0_[2], b0_[3], b1_[0], b1_[1], b1_[2], b1_[3]}, aa_ = {a0_[0], a0_[1], a0_[2], a0_[3], a1_[0], a1_[1], a1_[2], a1_[3]}; \
              \
            asm volatile("v_mfma_scale_f32_16x16x128_f8f6f4 %0, %1, %2, %0, %3, %3 op_sel_hi:[0,0,0]" : "+v"(acc[ai][bj][m][n]) : "v"(bb_), "v"(aa_), "v"(fp8_scale_)); } \
        else { _Pragma("unroll") for (int k = 0; k < 2; ++k) acc[ai][bj][m][n] = __builtin_amdgcn_mfma_f32_16x16x32_bf16(Bt[n][k], At[m][k], acc[ai][bj][m][n], 0, 0, 0); } } \
        __builtin_amdgcn_s_setprio(0); } while (0)
#define PG8_WAIT_V(n) asm volatile("s_waitcnt vmcnt(" #n ")" ::: "memory")
#define PG8_WAIT_L(n) asm volatile("s_waitcnt lgkmcnt(" #n ")" ::: "memory")
#define PG8_WAIT_VR(rx, n) asm volatile("s_cmp_lg_u32 %0, 0\n\ts_cbranch_scc1 1f\n\ts_waitcnt vmcnt(8)\n1:\n\ts_waitcnt vmcnt(%1)" :: "s"(rx), "n"(n) : "memory", "scc")
#define PG8_BAR __builtin_amdgcn_s_barrier()
#define PG8_SCHED __builtin_amdgcn_sched_barrier(0)
    Unit cur, nxt; int ui = 0;
    if (!S.next(0, cur)) return;
    int fp8_scale_ = 0x7f7f7f7f; asm volatile("" : "+v"(fp8_scale_)); (void)fp8_scale_;
    f32x4 acc[2][2][4][2];
#pragma unroll
    for (int a = 0; a < 2; ++a)
#pragma unroll
        for (int b = 0; b < 2; ++b)
#pragma unroll
            for (int m = 0; m < 4; ++m)
#pragma unroll
                for (int n = 0; n < 2; ++n) acc[a][b][m][n] = (f32x4){0.f, 0.f, 0.f, 0.f};
    bf16x8 At[4][2], B0[2][2], B1[2][2];
    const char* cA = (const char*)g.A + (size_t)cur.pm * tstep; const char* cB = (const char*)g.Bt + (size_t)cur.pn * tstep;
    S.a_ready(cur);
    if constexpr (SP2) {
        PG8_STAGE(PG8_SB(0, 0), cB, voffB); PG8_STAGE(PG8_SB(0, 1), cB + hstep, voffB); PG8_STAGE(PG8_SA(0, 0), cA, voffA); PG8_STAGE(PG8_SA(0, 1), cA + hstep, voffA);
        if (wr == 1) PG8_BAR;
        PG8_WAIT_V(2); PG8_BAR;
        PG8_STAGE(PG8_SB(1, 0), cB + kstep, voffB); PG8_STAGE(PG8_SA(1, 0), cA + kstep, voffA); PG8_STAGE(PG8_SB(1, 1), cB + hstep + kstep, voffB);
        PG8_WAIT_V(6); PG8_BAR;
    } else {
        PG8_STAGE(PG8_SB(0, 0), cB, voffB); PG8_STAGE(PG8_SA(0, 0), cA, voffA); PG8_STAGE(PG8_SB(0, 1), cB + hstep, voffB); PG8_STAGE(PG8_SA(0, 1), cA + hstep, voffA);
        if (wr == 1) PG8_BAR;
        PG8_WAIT_V(4); PG8_BAR;
        PG8_STAGE(PG8_SB(1, 0), cB + kstep, voffB); PG8_STAGE(PG8_SA(1, 0), cA + kstep, voffA); PG8_STAGE(PG8_SB(1, 1), cB + hstep + kstep, voffB);
        PG8_WAIT_V(6); PG8_BAR;
    }
    for (;;) {
        const bool has_next = S.next(ui + 1, nxt);
        const char* nA = has_next ? (const char*)g.A + (size_t)nxt.pm * tstep : cA; const char* nB = has_next ? (const char*)g.Bt + (size_t)nxt.pn * tstep : cB;
        for (int t = 0; t < nt; t += 2) {
            const bool last = (t == nt - 2);
            const char* a1 = cA + (size_t)(t + 1) * kstep;
            const char* a2 = last ? nA : cA + (size_t)(t + 2) * kstep; const char* b2 = last ? nB : cB + (size_t)(t + 2) * kstep;
            const char* a3 = a2 + kstep; const char* b3 = b2 + kstep;
            if (last && has_next) S.a_ready(nxt);
            const int relax = __builtin_amdgcn_readfirstlane((t == 0 && ui > 0) ? 1 : 0);
            if constexpr (SP2) {
            PG8_LDB(B0, 0, 0); PG8_LDB(B1, 0, 1); PG8_SCHED; PG8_LDA(At, 0, 0); PG8_STAGE(PG8_SA(1, 1), a1 + hstep, voffA);
            PG8_WAIT_VR(relax, 8 + Epi::NST); PG8_WAIT_L(0); PG8_BAR; PG8_MMA(0, 0, At, B0); PG8_MMA(0, 1, At, B1); PG8_BAR; PG8_SCHED;
            PG8_LDA(At, 0, 1); PG8_STAGE(PG8_SB(0, 0), b2, voffB); PG8_STAGE(PG8_SB(0, 1), b2 + hstep, voffB); PG8_STAGE(PG8_SA(0, 0), a2, voffA);
            PG8_WAIT_VR(relax, 8 + Epi::NST); PG8_WAIT_L(0); PG8_BAR; PG8_MMA(1, 0, At, B0); PG8_MMA(1, 1, At, B1); PG8_BAR; PG8_SCHED;
            PG8_LDB(B0, 1, 0); PG8_LDB(B1, 1, 1); PG8_SCHED; PG8_LDA(At, 1, 0); PG8_STAGE(PG8_SA(0, 1), a2 + hstep, voffA);
            PG8_WAIT_V(8); PG8_WAIT_L(0); PG8_BAR; PG8_MMA(0, 0, At, B0); PG8_MMA(0, 1, At, B1); PG8_BAR; PG8_SCHED;
            PG8_LDA(At, 1, 1); PG8_STAGE(PG8_SB(1, 0), b3, voffB); PG8_STAGE(PG8_SB(1, 1), b3 + hstep, voffB); PG8_STAGE(PG8_SA(1, 0), a3, voffA);
            PG8_WAIT_V(8); PG8_WAIT_L(0); PG8_BAR; PG8_MMA(1, 0, At, B0); PG8_MMA(1, 1, At, B1); PG8_BAR; PG8_SCHED;
            } else {
            PG8_LDB(B0, 0, 0); PG8_SCHED; PG8_LDA(At, 0, 0); PG8_STAGE(PG8_SA(1, 1), a1 + hstep, voffA);
            PG8_WAIT_L(8); PG8_BAR; PG8_WAIT_L(0); PG8_MMA(0, 0, At, B0); PG8_BAR; PG8_SCHED;
            PG8_LDB(B1, 0, 1); PG8_STAGE(PG8_SB(0, 0), b2, voffB);
            PG8_BAR; PG8_WAIT_L(0); PG8_MMA(0, 1, At, B1); PG8_BAR;
            PG8_LDA(At, 0, 1); PG8_STAGE(PG8_SA(0, 0), a2, voffA);
            PG8_BAR; PG8_WAIT_L(0); PG8_MMA(1, 0, At, B0); PG8_BAR; PG8_SCHED;
            PG8_STAGE(PG8_SB(0, 1), b2 + hstep, voffB);
            PG8_WAIT_V(6); PG8_BAR; PG8_MMA(1, 1, At, B1); PG8_BAR;
            PG8_LDB(B0, 1, 0); PG8_SCHED; PG8_LDA(At, 1, 0); PG8_STAGE(PG8_SA(0, 1), a2 + hstep, voffA);
            PG8_WAIT_L(8); PG8_BAR; PG8_WAIT_L(0); PG8_MMA(0, 0, At, B0); PG8_BAR; PG8_SCHED;
            PG8_LDB(B1, 1, 1); PG8_STAGE(PG8_SB(1, 0), b3, voffB);
            PG8_BAR; PG8_WAIT_L(0); PG8_MMA(0, 1, At, B1); PG8_BAR;
            PG8_LDA(At, 1, 1); PG8_STAGE(PG8_SA(1, 0), a3, voffA);
            PG8_BAR; PG8_WAIT_L(0); PG8_MMA(1, 0, At, B0); PG8_BAR; PG8_SCHED;
            PG8_STAGE(PG8_SB(1, 1), b3 + hstep, voffB);
            PG8_WAIT_V(6); PG8_BAR; PG8_MMA(1, 1, At, B1); PG8_BAR;
            }
        }
        if constexpr (FP8) asm volatile("s_nop 15\n\ts_nop 7" ::: "memory");
        if constexpr (ALIGN_EPI) { if (wr == 0) PG8_BAR; }
        if constexpr (!Epi::AFTER_DRAIN) { E(acc, cur, wr, wc, fr, fq); S.done(cur); }
        if (!has_next) break;
#pragma unroll
        for (int a = 0; a < 2; ++a)
#pragma unroll
            for (int b = 0; b < 2; ++b)
#pragma unroll
                for (int m = 0; m < 4; ++m)
#pragma unroll
                    for (int n = 0; n < 2; ++n) acc[a][b][m][n] = (f32x4){0.f, 0.f, 0.f, 0.f};
        cur = nxt; cA = nA; cB = nB; ++ui;
        if constexpr (ALIGN_EPI) { if (wr == 1) PG8_BAR; }
    }
    PG8_WAIT_V(0);
    if constexpr (!ALIGN_EPI) { if (wr == 0) PG8_BAR; }
    PG8_BAR;
    if constexpr (Epi::AFTER_DRAIN) { E.fused(acc, cur, wr, wc, fr, fq, lds, wid, lane); S.done(cur); }
#undef PG8_SA
#undef PG8_SB
#undef PG8_STAGE
#undef PG8_LDA
#undef PG8_LDB
#undef PG8_MMA
#undef PG8_WAIT_V
#undef PG8_WAIT_L
#undef PG8_WAIT_VR
#undef PG8_BAR
#undef PG8_SCHED
}
}

namespace attn_body {
using bf16=__hip_bfloat16;
using bf16x8=__attribute__((ext_vector_type(8)))short;
using s16x4=__attribute__((ext_vector_type(4)))short;
using f32x16=__attribute__((ext_vector_type(16)))float;
using u32x4=__attribute__((ext_vector_type(4)))unsigned;
constexpr int BATCH=2,NHEAD=16,SEQ=8192,D=64,DM=NHEAD*D;
constexpr int NW=8,QBLK=32,QB=QBLK*NW,KVBLK=64,NQB=SEQ/QB;
constexpr int ATTN_PITCH=DM, ATTN_UNIT_ROWS=QB;
__device__ __forceinline__ int crow(int r,int hi){return (r&3)+8*(r>>2)+4*hi;}
#define SBAR() __builtin_amdgcn_sched_barrier(0)
__device__ __forceinline__ void cmask(f32x16&p0,f32x16&p1,int jb,int qrel,int hi){
  const float NEG=-INFINITY; int kb=64*jb+4*hi;
  #pragma unroll
  for(int r=0;r<16;++r){int kv=kb+(r&3)+8*(r>>2); if(kv>qrel)p0[r]=NEG; if(kv+32>qrel)p1[r]=NEG;}
}

constexpr int NSLOT=3, SLOTB=8192;
constexpr int LDS_K=0, LDS_V=NSLOT*SLOTB, LDS_WS=2*NSLOT*SLOTB, LDS_OST=LDS_WS+NW*64*4, LDS_CB=LDS_OST+NW*4096, LDS_BYTES=LDS_CB+SEQ*4;
constexpr int PRUNE_THR=40;
constexpr float C2=0.125f*1.4426950408889634f;
__device__ __forceinline__ void glds16(const void*gsrc,unsigned lds_dst){unsigned keep;
  asm volatile("s_mov_b32 %0, m0\n\ts_mov_b32 m0, %2\n\ts_nop 0\n\tglobal_load_lds_dwordx4 %1, off\n\ts_mov_b32 m0, %0":"=&s"(keep):"v"(gsrc),"s"(lds_dst):"memory");}
__device__ __forceinline__ float max3f(float a,float b,float c){float r;asm("v_max3_f32 %0, %1, %2, %3":"=v"(r):"v"(a),"v"(b),"v"(c));return r;}
__device__ __forceinline__ float max2f(float a,float b){float r;asm("v_max_f32_e32 %0, %1, %2":"=v"(r):"v"(a),"v"(b));return r;}
__device__ __forceinline__ float fadd_s(float a,float b){float r;asm("v_add_f32_e32 %0, %1, %2":"=v"(r):"v"(a),"v"(b));return r;}
__device__ __forceinline__ float fsub_s(float a,float b){float r;asm("v_sub_f32_e32 %0, %1, %2":"=v"(r):"v"(a),"v"(b));return r;}
typedef float f32x2_t __attribute__((ext_vector_type(2))); typedef __bf16 bf16x2_t __attribute__((ext_vector_type(2)));
__device__ __forceinline__ unsigned cvtpk_s(float lo,float hi){f32x2_t v={lo,hi};bf16x2_t b=__builtin_convertvector(v,bf16x2_t);return __builtin_bit_cast(unsigned,b);}
#define WAIT_BAR(N) asm volatile("s_waitcnt vmcnt(" #N ") lgkmcnt(0)\n\ts_barrier":::"memory")

__device__ __forceinline__ void split3(float x,unsigned&w0,unsigned&w1){
  const unsigned hb=__float_as_uint(x)&0xffff0000u; const float r1=x-__uint_as_float(hb);
  const unsigned mb=__float_as_uint(r1)&0xffff0000u; const float r2=r1-__uint_as_float(mb);
  w0=(hb>>16)|mb; w1=__float_as_uint(r2)>>16; }
__device__ __forceinline__ bf16x8 mk8(unsigned a,unsigned b,unsigned c,unsigned d){ u32x4 v={a,b,c,d}; return __builtin_bit_cast(bf16x8,v); }
__device__ __forceinline__ void qkt(f32x16&p0,f32x16&p1,const char*Kslot,const bf16x8*qr,int r32,int hi){
  const char*kb=Kslot+hi*1024+r32*16;
  #pragma unroll
  for(int d0=0;d0<4;++d0){
    const bf16x8 b0=*reinterpret_cast<const bf16x8*>(kb+d0*2048);
    const bf16x8 b1=*reinterpret_cast<const bf16x8*>(kb+d0*2048+512);
    p0=__builtin_amdgcn_mfma_f32_32x32x16_bf16(b0,qr[d0],p0,0,0,0);p1=__builtin_amdgcn_mfma_f32_32x32x16_bf16(b1,qr[d0],p1,0,0,0);}
}
typedef __attribute__((address_space(3))) const char* lds_cptr;
typedef short v4i16_t __attribute__((ext_vector_type(4)));
__device__ __forceinline__ void kload8(bf16x8*kf,lds_cptr kp){
  kf[0]=*(const __attribute__((address_space(3))) bf16x8*)(kp);      kf[1]=*(const __attribute__((address_space(3))) bf16x8*)(kp+512);
  kf[2]=*(const __attribute__((address_space(3))) bf16x8*)(kp+2048); kf[3]=*(const __attribute__((address_space(3))) bf16x8*)(kp+2560);
  kf[4]=*(const __attribute__((address_space(3))) bf16x8*)(kp+4096); kf[5]=*(const __attribute__((address_space(3))) bf16x8*)(kp+4608);
  kf[6]=*(const __attribute__((address_space(3))) bf16x8*)(kp+6144); kf[7]=*(const __attribute__((address_space(3))) bf16x8*)(kp+6656);
}
__device__ __forceinline__ void kload2(bf16x8*kf,lds_cptr kp,int j){ kf[2*j]=*(const __attribute__((address_space(3))) bf16x8*)(kp+j*2048); kf[2*j+1]=*(const __attribute__((address_space(3))) bf16x8*)(kp+j*2048+512); }
__device__ __forceinline__ s16x4 vtr(lds_cptr p){ return __builtin_bit_cast(s16x4,__builtin_amdgcn_ds_read_tr16_b64_v4i16((__attribute__((address_space(3))) v4i16_t*)p)); }
__device__ __forceinline__ float rowmax(const f32x16&p0,const f32x16&p1){
  float a=max3f(p0[0],p0[1],p1[0]),b=max3f(p0[2],p0[3],p1[1]);a=max3f(a,p1[2],p1[3]);
  #pragma unroll
  for(int r=4;r<16;r+=4){a=max3f(a,p0[r],p0[r+1]);b=max3f(b,p0[r+2],p0[r+3]);a=max3f(a,p1[r],p1[r+1]);b=max3f(b,p1[r+2],p1[r+3]);}
  const float m=max2f(a,b);
  auto rr=__builtin_amdgcn_permlane32_swap(__float_as_uint(m),__float_as_uint(m),false,false);
  return max2f(__uint_as_float(rr[0]),__uint_as_float(rr[1]));
}
__device__ __forceinline__ void pv(f32x16*o,int vb,bf16x8 pa0,bf16x8 pa1,bf16x8 pa2,bf16x8 pa3){
  #pragma unroll
  for(int d0=0;d0<2;++d0){s16x4 lo[4],hi[4];
    #pragma unroll
    for(int ks=0;ks<4;++ks){
      asm volatile("ds_read_b64_tr_b16 %0,%1 offset:%c2":"=&v"(lo[ks]):"v"(vb),"i"(d0*4096+ks*1024):"memory");
      asm volatile("ds_read_b64_tr_b16 %0,%1 offset:%c2":"=&v"(hi[ks]):"v"(vb),"i"(d0*4096+ks*1024+512):"memory");}
    asm volatile("s_waitcnt lgkmcnt(0)":::"memory");SBAR();
    #define PK(k) (bf16x8){lo[k][0],lo[k][1],lo[k][2],lo[k][3],hi[k][0],hi[k][1],hi[k][2],hi[k][3]}
    o[d0]=__builtin_amdgcn_mfma_f32_32x32x16_bf16(pa0,PK(0),o[d0],0,0,0);
    o[d0]=__builtin_amdgcn_mfma_f32_32x32x16_bf16(pa1,PK(1),o[d0],0,0,0);
    o[d0]=__builtin_amdgcn_mfma_f32_32x32x16_bf16(pa2,PK(2),o[d0],0,0,0);
    o[d0]=__builtin_amdgcn_mfma_f32_32x32x16_bf16(pa3,PK(3),o[d0],0,0,0);
    #undef PK
  }
}

#ifndef ATTN_STORE16
#define ATTN_STORE16(p,v) (*(u32x4*)(p)=(v))
#endif
template<int THRL> __device__ __forceinline__ void attn_unit(int b,int h,int qb,const bf16*Q,const bf16*__restrict__ K,const bf16*__restrict__ V,const float*__restrict__ CB,const unsigned*__restrict__ QKM,const bf16*__restrict__ Gt,bf16*O,char*shm,const int wave_k){
  int wid_o=wave_k; asm volatile("":"+s"(wid_o)); const int lane=lane_opaque(),r32=lane&31,hi=lane>>5; const int wid=wid_o; const int tid=wid*64+lane; (void)tid;
  const long rowbase=(long)b*SEQ; const int q0=qb*QB;
  const bf16*Qw=Q+(rowbase+q0+wid*QBLK)*DM+h*D;
  const bf16*Kh=K+rowbase*DM+h*D,*Vh=V+rowbase*DM+h*D;
  const unsigned lds0=(unsigned)(uintptr_t)shm;
  float*wsf=(float*)(shm+LDS_WS)+wid*64;
  const bf16* ksrc=Kh+(long)lane*DM+wid*8;
  const bf16* vsrc=Vh+(long)(16*(wid&3)+(lane>>2))*DM+(wid>>2)*32+(lane&3)*8;
  const unsigned kdst=lds0+LDS_K+wid*1024, vdst=lds0+LDS_V+wid*1024;
  #define DMA_K(t,slot) glds16(ksrc+(long)(t)*KVBLK*DM,(unsigned)__builtin_amdgcn_readfirstlane(kdst+(slot)))
  #define DMA_V(t,slot) glds16(vsrc+(long)(t)*KVBLK*DM,(unsigned)__builtin_amdgcn_readfirstlane(vdst+(slot)))
  const int vb0=(int)(lds0+LDS_V)+((lane>>4)&1)*32+(lane&3)*8+(4*hi+((lane&15)>>2))*64;
  const char*Kbase=shm+LDS_K; bf16x8 kf[8];
  const lds_cptr shm3=(lds_cptr)shm; const lds_cptr kp0=shm3+LDS_K+hi*1024+r32*16; const lds_cptr vp0=shm3+LDS_V+((lane>>4)&1)*32+(lane&3)*8+(4*hi+((lane&15)>>2))*64;
  int NT=(q0+QB)/KVBLK;
  { const float*cbg=CB+(long)(b*NHEAD+h)*SEQ+lane*4;
    for(int pc=wid;pc<NT/4;pc+=NW) glds16(cbg+pc*256,(unsigned)__builtin_amdgcn_readfirstlane(lds0+LDS_CB+pc*1024)); }
  int t0=0;
  { asm volatile("s_waitcnt vmcnt(0)\n\ts_barrier":::"memory");
    typedef __attribute__((address_space(3))) const float* lds_fptr0; const lds_fptr0 cb0=(lds_fptr0)((lds_cptr)shm+LDS_CB);
    const float qk=sqrtf(__uint_as_float(QKM[(b*NHEAD+h)*2])*__uint_as_float(QKM[(b*NHEAD+h)*2+1]));
    const float lim=cb0[q0]+2.0f*qk*1.001f+1.0f+(float)PRUNE_THR;
    int cnt=0;
    for(int base=0;base<NT-4;base+=64){ const int tt=base+lane; const bool pr=(tt<NT-4)&&(cb0[64*(tt<NT-4?tt:0)+63]>=lim); cnt+=__popcll(__ballot(pr)); }
    t0=cnt&~1; }
  ksrc+=(long)t0*KVBLK*DM; vsrc+=(long)t0*KVBLK*DM; NT-=t0;
  DMA_K(0,0);DMA_V(0,0);DMA_K(1,SLOTB);
  bf16x8 qr[4];
  #pragma unroll
  for(int d0=0;d0<4;++d0)qr[d0]=*reinterpret_cast<const bf16x8*>(&Qw[(long)r32*DM+d0*16+hi*8]);
  float mhat=0.f,l_reg=0.f;f32x16 o[2];o[0]=f32x16{};o[1]=f32x16{};
  typedef __attribute__((address_space(3))) const float* lds_fptr;
  const lds_fptr cbl=(lds_fptr)(shm3+LDS_CB)+lane+t0*64; bf16x8 qm,kb0,kb1; float cref=0.f; const f32x16 z16=f32x16{};
  #define MKQM() do{ unsigned a_,b_; split3(-mhat,a_,b_); qm=hi?mk8(0u,0u,0u,0u):mk8(0x3F803F80u,0x3F80u|(a_<<16),(a_>>16)|(b_<<16),0u); }while(0)
  #define BIAS(t) do{ unsigned w0_,w1_; split3(cref-cbl[(t)*64],w0_,w1_); w1_|=0x3F800000u; \
    auto s0_=__builtin_amdgcn_permlane32_swap(w0_,w0_,false,false); auto s1_=__builtin_amdgcn_permlane32_swap(w1_,w1_,false,false); \
    kb0=mk8(w0_,w1_,0x3F803F80u,0u); kb1=mk8(s0_[1],s1_[1],0x3F803F80u,0u); }while(0)
  const int qrel=wid*QBLK+r32;
  #define CMASK(P0,P1,t) do{int jb_=(t)-(NT-4); if(jb_>=0)cmask(P0,P1,jb_,qrel,hi);}while(0)
  bool resc=false;
  #define START(P0,P1) do{ const float rm=rowmax(P0,P1); resc=false; \
    { const float dl=rm; mhat=fadd_s(mhat,dl); \
      _Pragma("unroll") for(int r=0;r<16;++r){P0[r]=fsub_s(P0[r],dl);P1[r]=fsub_s(P1[r],dl);} \
      } \
    _Pragma("unroll") for(int r=0;r<16;++r)P0[r]=__builtin_amdgcn_exp2f(P0[r]); }while(0)
  #define RESC() do{ if(resc){ asm volatile("s_waitcnt lgkmcnt(0)":::"memory"); \
      _Pragma("unroll") for(int d_=0;d_<2;++d_) _Pragma("unroll") for(int r=0;r<16;++r)o[d_][r]*=wsf[crow(r,hi)]; } }while(0)
  f32x16 pA0,pA1,pB0,pB1;
  int sl_prev=0,sl_cur=0,sl_next=SLOTB;
  #define ROT() do{sl_prev=sl_cur;sl_cur=sl_next;sl_next=(sl_next==(NSLOT-1)*SLOTB)?0:sl_next+SLOTB;}while(0)
  DMA_K(2,2*SLOTB);
  WAIT_BAR(3);
  cref=*((lds_fptr)(shm3+LDS_CB)+q0); MKQM(); BIAS(0);
  pA0=__builtin_amdgcn_mfma_f32_32x32x16_bf16(kb0,qm,z16,0,0,0); pA1=__builtin_amdgcn_mfma_f32_32x32x16_bf16(kb1,qm,z16,0,0,0);
  qkt(pA0,pA1,Kbase,qr,r32,hi);asm volatile("s_nop 15\n\ts_nop 7":"+v"(pA0),"+v"(pA1));CMASK(pA0,pA1,0);
  START(pA0,pA1);
  _Pragma("unroll") for(int r=0;r<16;++r)pA1[r]=__builtin_amdgcn_exp2f(pA1[r]);
  WAIT_BAR(0);
  DMA_K(3,0);DMA_V(1,SLOTB);
  ROT();
  kload8(kf,kp0+sl_cur);
  WAIT_BAR(2);
  s16x4 vlo[8],vhi[8]; u32x4 pw0,pw1,pw2,pw3;
  #define PKW(P,B) cvtpk_s(P[B],P[B+1])
  #define PAF(k) __builtin_bit_cast(bf16x8,pw##k)
  #define VFR(i) (bf16x8){vlo[i][0],vlo[i][1],vlo[i][2],vlo[i][3],vhi[i][0],vhi[i][1],vhi[i][2],vhi[i][3]}
  #define PIN(x) asm volatile("":"+v"(x))
  #define MX3(a,b,c) __builtin_fmaxf(__builtin_fmaxf((a),(b)),(c))
  #define GAPA(MF,A0,A1,A2,A3,W0,W1,PW) do{ MF; sacc+=A0; sacc+=A1; sacc+=A2; sacc+=A3; PIN(sacc); W0; W1; PIN(PW); SBAR(); }while(0)
  #define EX(v) __builtin_amdgcn_exp2f(v)
  #define GAPB(MF,X,B) do{ MF; X[B]=EX(X[B]); X[B+1]=EX(X[B+1]); X[B+2]=EX(X[B+2]); X[B+3]=EX(X[B+3]); PIN(X); SBAR(); }while(0)
  #define VRD(i) do{ vlo[i]=vtr(vp_+(((i)>>2)*4096+((i)&3)*1024)); vhi[i]=vtr(vp_+(((i)>>2)*4096+((i)&3)*1024+512)); }while(0)
  #define KRD(G,j) do{ if(G){ kload2(kf,kp0+sl_next,j); SBAR(); } }while(0)
  #define STEP(C0,C1,P0,P1,t,GK,GV,GL) do{ SBAR(); \
    MKQM(); BIAS(t); C0=__builtin_amdgcn_mfma_f32_32x32x16_bf16(kb0,qm,z16,0,0,0); C1=__builtin_amdgcn_mfma_f32_32x32x16_bf16(kb1,qm,z16,0,0,0); SBAR(); \
    const lds_cptr vp_=vp0+sl_prev; \
    VRD(0); SBAR(); float sacc=(P0[0]+P0[1]); \
    GAPA(C0=__builtin_amdgcn_mfma_f32_32x32x16_bf16(kf[0],qr[0],C0,0,0,0), P0[2],P0[3],P0[4],P0[5],     pw0[0]=PKW(P0,0), pw0[1]=PKW(P0,2), pw0); \
    VRD(4); SBAR(); GAPA(C1=__builtin_amdgcn_mfma_f32_32x32x16_bf16(kf[1],qr[0],C1,0,0,0), P0[6],P0[7],P0[8],P0[9],     pw0[2]=PKW(P0,4), pw0[3]=PKW(P0,6), pw0); \
    VRD(1); SBAR(); GAPA(C0=__builtin_amdgcn_mfma_f32_32x32x16_bf16(kf[2],qr[1],C0,0,0,0),   P0[10],P0[11],P0[12],P0[13], pw1[0]=PKW(P0,8), pw1[1]=PKW(P0,10), pw1); \
    VRD(5); SBAR(); GAPA(C1=__builtin_amdgcn_mfma_f32_32x32x16_bf16(kf[3],qr[1],C1,0,0,0),   P0[14],P0[15],P1[0],P1[1],   pw1[2]=PKW(P0,12),pw1[3]=PKW(P0,14), pw1); \
    VRD(2); SBAR(); GAPA(C0=__builtin_amdgcn_mfma_f32_32x32x16_bf16(kf[4],qr[2],C0,0,0,0),   P1[2],P1[3],P1[4],P1[5],     pw2[0]=PKW(P1,0), pw2[1]=PKW(P1,2), pw2); \
    VRD(6); SBAR(); GAPA(C1=__builtin_amdgcn_mfma_f32_32x32x16_bf16(kf[5],qr[2],C1,0,0,0),   P1[6],P1[7],P1[8],P1[9],     pw2[2]=PKW(P1,4), pw2[3]=PKW(P1,6), pw2); \
    VRD(3); SBAR(); GAPA(C0=__builtin_amdgcn_mfma_f32_32x32x16_bf16(kf[6],qr[3],C0,0,0,0),   P1[10],P1[11],P1[12],P1[13], pw3[0]=PKW(P1,8), pw3[1]=PKW(P1,10), pw3); \
    VRD(7); SBAR(); GAPA(C1=__builtin_amdgcn_mfma_f32_32x32x16_bf16(kf[7],qr[3],C1,0,0,0),   P1[14],P1[15],0.f,0.f,       pw3[2]=PKW(P1,12),pw3[3]=PKW(P1,14), pw3); \
    l_reg+=sacc; \
    if(GK){DMA_K((t)+3,sl_cur);} if(GV){DMA_V((t)+1,sl_next);} \
    CMASK(C0,C1,t); \
    { float a=MX3(C0[0],C0[1],C1[0]),b=MX3(C0[2],C0[3],C1[1]); a=MX3(a,C1[2],C1[3]); \
      _Pragma("unroll") for(int r=4;r<16;r+=4){a=MX3(a,C0[r],C0[r+1]);b=MX3(b,C0[r+2],C0[r+3]);a=MX3(a,C1[r],C1[r+1]);b=MX3(b,C1[r+2],C1[r+3]);} \
      float rm=__builtin_fmaxf(a,b); { auto rr=__builtin_amdgcn_permlane32_swap(__float_as_uint(rm),__float_as_uint(rm),false,false); rm=__builtin_fmaxf(__uint_as_float(rr[0]),__uint_as_float(rr[1])); } \
      resc=false; \
      if(__builtin_expect(__any(rm>(float)THRL),0)){ const float dl=__builtin_fmaxf(rm,0.f); mhat+=dl; \
        _Pragma("unroll") for(int r=0;r<16;++r){C0[r]-=dl;C1[r]-=dl;} \
        const float f=__builtin_amdgcn_exp2f(-dl); l_reg*=f; if(hi==0)wsf[r32]=f; resc=true; } } \
    SBAR(); \
    GAPB(o[0]=__builtin_amdgcn_mfma_f32_32x32x16_bf16(PAF(0),VFR(0),o[0],0,0,0), C0,0); \
    GAPB(o[1]=__builtin_amdgcn_mfma_f32_32x32x16_bf16(PAF(0),VFR(4),o[1],0,0,0), C0,4); \
    KRD(GL,0); GAPB(o[0]=__builtin_amdgcn_mfma_f32_32x32x16_bf16(PAF(1),VFR(1),o[0],0,0,0), C0,8); \
    KRD(GL,1); GAPB(o[1]=__builtin_amdgcn_mfma_f32_32x32x16_bf16(PAF(1),VFR(5),o[1],0,0,0), C0,12); \
    KRD(GL,2); GAPB(o[0]=__builtin_amdgcn_mfma_f32_32x32x16_bf16(PAF(2),VFR(2),o[0],0,0,0), C1,0); \
    KRD(GL,3); GAPB(o[1]=__builtin_amdgcn_mfma_f32_32x32x16_bf16(PAF(2),VFR(6),o[1],0,0,0), C1,4); \
    GAPB(o[0]=__builtin_amdgcn_mfma_f32_32x32x16_bf16(PAF(3),VFR(3),o[0],0,0,0), C1,8); \
    GAPB(o[1]=__builtin_amdgcn_mfma_f32_32x32x16_bf16(PAF(3),VFR(7),o[1],0,0,0), C1,12); \
    }while(0)
  int t=1;
  #undef CMASK
  #define CMASK(P0,P1,t) do{}while(0)
  for(;t+5<NT;t+=2){
    STEP(pB0,pB1,pA0,pA1,t,true,true,true);     WAIT_BAR(2); RESC(); ROT();
    STEP(pA0,pA1,pB0,pB1,t+1,true,true,true);   WAIT_BAR(2); RESC(); ROT();
  }
  #undef CMASK
  #define CMASK(P0,P1,t) do{int jb_=(t)-(NT-4); if(jb_>=0)cmask(P0,P1,jb_,qrel,hi);}while(0)
  #define ENDW(tt) do{ if((tt)+3<NT){WAIT_BAR(2);} else if((tt)+2<NT){WAIT_BAR(1);} else {WAIT_BAR(0);} }while(0)
  for(;t+1<NT;t+=2){
    STEP(pB0,pB1,pA0,pA1,t,(t+3<NT),(t+1<NT),(t+1<NT));       ENDW(t);   RESC(); ROT();
    STEP(pA0,pA1,pB0,pB1,t+1,(t+4<NT),(t+2<NT),(t+2<NT));     ENDW(t+1); RESC(); ROT();
  }
  STEP(pB0,pB1,pA0,pA1,NT-1,false,false,false); RESC();
  { float sacc=pB0[0]+pB0[1]; _Pragma("unroll") for(int r=2;r<16;++r)sacc+=pB0[r]; _Pragma("unroll") for(int r=0;r<16;++r)sacc+=pB1[r]; l_reg+=sacc;
    pw0=(u32x4){PKW(pB0,0),PKW(pB0,2),PKW(pB0,4),PKW(pB0,6)};pw1=(u32x4){PKW(pB0,8),PKW(pB0,10),PKW(pB0,12),PKW(pB0,14)};pw2=(u32x4){PKW(pB1,0),PKW(pB1,2),PKW(pB1,4),PKW(pB1,6)};pw3=(u32x4){PKW(pB1,8),PKW(pB1,10),PKW(pB1,12),PKW(pB1,14)};
    SBAR(); pv(o,vb0+sl_cur,PAF(0),PAF(1),PAF(2),PAF(3)); }
  #undef PKW
  #undef PAF
  #undef VFR
  #undef PIN
  #undef MX3
  #undef GAPA
  #undef GAPB
  #undef EX
  #undef VRD
  #undef KRD
  #undef STEP
  #undef ENDW
  {auto rr=__builtin_amdgcn_permlane32_swap(__float_as_uint(l_reg),__float_as_uint(l_reg),false,false);l_reg=__uint_as_float(rr[0])+__uint_as_float(rr[1]);}
  if(hi==0)wsf[32+r32]=l_reg;asm volatile("s_waitcnt lgkmcnt(0)":::"memory");
  float rli[16];
  #pragma unroll
  for(int r=0;r<16;++r)rli[r]=__builtin_amdgcn_rcpf(wsf[32+crow(r,hi)]);
  bf16*Ow=O+(rowbase+q0+wid*QBLK)*DM+h*D; const bf16*Gw=Gt+(rowbase+q0+wid*QBLK)*DM+h*D;
  { bf16*stg=(bf16*)(shm+LDS_OST)+wid*2048;
    #pragma unroll
    for(int r=0;r<16;++r){const int orow=crow(r,hi);
      #pragma unroll
      for(int d0=0;d0<2;++d0)stg[orow*64+d0*32+r32]=__float2bfloat16(o[d0][r]*rli[r]);}
    asm volatile("s_waitcnt lgkmcnt(0)":::"memory");
    #pragma unroll
    for(int i=0;i<4;++i){const int row=i*8+(lane>>3),ch=lane&7; const u32x4 v=*(const u32x4*)(stg+row*64+ch*8); const u32x4 g=*(const u32x4*)(Gw+(long)row*DM+ch*8); u32x4 w;
      #pragma unroll
      for(int e=0;e<4;++e){ const float o0=__uint_as_float(v[e]<<16),o1=__uint_as_float(v[e]&0xffff0000u),g0=__uint_as_float(g[e]<<16),g1=__uint_as_float(g[e]&0xffff0000u);
        w[e]=cvtpk_s(o0*g0*__builtin_amdgcn_rcpf(1.f+__expf(-g0)),o1*g1*__builtin_amdgcn_rcpf(1.f+__expf(-g1))); }
      ATTN_STORE16(Ow+(long)row*DM+ch*8,w);} }
  asm volatile("s_waitcnt lgkmcnt(0)\n\ts_barrier":::"memory");
  #undef DMA_K
  #undef DMA_V
  #undef CMASK
  #undef START
  #undef RESC
  #undef ROT
  #undef MKQM
  #undef BIAS
}
constexpr int ATTN_LDS_BYTES=LDS_BYTES;
struct AttnTensors { const bf16* Q; const bf16* K; const bf16* V; const float* CB; const unsigned* QKM; const bf16* G; bf16* O; };
struct AttnUnit { int bh; int qb; };
struct StaticOrder {
  int vcu;
  __device__ __forceinline__ explicit StaticOrder(int grid,int block):vcu((block%8)*(grid/8)+block/8){}
  __device__ __forceinline__ bool next(int i,AttnUnit&u)const{ if(i>=4)return false; const int s=vcu&7; u.bh=vcu>>3; u.qb=(i==0)?s:(i==1)?15-s:(i==2)?16+s:31-s; return true; }
  __device__ __forceinline__ void a_ready(const AttnUnit&)const{}
  __device__ __forceinline__ void done(const AttnUnit&)const{}
};
template<class Sched,int THRL=8> __device__ __forceinline__ void attn_phase(char*lds,const AttnTensors&T,const Sched&S,const int wave_k){
  AttnUnit u;
  for(int i=0;S.next(i,u);++i){ S.a_ready(u); attn_unit<THRL>(u.bh/NHEAD,u.bh%NHEAD,u.qb,T.Q,T.K,T.V,T.CB,T.QKM,T.G,T.O,lds,wave_k); S.done(u); }
}
#undef SBAR
#undef WAIT_BAR
}

#define LAS __attribute__((address_space(3)))
#define XB_TMO      128
#define XB_XCNT(j)  (256  + 64 * (j))
#define XB_XSUB(j)  (1280 + 64 * (j))
#define XB_XGEN(j)  (2304 + 64 * (j))
#define XB_TOP      3328
#define XB_TOPGEN   3392
#define XCD_BAR_WORDS 3456
#define XB_SPIN_CAP (1u << 18)

__device__ __forceinline__ unsigned xb_ld(unsigned* p)              { return __hip_atomic_load(p, __ATOMIC_RELAXED, __HIP_MEMORY_SCOPE_AGENT); }
__device__ __forceinline__ unsigned xb_add(unsigned* p, unsigned v) { return __hip_atomic_fetch_add(p, v, __ATOMIC_RELAXED, __HIP_MEMORY_SCOPE_AGENT); }
__device__ __forceinline__ unsigned xb_xcc_id() { return (unsigned)__builtin_amdgcn_s_getreg((3 << 11) | 20) & 0xFu; }
#define XB_SPIN(cond, bar) do { unsigned _sp = 0; while (cond) { __builtin_amdgcn_s_sleep(1); \
    if ((++_sp & 255u) == 0u) { if (xb_ld(&(bar)[XB_TMO])) break; if (_sp > XB_SPIN_CAP) { atomicAdd(&(bar)[XB_TMO], 1u); break; } } } } while (0)

struct XcdBarrier {
    unsigned* bar; unsigned x;
    volatile LAS unsigned* st;
};

__device__ __forceinline__ XcdBarrier xcd_barrier_post(unsigned* bar, volatile LAS unsigned* st) {
    XcdBarrier b; b.bar = bar; b.x = xb_xcc_id(); b.st = st;
    if (threadIdx.x == 0) (void)xb_add(&bar[XB_XCNT(b.x)], 1u);
    return b;
}
__device__ __forceinline__ void xcd_barrier_complete(unsigned* bar, unsigned x_in, unsigned& nloc, unsigned& nx) { unsigned x = x_in;
    const unsigned G = gridDim.x * gridDim.y * gridDim.z;
    asm volatile("" : "+s"(x));
    unsigned sum, cnt, mine, sp = 0u;
    for (;;) {
        sum = 0u; cnt = 0u; mine = 0u;
#pragma unroll
        for (unsigned j = 0; j < 16; ++j) { const unsigned c = xb_ld(&bar[XB_XCNT(j)]); sum += c; cnt += (c > 0u) ? 1u : 0u; mine = (j == x) ? c : mine; }
        if (sum == G) break;
        __builtin_amdgcn_s_sleep(1);
        if ((++sp & 255u) == 0u) { if (xb_ld(&bar[XB_TMO])) break; if (sp > XB_SPIN_CAP) { atomicAdd(&bar[XB_TMO], 1u); break; } }
    }
    nloc = mine > 0u ? mine : 1u; nx = cnt > 0u ? cnt : 1u;
}

__device__ __forceinline__ void xcd_barrier(const XcdBarrier& b, const bool t0  ) {
    asm volatile("s_waitcnt vmcnt(0)" ::: "memory");
    __syncthreads();
    if (t0) {
        unsigned* bar = b.bar;
        __builtin_amdgcn_s_waitcnt(0);
        unsigned nloc = b.st[0], nx = b.st[1];
        if (nloc == 0u) { xcd_barrier_complete(bar, b.x, nloc, nx); b.st[0] = nloc; b.st[1] = nx; }
        const unsigned old = xb_add(&bar[XB_XSUB(b.x)], 1u);
        const unsigned gen = old / nloc;
        if (old + 1u == (gen + 1u) * nloc) {
            __builtin_amdgcn_fence(__ATOMIC_RELEASE, "agent");
            asm volatile("s_waitcnt vmcnt(0)" ::: "memory");
            const unsigned og = xb_add(&bar[XB_TOP], 1u);
            const unsigned tg = og / nx;
            if (og + 1u == (tg + 1u) * nx) xb_add(&bar[XB_TOPGEN], 1u);
            else XB_SPIN(xb_ld(&bar[XB_TOPGEN]) == tg, bar);
            __builtin_amdgcn_fence(__ATOMIC_ACQUIRE, "agent");
            xb_add(&bar[XB_XGEN(b.x)], 1u);
            asm volatile("s_waitcnt vmcnt(0)" ::: "memory");
        } else {
            XB_SPIN(xb_ld(&bar[XB_XGEN(b.x)]) == gen, bar);
            __builtin_amdgcn_fence(__ATOMIC_ACQUIRE, "agent");
            asm volatile("s_waitcnt vmcnt(0)" ::: "memory");
        }
    }
    __syncthreads();
}

typedef unsigned short bf16_t;
typedef short bf16x8 __attribute__((ext_vector_type(8)));
typedef float f32x4 __attribute__((ext_vector_type(4)));
typedef unsigned u32x4 __attribute__((ext_vector_type(4)));
typedef unsigned u32x2 __attribute__((ext_vector_type(2)));
__device__ __forceinline__ float bf2f(bf16_t v) { return __uint_as_float((unsigned)v << 16); }
__device__ __forceinline__ unsigned f2bfu(float f) { unsigned u = __float_as_uint(f); return (u + 0x7fffu + ((u >> 16) & 1u)) >> 16; }
__device__ __forceinline__ bf16_t f2bf(float f) { return (bf16_t)f2bfu(f); }
__device__ __forceinline__ unsigned pk2(float lo, float hi) { return f2bfu(lo) | (f2bfu(hi) << 16); }
__device__ __forceinline__ float sigmoidf_(float x) { return __builtin_amdgcn_rcpf(1.0f + __expf(-x)); }
__device__ __forceinline__ float siluf_(float x) { return x * __builtin_amdgcn_rcpf(1.0f + __expf(-x)); }
template <int CTRL> __device__ __forceinline__ float dppf(float v) { return __int_as_float(__builtin_amdgcn_update_dpp(0, __float_as_int(v), CTRL, 0xf, 0xf, true)); }
__device__ __forceinline__ float allred16(float v) { v += dppf<0xB1>(v); v += dppf<0x4E>(v); v += dppf<0x141>(v); v += dppf<0x140>(v); return v; }
__device__ __forceinline__ float rdlane(float v, int l) { return __int_as_float(__builtin_amdgcn_readlane(__float_as_int(v), l)); }
__device__ __forceinline__ float wave_sum(float v) { v = allred16(v); return (rdlane(v, 0) + rdlane(v, 16)) + (rdlane(v, 32) + rdlane(v, 48)); }
__device__ __forceinline__ void ld8bf(const bf16_t* p, float (&o)[8]) {
    const u32x4 v = *(const u32x4*)p;
#pragma unroll
    for (int i = 0; i < 4; ++i) { o[2 * i] = __uint_as_float(v[i] << 16); o[2 * i + 1] = __uint_as_float(v[i] & 0xffff0000u); }
}
__device__ __forceinline__ void ld4bf(const bf16_t* p, float (&o)[4]) {
    const u32x2 v = *(const u32x2*)p;
#pragma unroll
    for (int i = 0; i < 2; ++i) { o[2 * i] = __uint_as_float(v[i] << 16); o[2 * i + 1] = __uint_as_float(v[i] & 0xffff0000u); }
}

struct EpiG1 {
    static constexpr bool PERM = true, AFTER_DRAIN = false; static constexpr int NST = 16; unsigned char* ws;
    __device__ __forceinline__ void operator()(const f32x4 (&acc)[2][2][4][2], const pg8::Unit& u, int wr, int wc, int fr, int fq) const {
        const int pn = u.pn, row0 = u.pm * 256 + wr * 64 + fr, cin = wc * 32 + 8 * fq;
        if (pn == 56) {
            float* S = (float*)(ws + O_S);
#pragma unroll
            for (int ai = 0; ai < 2; ++ai)
#pragma unroll
                for (int m = 0; m < 4; ++m) { float* rp = S + (size_t)(row0 + ai * 128 + m * 16) * 256 + cin;
#pragma unroll
                    for (int bj = 0; bj < 2; ++bj) { *(f32x4*)(rp + bj * 128) = acc[ai][bj][m][0]; *(f32x4*)(rp + bj * 128 + 4) = acc[ai][bj][m][1]; } }
            return;
        }
        size_t off; int ldc, coff; float sc = 1.f;
        if (pn < 16) { off = O_UA; ldc = 4096; coff = pn * 256; }
        else if (pn < 28) { off = O_UB; ldc = 3072; coff = (pn - 16) * 256; }
        else if (pn < 56) { const int sidx = (pn - 28) >> 2; off = O_GB + (size_t)sidx * (32 * MiB); ldc = 1024; coff = ((pn - 28) & 3) * 256; if (sidx == 1) sc = C2; }
        else { off = O_ML; ldc = 8192; coff = (pn - 57) * 256; }
        bf16_t* base = (bf16_t*)(ws + off) + coff + cin;
#pragma unroll
        for (int ai = 0; ai < 2; ++ai)
#pragma unroll
            for (int m = 0; m < 4; ++m) { bf16_t* rowp = base + (size_t)(row0 + ai * 128 + m * 16) * ldc;
#pragma unroll
                for (int bj = 0; bj < 2; ++bj) { const f32x4 v0 = acc[ai][bj][m][0] * sc, v1 = acc[ai][bj][m][1] * sc; u32x4 w;
                    w.x = pg8::cvt_pk_bf16(v0[0], v0[1]); w.y = pg8::cvt_pk_bf16(v0[2], v0[3]); w.z = pg8::cvt_pk_bf16(v1[0], v1[1]); w.w = pg8::cvt_pk_bf16(v1[2], v1[3]);
                    *(u32x4*)(rowp + bj * 128) = w; } }
    }
};
struct EpiML {
    static constexpr bool PERM = true, AFTER_DRAIN = false; static constexpr int NST = 16; unsigned char* ws;
    __device__ __forceinline__ void operator()(const f32x4 (&acc)[2][2][4][2], const pg8::Unit& u, int wr, int wc, int fr, int fq) const {
        const int row0 = u.pm * 256 + wr * 64 + fr; bf16_t* base = (bf16_t*)(ws + O_ML) + (u.pn + 3) * 256 + wc * 32 + 8 * fq;
#pragma unroll
        for (int ai = 0; ai < 2; ++ai)
#pragma unroll
            for (int m = 0; m < 4; ++m) { bf16_t* rowp = base + (size_t)(row0 + ai * 128 + m * 16) * 8192;
#pragma unroll
                for (int bj = 0; bj < 2; ++bj) { const f32x4 v0 = acc[ai][bj][m][0] * (1.0f / 256.0f), v1 = acc[ai][bj][m][1] * (1.0f / 256.0f); u32x4 w;
                    w.x = pg8::cvt_pk_bf16(v0[0], v0[1]); w.y = pg8::cvt_pk_bf16(v0[2], v0[3]); w.z = pg8::cvt_pk_bf16(v1[0], v1[1]); w.w = pg8::cvt_pk_bf16(v1[2], v1[3]);
                    *(u32x4*)(rowp + bj * 128) = w; } }
    }
};
struct PoolOrder {
    int G, c;
    __device__ bool next(int i, pg8::Unit& u) const { const int j = i * G + c; if (j >= 256) return false; u.pm = j; u.pn = j >> 6; return true; }
    __device__ __forceinline__ void a_ready(const pg8::Unit&) const {}
    __device__ __forceinline__ void done(const pg8::Unit&) const {}
};
struct RangeOrder {
    pg8::StaticOrder S; int i0, i1;
    __device__ bool next(int i, pg8::Unit& u) const { return (i0 + i < i1) && S.next(i0 + i, u); }
    __device__ __forceinline__ void a_ready(const pg8::Unit&) const {}
    __device__ __forceinline__ void done(const pg8::Unit&) const {}
};
struct EpiPool {
    static constexpr bool PERM = true, AFTER_DRAIN = false; static constexpr int NST = 16; unsigned char* ws; const float* ps;
    __device__ __forceinline__ void operator()(const f32x4 (&acc)[2][2][4][2], const pg8::Unit& u, int wr, int wc, int fr, int fq) const {
        const int g = u.pn, row0 = (u.pm & 63) * 256 + wr * 64 + fr, col0 = g * 256 + wc * 32 + 8 * fq;
        const bf16_t* GD = (const bf16_t*)(ws + O_GD) + col0; bf16_t* Y = (bf16_t*)(ws + O_Y) + (size_t)3 * T * W + col0; const float* psc = ps + col0;
#pragma unroll
        for (int ai = 0; ai < 2; ++ai)
#pragma unroll
            for (int m = 0; m < 4; ++m) { const size_t row = (size_t)(row0 + ai * 128 + m * 16);
#pragma unroll
                for (int bj = 0; bj < 2; ++bj) { float gd[8]; ld8bf(GD + row * W + bj * 128, gd);
                    const f32x4 p0 = *(const f32x4*)(psc + bj * 128), p1 = *(const f32x4*)(psc + bj * 128 + 4); float o[8];
#pragma unroll
                    for (int e = 0; e < 4; ++e) { o[e] = acc[ai][bj][m][0][e] * p0[e] * siluf_(gd[e]); o[4 + e] = acc[ai][bj][m][1][e] * p1[e] * siluf_(gd[4 + e]); }
                    u32x4 w; w.x = pg8::cvt_pk_bf16(o[0], o[1]); w.y = pg8::cvt_pk_bf16(o[2], o[3]); w.z = pg8::cvt_pk_bf16(o[4], o[5]); w.w = pg8::cvt_pk_bf16(o[6], o[7]);
                    *(u32x4*)(Y + row * W + bj * 128) = w; }
                if (m & 1) asm volatile("" ::: "memory"); }
    }
};
struct EpiG2 {
    static constexpr bool PERM = true, AFTER_DRAIN = false; static constexpr int NST = 16; unsigned char* ws; const float* w0; const float* a0;
    __device__ __forceinline__ void operator()(const f32x4 (&acc)[2][2][4][2], const pg8::Unit& u, int wr, int wc, int fr, int fq) const {
        const int row0 = u.pm * 256 + wr * 64 + fr; const bool dec = u.pn < 4; const int col0 = (u.pn & 3) * 256 + wc * 32 + 8 * fq;
        bf16_t* out = (bf16_t*)(ws + (dec ? O_WDEC : O_ASIG)) + col0; const float* bias = (dec ? w0 : a0) + col0;
        const float mul = dec ? 0.6065306597126334f : 1.0f;
#pragma unroll
        for (int ai = 0; ai < 2; ++ai)
#pragma unroll
            for (int m = 0; m < 4; ++m) { bf16_t* rp = out + (size_t)(row0 + ai * 128 + m * 16) * W;
#pragma unroll
                for (int bj = 0; bj < 2; ++bj) { float o[8]; const f32x4 b0 = *(const f32x4*)(bias + bj * 128), b1 = *(const f32x4*)(bias + bj * 128 + 4);
#pragma unroll
                    for (int e = 0; e < 4; ++e) { o[e] = mul * sigmoidf_(acc[ai][bj][m][0][e] + b0[e]); o[4 + e] = mul * sigmoidf_(acc[ai][bj][m][1][e] + b1[e]); }
                    u32x4 w; w.x = pg8::cvt_pk_bf16(o[0], o[1]); w.y = pg8::cvt_pk_bf16(o[2], o[3]); w.z = pg8::cvt_pk_bf16(o[4], o[5]); w.w = pg8::cvt_pk_bf16(o[6], o[7]);
                    *(u32x4*)(rp + bj * 128) = w; }
                asm volatile("" ::: "memory"); }
    }
};
struct EpiG3Q {
    static constexpr bool PERM = true, AFTER_DRAIN = false; static constexpr int NST = 16; unsigned char* ws; const float* bm; int wg;
    __device__ __forceinline__ void operator()(const f32x4 (&acc)[2][2][4][2], const pg8::Unit& u, int wr, int wc, int fr, int fq) const {
        const int kb = u.pn >> 3, pn = u.pn & 7, pm = u.pm & 63;
        const size_t slab = ((size_t)(wg >> 3) * 3) * (256 * D) + (size_t)(wg & 7) * 256 - ((size_t)pm * 256 * D + (size_t)pn * 256);
        const int row0 = pm * 256 + wr * 64 + fr, col0 = pn * 256 + wc * 32 + 8 * fq;
        const bf16_t* ML = (const bf16_t*)(ws + O_ML) + kb * 2048 + col0; const float* bmk = bm + kb * 2048 + col0;
        f32x4 bv[2][2];
#pragma unroll
        for (int bj = 0; bj < 2; ++bj) { bv[bj][0] = *(const f32x4*)(bmk + bj * 128); bv[bj][1] = *(const f32x4*)(bmk + bj * 128 + 4); }
        if (kb < 3) {
            bf16_t* GP = (bf16_t*)(ws + O_GP) + slab + (size_t)kb * (256 * D) + col0;
#pragma unroll
            for (int ai = 0; ai < 2; ++ai) {
                u32x4 mlv[4][2];
#pragma unroll
                for (int m = 0; m < 4; ++m)
#pragma unroll
                    for (int bj = 0; bj < 2; ++bj) mlv[m][bj] = *(const u32x4*)(ML + (size_t)(row0 + ai * 128 + m * 16) * 8192 + bj * 128);
#pragma unroll
                for (int m = 0; m < 4; ++m) { const size_t row = (size_t)(row0 + ai * 128 + m * 16);
#pragma unroll
                    for (int bj = 0; bj < 2; ++bj) {
                        float ml[8];
#pragma unroll
                        for (int i = 0; i < 4; ++i) { ml[2 * i] = __uint_as_float(mlv[m][bj][i] << 16); ml[2 * i + 1] = __uint_as_float(mlv[m][bj][i] & 0xffff0000u); }
                        f32x4 s0, s1;
#pragma unroll
                        for (int e = 0; e < 4; ++e) { s0[e] = sigmoidf_(ml[e] + bv[bj][0][e]) * acc[ai][bj][m][0][e]; s1[e] = sigmoidf_(ml[4 + e] + bv[bj][1][e]) * acc[ai][bj][m][1][e]; }
                        u32x4 w; w.x = pg8::cvt_pk_bf16(s0[0], s0[1]); w.y = pg8::cvt_pk_bf16(s0[2], s0[3]); w.z = pg8::cvt_pk_bf16(s1[0], s1[1]); w.w = pg8::cvt_pk_bf16(s1[2], s1[3]);
                        *(u32x4*)(GP + row * D + bj * 128) = w;
                    } }
                asm volatile("" ::: "memory"); }
        } else {
            const bf16_t* GP = (const bf16_t*)(ws + O_GP) + slab + col0; bf16_t* MG = (bf16_t*)(ws + O_MG) + col0;
#pragma unroll
            for (int ai = 0; ai < 2; ++ai)
#pragma unroll
                for (int mp = 0; mp < 2; ++mp) {
                    u32x4 mlv[2][2], gp[3][2][2];
#pragma unroll
                    for (int mm = 0; mm < 2; ++mm)
#pragma unroll
                        for (int bj = 0; bj < 2; ++bj) { const size_t row = (size_t)(row0 + ai * 128 + (2 * mp + mm) * 16);
                            mlv[mm][bj] = *(const u32x4*)(ML + row * 8192 + bj * 128);
#pragma unroll
                            for (int k = 0; k < 3; ++k) gp[k][mm][bj] = *(const u32x4*)(GP + (size_t)k * (256 * D) + row * D + bj * 128); }
#pragma unroll
                    for (int mm = 0; mm < 2; ++mm) { const int m = 2 * mp + mm; const size_t row = (size_t)(row0 + ai * 128 + m * 16);
#pragma unroll
                        for (int bj = 0; bj < 2; ++bj) { u32x4 w;
#pragma unroll
                            for (int i = 0; i < 4; ++i) { const int n = i >> 1, e = (i & 1) * 2;
                                float lo = sigmoidf_(__uint_as_float(mlv[mm][bj][i] << 16) + bv[bj][n][e]) * acc[ai][bj][m][n][e], hi = sigmoidf_(__uint_as_float(mlv[mm][bj][i] & 0xffff0000u) + bv[bj][n][e + 1]) * acc[ai][bj][m][n][e + 1];
#pragma unroll
                                for (int k = 0; k < 3; ++k) { lo += __uint_as_float(gp[k][mm][bj][i] << 16); hi += __uint_as_float(gp[k][mm][bj][i] & 0xffff0000u); }
                                w[i] = pg8::cvt_pk_bf16(lo, hi); }
                            *(u32x4*)(MG + row * D + bj * 128) = w; } }
                    asm volatile("" ::: "memory"); }
        }
    }
};
struct BranchOrder {
    pg8::StaticOrder S0;
    __device__ void init(int G, int c) { S0.init(T, D, G, c); }
    __device__ bool next(int i, pg8::Unit& u) const { pg8::Unit t; if (!S0.next(i >> 2, t)) return false; const int kb = i & 3; u.pm = kb * 64 + t.pm; u.pn = kb * 8 + t.pn; return true; }
    __device__ __forceinline__ void a_ready(const pg8::Unit&) const {}
    __device__ __forceinline__ void done(const pg8::Unit&) const {}
};
__device__ __forceinline__ void g3_sum(unsigned char* ws, const BranchOrder& S, int tid) {
    const bf16_t* GP = (const bf16_t*)(ws + O_GP); bf16_t* MG = (bf16_t*)(ws + O_MG);
    pg8::Unit t;
    for (int j = 0; S.S0.next(j, t); ++j)
        for (int i0 = tid; i0 < 256 * 32; i0 += 4 * 512) {
            u32x4 v[4][4];
#pragma unroll
            for (int q = 0; q < 4; ++q) { const int i = i0 + q * 512, r = i >> 5, c8 = (i & 31) * 8; const size_t off = (size_t)(t.pm * 256 + r) * D + t.pn * 256 + c8;
#pragma unroll
                for (int kb = 0; kb < 4; ++kb) v[q][kb] = *(const u32x4*)(GP + (size_t)kb * T * D + off); }
#pragma unroll
            for (int q = 0; q < 4; ++q) { const int i = i0 + q * 512, r = i >> 5, c8 = (i & 31) * 8; const size_t off = (size_t)(t.pm * 256 + r) * D + t.pn * 256 + c8; u32x4 w;
#pragma unroll
                for (int e = 0; e < 4; ++e) { float lo = 0.f, hi = 0.f;
#pragma unroll
                    for (int kb = 0; kb < 4; ++kb) { lo += __uint_as_float(v[q][kb][e] << 16); hi += __uint_as_float(v[q][kb][e] & 0xffff0000u); }
                    w[e] = pk2(lo, hi); }
                *(u32x4*)(MG + off) = w; }
        }
}
struct EpiG4 {
    static constexpr bool PERM = true, AFTER_DRAIN = false; static constexpr int NST = 32; const float* xin32; const bf16_t* xinb; bf16_t* xout;
    __device__ __forceinline__ void operator()(const f32x4 (&acc)[2][2][4][2], const pg8::Unit& u, int wr, int wc, int fr, int fq) const {
        const int row0 = u.pm * 256 + wr * 64 + fr, col0 = u.pn * 256 + wc * 32 + 8 * fq;
        if (xin32) {
#pragma unroll
            for (int q8 = 0; q8 < 4; ++q8) { const int ai = q8 >> 1, m0 = (q8 & 1) * 2;
                f32x4 xv[2][2][2];
#pragma unroll
                for (int mm = 0; mm < 2; ++mm) { const size_t off = (size_t)(row0 + ai * 128 + (m0 + mm) * 16) * D + col0;
#pragma unroll
                    for (int bj = 0; bj < 2; ++bj) { xv[mm][bj][0] = *(const f32x4*)(xin32 + off + bj * 128); xv[mm][bj][1] = *(const f32x4*)(xin32 + off + bj * 128 + 4); } }
#pragma unroll
                for (int mm = 0; mm < 2; ++mm) { const size_t off = (size_t)(row0 + ai * 128 + (m0 + mm) * 16) * D + col0;
#pragma unroll
                    for (int bj = 0; bj < 2; ++bj) { const f32x4 x0 = xv[mm][bj][0] + acc[ai][bj][m0 + mm][0], x1 = xv[mm][bj][1] + acc[ai][bj][m0 + mm][1]; u32x4 w;
                        w.x = pg8::cvt_pk_bf16(x0[0], x0[1]); w.y = pg8::cvt_pk_bf16(x0[2], x0[3]); w.z = pg8::cvt_pk_bf16(x1[0], x1[1]); w.w = pg8::cvt_pk_bf16(x1[2], x1[3]);
                        *(u32x4*)(xout + off + bj * 128) = w; } }
                asm volatile("" ::: "memory"); }
        } else {
#pragma unroll
            for (int ai = 0; ai < 2; ++ai) {
                u32x4 xv[4][2];
#pragma unroll
                for (int m = 0; m < 4; ++m)
#pragma unroll
                    for (int bj = 0; bj < 2; ++bj) xv[m][bj] = *(const u32x4*)(xinb + (size_t)(row0 + ai * 128 + m * 16) * D + col0 + bj * 128);
#pragma unroll
                for (int m = 0; m < 4; ++m) { const size_t off = (size_t)(row0 + ai * 128 + m * 16) * D + col0;
#pragma unroll
                    for (int bj = 0; bj < 2; ++bj) { u32x4 w;
#pragma unroll
                        for (int i = 0; i < 4; ++i) { const int n = i >> 1, e = (i & 1) * 2;
                            const float lo = __uint_as_float(xv[m][bj][i] << 16) + acc[ai][bj][m][n][e], hi = __uint_as_float(xv[m][bj][i] & 0xffff0000u) + acc[ai][bj][m][n][e + 1];
                            w[i] = pg8::cvt_pk_bf16(lo, hi); }
                        *(u32x4*)(xout + off + bj * 128) = w; } }
                asm volatile("" ::: "memory"); }
        }
    }
};
__device__ __forceinline__ int win_col(int n) {
    if (n < PGB) return n;
    if (n < PQ) return OBG + (n - PGB);
    if (n < PGC) return OCQ + (n - PQ);
    if (n < PUD) return OCG + (n - PGC);
    if (n < PGD) return ODI + (n - PUD);
    if (n < PS) return ODG + (n - PGD);
    if (n < PML) { const int j = n - PS; if (j < 64) return OWL + j; if (j < 128) return OAL + (j - 64); if (j < 144) return OCF + (j - 128); return -1; }
    return OML + (n - PML);
}
__device__ __forceinline__ void p1_weights(const Params& p, LAS unsigned char* lds, int gw, int ngw, int wave, int lane, size_t gt, size_t ngt) {
    LAS float* scr = (LAS float*)(lds + wave * 9216);
    constexpr int I0 = 4 * (NP / 32) * (D / 64), I1 = 16 * (D / 32) * (W / 64), I2 = 4 * (D / 32) * (D / 64), I3 = 16 * (256 / 32) * (256 / 64);
    for (int it = gw; it < I0 + I1 + I2 + I3; it += ngw) {
        int mode, r = it; if (r < I0) mode = 0; else if (r < I0 + I1) { mode = 1; r -= I0; } else if (r < I0 + I1 + I2) { mode = 2; r -= I0 + I1; } else { mode = 3; r -= I0 + I1 + I2; }
        const int N = (mode == 0) ? NP : (mode == 3 ? 256 : D), K = (mode == 1) ? W : (mode == 3 ? 256 : D), nb = N / 32, per = nb * (K / 64);
        const int mat = r / per, q = r % per, n0 = (q % nb) * 32, k0 = (q / nb) * 64, n4 = (lane & 7) * 4, kr = lane >> 3;
        const float* src; long ld; bf16_t* dst; int col;
        if (mode == 0) { col = win_col(n0 + n4); src = p.in[I_WIN] + (size_t)mat * D * NIN; ld = NIN; dst = (bf16_t*)(p.ws + O_WTIN) + (size_t)mat * NP * D; }
        else if (mode == 1) { src = p.in[I_WB] + (size_t)mat * W * D; ld = D; col = n0 + n4; dst = (bf16_t*)(p.ws + O_WTBR) + (size_t)mat * D * W; }
        else if (mode == 2) { src = p.in[I_WO] + (size_t)mat * D * D; ld = D; col = n0 + n4; dst = (bf16_t*)(p.ws + O_WTOUT) + (size_t)mat * D * D; }
        else { src = p.in[I_PW] + (size_t)mat * 65536; ld = 256; col = n0 + n4; dst = (bf16_t*)(p.ws + O_WD) + (size_t)mat * 65536; }
#pragma unroll
        for (int i = 0; i < 8; ++i) { const int kk = 8 * i + kr; const f32x4 v = (col >= 0) ? *(const f32x4*)(src + (size_t)(k0 + kk) * ld + col) : (f32x4){0.f, 0.f, 0.f, 0.f}; *(LAS f32x4*)(scr + kk * 36 + n4) = v; }
        asm volatile("s_waitcnt lgkmcnt(0)" ::: "memory");
        const int c = lane & 7;
#pragma unroll
        for (int j = 0; j < 4; ++j) { const int n = (lane >> 3) + 8 * j; const LAS float* sp = scr + (8 * c) * 36 + n; u32x4 o;
            o.x = pk2(sp[0 * 36], sp[1 * 36]); o.y = pk2(sp[2 * 36], sp[3 * 36]); o.z = pk2(sp[4 * 36], sp[5 * 36]); o.w = pk2(sp[6 * 36], sp[7 * 36]);
            *(u32x4*)(dst + (size_t)(n0 + n) * K + k0 + 8 * c) = o;
            if (mode == 0 && n0 + n >= PML + 768) {
                int a_ = __builtin_amdgcn_cvt_pk_fp8_f32(sp[0 * 36] * 256.f, sp[1 * 36] * 256.f, 0, false); a_ = __builtin_amdgcn_cvt_pk_fp8_f32(sp[2 * 36] * 256.f, sp[3 * 36] * 256.f, a_, true);
                int b_ = __builtin_amdgcn_cvt_pk_fp8_f32(sp[4 * 36] * 256.f, sp[5 * 36] * 256.f, 0, false); b_ = __builtin_amdgcn_cvt_pk_fp8_f32(sp[6 * 36] * 256.f, sp[7 * 36] * 256.f, b_, true);
                u32x2 q_; q_.x = (unsigned)a_; q_.y = (unsigned)b_;
                *(u32x2*)(p.ws + O_WQ + ((size_t)mat * (29 * 256) + (n0 + n - (PML + 768))) * D + k0 + 8 * c) = q_; } }
        asm volatile("s_waitcnt lgkmcnt(0)" ::: "memory");
    }
    for (size_t i = gt; i < (size_t)4 * 2048 * 256; i += ngt) {
        const int k = (int)(i & 255), n = (int)((i >> 8) & 2047), l = (int)(i >> 19);
        float v = 0.f;
        if (n < 1024) { if (k < 64) v = p.in[I_W2][((size_t)l * 64 + k) * W + n]; }
        else { if (k >= 64 && k < 128) v = p.in[I_A2][((size_t)l * 64 + (k - 64)) * W + (n - 1024)]; }
        ((bf16_t*)(p.ws + O_WTLORA))[i] = f2bf(v);
    }
}
__device__ __forceinline__ void e_rmsnorm(const float* __restrict__ x, const float* __restrict__ g, bf16_t* __restrict__ h, float* __restrict__ outf, int gw, int ngw, int lane, int rend = T, unsigned char* __restrict__ hq = nullptr) {
    for (int m0 = gw; m0 < rend; m0 += 2 * ngw) {
        const int m1 = (m0 + ngw < rend) ? m0 + ngw : m0;
        const f32x4* xr0 = (const f32x4*)(x + (size_t)m0 * D); const f32x4* xr1 = (const f32x4*)(x + (size_t)m1 * D);
        f32x4 v0[8], v1[8]; float ss0 = 0.f, ss1 = 0.f;
#pragma unroll
        for (int j = 0; j < 8; ++j) { v0[j] = xr0[lane + 64 * j]; v1[j] = xr1[lane + 64 * j]; }
#pragma unroll
        for (int j = 0; j < 8; ++j) { ss0 += (v0[j].x * v0[j].x + v0[j].y * v0[j].y) + (v0[j].z * v0[j].z + v0[j].w * v0[j].w); ss1 += (v1[j].x * v1[j].x + v1[j].y * v1[j].y) + (v1[j].z * v1[j].z + v1[j].w * v1[j].w); }
        ss0 = wave_sum(ss0); ss1 = wave_sum(ss1);
        const float rs0 = rsqrtf(ss0 * (1.0f / D) + 1e-6f), rs1 = rsqrtf(ss1 * (1.0f / D) + 1e-6f);
#pragma unroll
        for (int j = 0; j < 8; ++j) {
            const f32x4 gg = ((const f32x4*)g)[lane + 64 * j];
            const f32x4 o0 = v0[j] * rs0 * gg, o1 = v1[j] * rs1 * gg;
            if (h) { u32x2 w; w.x = pk2(o0.x, o0.y); w.y = pk2(o0.z, o0.w); *(u32x2*)(h + (size_t)m0 * D + (lane + 64 * j) * 4) = w;
                     if (hq) { int q_ = __builtin_amdgcn_cvt_pk_fp8_f32(o0.x, o0.y, 0, false); q_ = __builtin_amdgcn_cvt_pk_fp8_f32(o0.z, o0.w, q_, true); *(int*)(hq + (size_t)m0 * D + (lane + 64 * j) * 4) = q_; }
                     if (m1 != m0) { w.x = pk2(o1.x, o1.y); w.y = pk2(o1.z, o1.w); *(u32x2*)(h + (size_t)m1 * D + (lane + 64 * j) * 4) = w;
                         if (hq) { int q_ = __builtin_amdgcn_cvt_pk_fp8_f32(o1.x, o1.y, 0, false); q_ = __builtin_amdgcn_cvt_pk_fp8_f32(o1.z, o1.w, q_, true); *(int*)(hq + (size_t)m1 * D + (lane + 64 * j) * 4) = q_; } } }
            else { ((f32x4*)(outf + (size_t)m0 * D))[lane + 64 * j] = o0; if (m1 != m0) ((f32x4*)(outf + (size_t)m1 * D))[lane + 64 * j] = o1; }
        }
    }
}
__device__ __forceinline__ void e_rmsnorm_bf(const bf16_t* __restrict__ x, const float* __restrict__ g, bf16_t* __restrict__ h, float* __restrict__ outf, int gw, int ngw, int lane, int rend = T, unsigned char* __restrict__ hq = nullptr) {
    for (int m0 = gw; m0 < rend; m0 += 2 * ngw) {
        const int m1 = (m0 + ngw < rend) ? m0 + ngw : m0;
        const u32x4* xr0 = (const u32x4*)(x + (size_t)m0 * D); const u32x4* xr1 = (const u32x4*)(x + (size_t)m1 * D);
        u32x4 r0[4], r1[4]; float v0[4][8], v1[4][8], ss0 = 0.f, ss1 = 0.f;
#pragma unroll
        for (int j = 0; j < 4; ++j) { r0[j] = xr0[lane + 64 * j]; r1[j] = xr1[lane + 64 * j]; }
#pragma unroll
        for (int j = 0; j < 4; ++j)
#pragma unroll
            for (int i = 0; i < 4; ++i) { v0[j][2 * i] = __uint_as_float(r0[j][i] << 16); v0[j][2 * i + 1] = __uint_as_float(r0[j][i] & 0xffff0000u); v1[j][2 * i] = __uint_as_float(r1[j][i] << 16); v1[j][2 * i + 1] = __uint_as_float(r1[j][i] & 0xffff0000u);
                ss0 += v0[j][2 * i] * v0[j][2 * i] + v0[j][2 * i + 1] * v0[j][2 * i + 1]; ss1 += v1[j][2 * i] * v1[j][2 * i] + v1[j][2 * i + 1] * v1[j][2 * i + 1]; }
        ss0 = wave_sum(ss0); ss1 = wave_sum(ss1);
        const float rs0 = rsqrtf(ss0 * (1.0f / D) + 1e-6f), rs1 = rsqrtf(ss1 * (1.0f / D) + 1e-6f);
#pragma unroll
        for (int j = 0; j < 4; ++j) {
            const f32x4 ga = *(const f32x4*)(g + (lane + 64 * j) * 8), gb = *(const f32x4*)(g + (lane + 64 * j) * 8 + 4);
            float o0[8], o1[8];
#pragma unroll
            for (int e = 0; e < 4; ++e) { o0[e] = v0[j][e] * rs0 * ga[e]; o0[4 + e] = v0[j][4 + e] * rs0 * gb[e]; o1[e] = v1[j][e] * rs1 * ga[e]; o1[4 + e] = v1[j][4 + e] * rs1 * gb[e]; }
            if (h) { u32x4 w; w.x = pk2(o0[0], o0[1]); w.y = pk2(o0[2], o0[3]); w.z = pk2(o0[4], o0[5]); w.w = pk2(o0[6], o0[7]); *(u32x4*)(h + (size_t)m0 * D + (lane + 64 * j) * 8) = w;
                     if (hq) { u32x2 q_; int a_ = __builtin_amdgcn_cvt_pk_fp8_f32(o0[0], o0[1], 0, false); a_ = __builtin_amdgcn_cvt_pk_fp8_f32(o0[2], o0[3], a_, true); int b_ = __builtin_amdgcn_cvt_pk_fp8_f32(o0[4], o0[5], 0, false); b_ = __builtin_amdgcn_cvt_pk_fp8_f32(o0[6], o0[7], b_, true); q_.x = (unsigned)a_; q_.y = (unsigned)b_; *(u32x2*)(hq + (size_t)m0 * D + (lane + 64 * j) * 8) = q_; }
                     if (m1 != m0) { w.x = pk2(o1[0], o1[1]); w.y = pk2(o1[2], o1[3]); w.z = pk2(o1[4], o1[5]); w.w = pk2(o1[6], o1[7]); *(u32x4*)(h + (size_t)m1 * D + (lane + 64 * j) * 8) = w;
                         if (hq) { u32x2 q_; int a_ = __builtin_amdgcn_cvt_pk_fp8_f32(o1[0], o1[1], 0, false); a_ = __builtin_amdgcn_cvt_pk_fp8_f32(o1[2], o1[3], a_, true); int b_ = __builtin_amdgcn_cvt_pk_fp8_f32(o1[4], o1[5], 0, false); b_ = __builtin_amdgcn_cvt_pk_fp8_f32(o1[6], o1[7], b_, true); q_.x = (unsigned)a_; q_.y = (unsigned)b_; *(u32x2*)(hq + (size_t)m1 * D + (lane + 64 * j) * 8) = q_; } } }
            else { float* p0 = outf + (size_t)m0 * D + (lane + 64 * j) * 8; *(f32x4*)p0 = (f32x4){o0[0], o0[1], o0[2], o0[3]}; *(f32x4*)(p0 + 4) = (f32x4){o0[4], o0[5], o0[6], o0[7]};
                   if (m1 != m0) { float* p1 = outf + (size_t)m1 * D + (lane + 64 * j) * 8; *(f32x4*)p1 = (f32x4){o1[0], o1[1], o1[2], o1[3]}; *(f32x4*)(p1 + 4) = (f32x4){o1[4], o1[5], o1[6], o1[7]}; } }
        }
    }
}
__device__ __forceinline__ void e1_conv(const bf16_t* __restrict__ UA, bf16_t* __restrict__ Y, const float* __restrict__ cw, size_t gt, size_t ngt) {
    for (size_t it = gt; it < (size_t)(T / 4) * 128; it += ngt) {
        const int t0 = (int)(it >> 7) * 4, c = (int)(it & 127) * 8, s0 = t0 & (SEQ - 1);
        float w0[8], w1[8], w2[8], cm2[8], cm1[8], a[8], b2[8];
#pragma unroll
        for (int i = 0; i < 8; ++i) { w0[i] = cw[c + i]; w1[i] = cw[W + c + i]; w2[i] = cw[2 * W + c + i]; cm2[i] = 0.f; cm1[i] = 0.f; }
        u32x4 vb[4], vg[4], va[4], vx[4];
#pragma unroll
        for (int j = 0; j < 4; ++j) { const size_t t = (size_t)(t0 + j); vb[j] = *(const u32x4*)(UA + t * 4096 + c); vg[j] = *(const u32x4*)(UA + t * 4096 + 3072 + c); va[j] = *(const u32x4*)(UA + t * 4096 + 1024 + c); vx[j] = *(const u32x4*)(UA + t * 4096 + 2048 + c); }
        if (s0 > 0) {
            ld8bf(UA + (size_t)(t0 - 2) * 4096 + 1024 + c, a); ld8bf(UA + (size_t)(t0 - 2) * 4096 + 2048 + c, b2);
#pragma unroll
            for (int i = 0; i < 8; ++i) cm2[i] = a[i] * b2[i];
            ld8bf(UA + (size_t)(t0 - 1) * 4096 + 1024 + c, a); ld8bf(UA + (size_t)(t0 - 1) * 4096 + 2048 + c, b2);
#pragma unroll
            for (int i = 0; i < 8; ++i) cm1[i] = a[i] * b2[i];
        }
#pragma unroll
        for (int j = 0; j < 4; ++j) {
            const size_t t = (size_t)(t0 + j);
            float bg[8], g[8], cx[8];
#pragma unroll
            for (int i = 0; i < 4; ++i) { bg[2 * i] = __uint_as_float(vb[j][i] << 16); bg[2 * i + 1] = __uint_as_float(vb[j][i] & 0xffff0000u); g[2 * i] = __uint_as_float(vg[j][i] << 16); g[2 * i + 1] = __uint_as_float(vg[j][i] & 0xffff0000u);
                a[2 * i] = __uint_as_float(va[j][i] << 16); a[2 * i + 1] = __uint_as_float(va[j][i] & 0xffff0000u); b2[2 * i] = __uint_as_float(vx[j][i] << 16); b2[2 * i + 1] = __uint_as_float(vx[j][i] & 0xffff0000u); }
            u32x4 o; float z[8];
#pragma unroll
            for (int i = 0; i < 8; ++i) { cx[i] = a[i] * b2[i]; z[i] = (w0[i] * cm2[i] + w1[i] * cm1[i] + w2[i] * cx[i]) * bg[i] * siluf_(g[i]); cm2[i] = cm1[i]; cm1[i] = cx[i]; }
#pragma unroll
            for (int i = 0; i < 4; ++i) o[i] = pk2(z[2 * i], z[2 * i + 1]);
            *(u32x4*)(Y + t * W + c) = o;
        }
    }
}
__device__ __forceinline__ void e1_pool(const bf16_t* __restrict__ UD, bf16_t* __restrict__ PG, size_t gt, size_t ngt) {
    for (size_t it = gt; it < (size_t)(T / 16) * 128; it += ngt) {
        const int t0 = (int)(it >> 7) * 16, c = (int)(it & 127) * 8, s0 = t0 & (SEQ - 1);
        const int win = 2 << (c >> 8);
        float sum[8], tmp[8], cur[8];
#pragma unroll
        for (int i = 0; i < 8; ++i) sum[i] = 0.f;
        u32x4 cv[16];
#pragma unroll
        for (int j = 0; j < 16; ++j) cv[j] = *(const u32x4*)(UD + (size_t)(t0 + j) * W + c);
        if (s0 > 0) {
#pragma unroll
            for (int j = 1; j < 16; ++j) if (j < win) { ld8bf(UD + (size_t)(t0 - j) * W + c, tmp);
#pragma unroll
                for (int i = 0; i < 8; ++i) sum[i] += tmp[i]; } }
        bf16_t* dst = PG + ((size_t)(c >> 8) * T + t0) * 256 + (c & 255);
#pragma unroll
        for (int j = 0; j < 16; ++j) {
            const int s = s0 + j;
#pragma unroll
            for (int i = 0; i < 4; ++i) { cur[2 * i] = __uint_as_float(cv[j][i] << 16); cur[2 * i + 1] = __uint_as_float(cv[j][i] & 0xffff0000u); }
#pragma unroll
            for (int i = 0; i < 8; ++i) sum[i] += cur[i];
            const int cnt = (s + 1 < win) ? s + 1 : win; const float inv = 1.0f / (float)cnt;
            u32x4 o;
#pragma unroll
            for (int i = 0; i < 4; ++i) o[i] = pk2(sum[2 * i] * inv - cur[2 * i], sum[2 * i + 1] * inv - cur[2 * i + 1]);
            *(u32x4*)(dst + (size_t)j * 256) = o;
            if (s + 1 >= win) {
                ld8bf(UD + ((size_t)(t0 + j) + 1 - win) * W + c, tmp);
#pragma unroll
                for (int i = 0; i < 8; ++i) sum[i] -= tmp[i]; }
        }
    }
}
__device__ __forceinline__ void e1_lora(const float* __restrict__ S, bf16_t* __restrict__ LA, float* __restrict__ LF, const float* __restrict__ mu, const float* __restrict__ bf, size_t gt, size_t ngt) {
#pragma unroll 4
    for (size_t it = gt; it < (size_t)T * 64; it += ngt) {
        const int t = (int)(it >> 6), j = (int)(it & 63) * 4, s = t & (SEQ - 1);
        f32x4 o = {0.f, 0.f, 0.f, 0.f};
        if (j < 128) {
            const f32x4 cur = *(const f32x4*)(S + (size_t)t * 256 + j), prv = (s > 0) ? *(const f32x4*)(S + (size_t)(t - 1) * 256 + j) : (f32x4){0.f, 0.f, 0.f, 0.f}, m4 = *(const f32x4*)(mu + j);
#pragma unroll
            for (int e = 0; e < 4; ++e) { const float xm = cur[e] + (prv[e] - cur[e]) * m4[e]; o[e] = (j < 64) ? (1.0f - 2.0f * __builtin_amdgcn_rcpf(__expf(2.0f * xm) + 1.0f)) : xm; }
        } else if (j < 144) {
            const f32x4 x4 = *(const f32x4*)(S + (size_t)t * 256 + j) + *(const f32x4*)(bf + (j - 128)); f32x4 lf;
#pragma unroll
            for (int e = 0; e < 4; ++e) lf[e] = fminf(x4[e], 0.f) - __logf(1.0f + __expf(-fabsf(x4[e])));
            *(f32x4*)(LF + (size_t)t * 16 + (j - 128)) = lf;
        }
        u32x2 w; w.x = pk2(o[0], o[1]); w.y = pk2(o[2], o[3]);
        *(u32x2*)(LA + (size_t)t * 256 + j) = w;
    }
}
__device__ __forceinline__ void e1_phase(const Params& p, int l, size_t gt, size_t ngt, int gw, int ngw, int lane) {
    unsigned char* ws = p.ws;
    e1_lora((const float*)(ws + O_S), (bf16_t*)(ws + O_LA), (float*)(ws + O_LF), p.in[I_MU] + (size_t)l * 3200 + 3072, p.in[I_BF] + (size_t)l * 16, gt, ngt);
}
__device__ __forceinline__ void e_cumsum_wg(const Params& p, int l, int bh, int wave, int lane, volatile LAS float* wsum) {
    const int b = bh >> 4, h = bh & 15;
    const float* SF = (const float*)(p.ws + O_S) + ((size_t)b * SEQ) * 256 + 128 + h; float* CB = (float*)(p.ws + O_CB) + (size_t)bh * SEQ; const float bfh = p.in[I_BF][(size_t)l * 16 + h];
    const int s0 = (wave * 64 + lane) * 16;
    float v[16], loc = 0.f;
#pragma unroll
    for (int i = 0; i < 16; ++i) { const float x = SF[(size_t)(s0 + i) * 256] + bfh; v[i] = fminf(x, 0.f) - __logf(1.0f + __expf(-fabsf(x))); }
#pragma unroll
    for (int i = 0; i < 16; ++i) loc += v[i];
    float inc = loc;
#pragma unroll
    for (int o = 1; o < 64; o <<= 1) { const float n = __int_as_float(__builtin_amdgcn_ds_bpermute(((lane >= o) ? lane - o : lane) << 2, __float_as_int(inc))); if (lane >= o) inc += n; }
    if (lane == 63) wsum[wave] = inc;
    asm volatile("s_waitcnt lgkmcnt(0)" ::: "memory"); __builtin_amdgcn_s_barrier(); asm volatile("" ::: "memory");
    float run = inc - loc;
#pragma unroll
    for (int w = 0; w < 7; ++w) run += (w < wave) ? wsum[w] : 0.f;
#pragma unroll
    for (int i = 0; i < 4; ++i) { f32x4 o;
#pragma unroll
        for (int e = 0; e < 4; ++e) { run += v[4 * i + e]; o[e] = run * LOG2E; }
        *(f32x4*)(CB + s0 + 4 * i) = o; }
}
constexpr int LDS_LA = 131072 + 8192;
constexpr int CB_APT = 0, CB_RTT = 2048, CB_G1T = 4096, CB_ARBT = 4608, CB_ARKT = 5120, CB_WC = 5632, CB_BB = 6144, CB_KB = 8192, CB_VT = 10240, CB_BYTES = 12288;
constexpr int GRP = 36;
constexpr int EL_X = 0, EL_Y = 4608, EL_ATT = 9216, EL_GR = 11264, EL_TM = 0, EL_G1 = 1088, EL_BYTES = 16384;
__device__ __forceinline__ unsigned pkbf(float lo, float hi) { return pg8::cvt_pk_bf16(lo, hi); }
__device__ __forceinline__ void e2c_phase(const Params& p, int l, LAS unsigned char* lds, int bx, int wave, int lane) {
    unsigned char* ws = p.ws;
    const bf16_t* UB = (const bf16_t*)(ws + O_UB); const bf16_t* WTL = (const bf16_t*)(ws + O_WTLORA) + (size_t)l * 2048 * 256;
    const float* w0p = p.in[I_W0] + (size_t)l * W; const float* a0p = p.in[I_A0] + (size_t)l * W;
    unsigned char* BLOB = ws + O_SCN; float* BON = (float*)(ws + O_VS);
    const float* mu = p.in[I_MU] + (size_t)l * 3200; const float* kkp = p.in[I_KK] + (size_t)l * W; const float* kap = p.in[I_KA] + (size_t)l * W;
    LAS unsigned char* L = lds + wave * EL_BYTES;
    const int r32 = lane & 31, hh = lane >> 5, l16 = lane & 15, rg = lane >> 4;
    for (int k_ = 0; k_ < 8; ++k_) {
        const int jr = k_ >> 1, cr = bx * 4 + jr, b = cr >> 9, c = cr & 511, h = wave * 2 + (k_ & 1), bh = b * 16 + h, ch = h * 64 + lane;
        const size_t tok0 = (size_t)b * SEQ + c * 16;
        const float mr = mu[ch], mk = mu[1024 + ch], mv = mu[2048 + ch], kkc = kkp[ch], kac = kap[ch], rkc = p.in[I_RK][(size_t)l * W + ch];
        float pr = 0.f, pk = 0.f, pv = 0.f;
        if (c > 0) { pr = bf2f(UB[(tok0 - 1) * 3072 + ch]); pk = bf2f(UB[(tok0 - 1) * 3072 + 1024 + ch]); pv = bf2f(UB[(tok0 - 1) * 3072 + 2048 + ch]); }
        float At[16], Rt[16], Bh[16], Kh[16], Vv[16];
        float Wc = 1.0f;
        float wdv[16], asv[16];
        { attn_body::f32x16 xw0 = attn_body::f32x16{}, xw1 = xw0, xa0 = xw0, xa1 = xw0;
          const int arow = jr * 16 + (lane & 15); const LAS unsigned char* ap = lds + LDS_LA + arow * 256; const bf16_t* bw = WTL + (size_t)(h * 64 + r32) * 256 + hh * 8; const bf16_t* ba = bw + (size_t)1024 * 256 + 64;
#pragma unroll
          for (int ks = 0; ks < 4; ++ks) {
              u32x4 aw = {0u, 0u, 0u, 0u}, aa = {0u, 0u, 0u, 0u};
              if (r32 < 16) { aw = *(const LAS u32x4*)(ap + (((ks * 2 + hh) ^ (arow & 15)) * 16)); aa = *(const LAS u32x4*)(ap + (((8 + ks * 2 + hh) ^ (arow & 15)) * 16)); }
              const bf16x8 fw = __builtin_bit_cast(bf16x8, aw), fa = __builtin_bit_cast(bf16x8, aa);
              xw0 = __builtin_amdgcn_mfma_f32_32x32x16_bf16(fw, *(const bf16x8*)(bw + ks * 16), xw0, 0, 0, 0);
              xw1 = __builtin_amdgcn_mfma_f32_32x32x16_bf16(fw, *(const bf16x8*)(bw + 32 * 256 + ks * 16), xw1, 0, 0, 0);
              xa0 = __builtin_amdgcn_mfma_f32_32x32x16_bf16(fa, *(const bf16x8*)(ba + ks * 16), xa0, 0, 0, 0);
              xa1 = __builtin_amdgcn_mfma_f32_32x32x16_bf16(fa, *(const bf16x8*)(ba + 32 * 256 + ks * 16), xa1, 0, 0, 0);
          }
          const float w0c = w0p[ch], a0c = a0p[ch];
#pragma unroll
          for (int r = 0; r < 8; ++r) { const int t = (r & 3) + 8 * (r >> 2);
              auto rw = __builtin_amdgcn_permlane32_swap(__float_as_uint(xw0[r]), __float_as_uint(xw1[r]), false, false);
              auto ra = __builtin_amdgcn_permlane32_swap(__float_as_uint(xa0[r]), __float_as_uint(xa1[r]), false, false);
              wdv[t] = __builtin_amdgcn_exp2f(-0.6065306597126334f * LOG2E * sigmoidf_(__builtin_bit_cast(float, (unsigned)rw[0]) + w0c));
              wdv[t + 4] = __builtin_amdgcn_exp2f(-0.6065306597126334f * LOG2E * sigmoidf_(__builtin_bit_cast(float, (unsigned)rw[1]) + w0c));
              asv[t] = sigmoidf_(__builtin_bit_cast(float, (unsigned)ra[0]) + a0c); asv[t + 4] = sigmoidf_(__builtin_bit_cast(float, (unsigned)ra[1]) + a0c); }
        }
        float invn_l;
        { LAS float* PT = (LAS float*)(L + EL_X); float pk2_ = pk;
#pragma unroll
          for (int t = 0; t < 16; ++t) { const float ck = bf2f(UB[(tok0 + t) * 3072 + 1024 + ch]); const float kr = (ck + (pk2_ - ck) * mk) * kkc; pk2_ = ck; PT[t * 68 + lane] = kr * kr; }
          asm volatile("s_waitcnt lgkmcnt(0)" ::: "memory");
          const LAS float* pr_ = PT + l16 * 68 + rg * 16; float n2 = 0.f;
#pragma unroll
          for (int i = 0; i < 4; ++i) { const f32x4 q4 = *(const LAS f32x4*)(pr_ + 4 * i); n2 += (q4[0] + q4[1]) + (q4[2] + q4[3]); }
          n2 += __builtin_bit_cast(float, __builtin_amdgcn_ds_swizzle(__builtin_bit_cast(int, n2), 0x401F));
          { const unsigned ub_ = __float_as_uint(n2); auto rr = __builtin_amdgcn_permlane32_swap(ub_, ub_, false, false); n2 = __uint_as_float(rr[0]) + __uint_as_float(rr[1]); }
          invn_l = 1.0f / fmaxf(sqrtf(n2), 1e-12f);
          asm volatile("s_waitcnt lgkmcnt(0)" ::: "memory"); }
#pragma unroll
        for (int t = 0; t < 16; ++t) {
            const size_t tok = tok0 + t;
            const float cr = bf2f(UB[tok * 3072 + ch]), ck = bf2f(UB[tok * 3072 + 1024 + ch]), cv = bf2f(UB[tok * 3072 + 2048 + ch]);
            const float wd = wdv[t], as = asv[t];
            const float r = cr + (pr - cr) * mr, k = ck + (pk - ck) * mk, v = cv + (pv - cv) * mv;
            pr = cr; pk = ck; pv = cv;
            const float kkr = k * kkc, k2 = k * (1.0f + (as - 1.0f) * kac);
            const float kk = kkr * rdlane(invn_l, t);
            const float Wprev = Wc; Wc *= wd; const float iW = __builtin_amdgcn_rcpf(Wc);
            At[t] = -kk * Wprev; Rt[t] = r * Wc; Bh[t] = kk * as * iW; Kh[t] = k2 * iW; Vv[t] = v; ((LAS float*)(L + EL_X))[t * 68 + lane] = r * k2 * rkc;
        }
        { LAS float* PT = (LAS float*)(L + EL_X);
          asm volatile("s_waitcnt lgkmcnt(0)" ::: "memory");
          const LAS float* pr_ = PT + l16 * 68 + rg * 16; float bs = 0.f;
#pragma unroll
          for (int i = 0; i < 4; ++i) { const f32x4 q4 = *(const LAS f32x4*)(pr_ + 4 * i); bs += (q4[0] + q4[1]) + (q4[2] + q4[3]); }
          bs += __builtin_bit_cast(float, __builtin_amdgcn_ds_swizzle(__builtin_bit_cast(int, bs), 0x401F));
          { const unsigned ub_ = __builtin_bit_cast(unsigned, bs); auto rr = __builtin_amdgcn_permlane32_swap(ub_, ub_, false, false); bs = __builtin_bit_cast(float, (unsigned)rr[0]) + __builtin_bit_cast(float, (unsigned)rr[1]); }
          if (lane < 16) BON[(tok0 + lane) * 16 + h] = bs;
          asm volatile("s_waitcnt lgkmcnt(0)" ::: "memory"); }
        { LAS bf16_t* X = (LAS bf16_t*)(L + EL_X); LAS bf16_t* Y = (LAS bf16_t*)(L + EL_Y);
#pragma unroll
          for (int t = 0; t < 16; ++t) { const unsigned ux = pkbf(Bh[t], Kh[t]), uy = pkbf(At[t], Rt[t]);
              X[t * 72 + lane] = (bf16_t)(ux & 0xffffu); X[(16 + t) * 72 + lane] = (bf16_t)(ux >> 16); Y[t * 72 + lane] = (bf16_t)(uy & 0xffffu); Y[(16 + t) * 72 + lane] = (bf16_t)(uy >> 16); }
          u32x4 w0, w1;
#pragma unroll
          for (int i = 0; i < 4; ++i) { w0[i] = pkbf(At[2 * i], At[2 * i + 1]); w1[i] = pkbf(At[8 + 2 * i], At[8 + 2 * i + 1]); }
          *(LAS u32x4*)(L + EL_ATT + lane * 32) = w0; *(LAS u32x4*)(L + EL_ATT + lane * 32 + 16) = w1; }
        asm volatile("s_waitcnt lgkmcnt(0)" ::: "memory");
        attn_body::f32x16 gram = attn_body::f32x16{};
#pragma unroll
        for (int s4 = 0; s4 < 4; ++s4) {
            const bf16x8 fa = *(const LAS bf16x8*)(L + EL_X + r32 * 144 + s4 * 32 + hh * 16), fb = *(const LAS bf16x8*)(L + EL_Y + r32 * 144 + s4 * 32 + hh * 16);
            gram = __builtin_amdgcn_mfma_f32_32x32x16_bf16(fa, fb, gram, 0, 0, 0);
        }
        { LAS float* GR = (LAS float*)(L + EL_GR);
#pragma unroll
          for (int i = 0; i < 16; ++i) GR[((i & 3) + 8 * (i >> 2) + 4 * hh) * GRP + r32] = gram[i]; }
        asm volatile("s_waitcnt lgkmcnt(0)" ::: "memory");
        { const LAS float* GR = (const LAS float*)(L + EL_GR); float x[16];
          int l16o = l16; asm volatile("" : "+v"(l16o));
#pragma unroll
          for (int t = 0; t < 16; ++t) x[t] = (l16o == t) ? 1.0f : 0.f;
#pragma unroll
          for (int s_ = 0; s_ < 15; ++s_) { f32x4 n4[4];
#pragma unroll
              for (int g = (s_ + 1) >> 2; g < 4; ++g) n4[g] = *(const LAS f32x4*)(GR + s_ * GRP + 4 * g);
              if ((s_ & 1) == 1) asm volatile("" ::: "memory");
#pragma unroll
              for (int g = (s_ + 1) >> 2; g < 4; ++g)
#pragma unroll
                  for (int e = 0; e < 4; ++e) if (4 * g + e > s_) x[4 * g + e] += x[s_] * n4[g][e]; }
          asm volatile("s_waitcnt lgkmcnt(0)" ::: "memory");
          LAS float* TM = (LAS float*)(L + EL_TM);
          if (rg == 0) {
#pragma unroll
              for (int t = 0; t < 16; ++t) TM[l16 * 17 + t] = x[t]; } }
        asm volatile("s_waitcnt lgkmcnt(0)" ::: "memory");
        attn_body::f32x16 ap0, ap1, g1;
        { const LAS float* TM = (const LAS float*)(L + EL_TM); const LAS float* GR = (const LAS float*)(L + EL_GR);
          u32x4 tb, ga;
#pragma unroll
          for (int i = 0; i < 4; ++i) {
              const float t0 = (r32 < 16) ? TM[(8 * hh + 2 * i) * 17 + r32] : 0.f, t1 = (r32 < 16) ? TM[(8 * hh + 2 * i + 1) * 17 + r32] : 0.f; tb[i] = pkbf(t0, t1);
              const int s0 = 8 * hh + 2 * i, s1 = s0 + 1;
              const float a0 = (r32 < 16 && r32 < s0) ? GR[(16 + r32) * GRP + s0] : 0.f, a1 = (r32 < 16 && r32 < s1) ? GR[(16 + r32) * GRP + s1] : 0.f; ga[i] = pkbf(a0, a1); }
          const bf16x8 ftm = __builtin_bit_cast(bf16x8, tb);
          const bf16x8 fa0 = *(const LAS bf16x8*)(L + EL_ATT + r32 * 32 + hh * 16), fa1 = *(const LAS bf16x8*)(L + EL_ATT + (32 + r32) * 32 + hh * 16);
          const attn_body::f32x16 z16 = attn_body::f32x16{};
          ap0 = __builtin_amdgcn_mfma_f32_32x32x16_bf16(fa0, ftm, z16, 0, 0, 0);
          ap1 = __builtin_amdgcn_mfma_f32_32x32x16_bf16(fa1, ftm, z16, 0, 0, 0);
          g1 = __builtin_amdgcn_mfma_f32_32x32x16_bf16(__builtin_bit_cast(bf16x8, ga), ftm, z16, 0, 0, 0);
          LAS float* G1L = (LAS float*)(L + EL_G1);
          if (r32 < 16) {
#pragma unroll
              for (int i = 0; i < 8; ++i) G1L[((i & 3) + 8 * (i >> 2) + 4 * hh) * 17 + r32] = g1[i]; } }
        asm volatile("s_waitcnt lgkmcnt(0)" ::: "memory");
        unsigned char* out = BLOB + ((size_t)(bh >> 1) * 512 + c) * (2 * CB_BYTES) + (size_t)(bh & 1) * CB_BYTES;
        { const LAS float* GR = (const LAS float*)(L + EL_GR); const LAS float* G1L = (const LAS float*)(L + EL_G1); const LAS unsigned char* Yb = L + EL_Y;
          if (r32 < 16) {
              const int t = r32, slot = (t + 16 * hh) * 16;
#pragma unroll
              for (int s = 0; s < 2; ++s) {
                  u32x4 w0, w1;
#pragma unroll
                  for (int i = 0; i < 4; ++i) { w0[i] = pkbf(ap0[8 * s + 2 * i], ap0[8 * s + 2 * i + 1]); w1[i] = pkbf(ap1[8 * s + 2 * i], ap1[8 * s + 2 * i + 1]); }
                  *(u32x4*)(out + CB_APT + s * 512 + slot) = w0; *(u32x4*)(out + CB_APT + (2 + s) * 512 + slot) = w1;
#pragma unroll
                  for (int kt = 0; kt < 2; ++kt) { const LAS unsigned char* yr = Yb + (16 + t) * 144 + (32 * kt + 16 * s + 4 * hh) * 2;
                      const u32x2 lo = *(const LAS u32x2*)(yr), hi2 = *(const LAS u32x2*)(yr + 16); u32x4 w; w.x = lo.x; w.y = lo.y; w.z = hi2.x; w.w = hi2.y;
                      *(u32x4*)(out + CB_RTT + (kt * 2 + s) * 512 + slot) = w; }
              }
              u32x4 wg, wb, wk;
#pragma unroll
              for (int i = 0; i < 4; ++i) {
                  const int j0 = 2 * i, j1 = 2 * i + 1;
                  wg[i] = pkbf(G1L[(8 * hh + j0) * 17 + t], G1L[(8 * hh + j1) * 17 + t]);
                  const int sa = 8 * (j0 >> 2) + 4 * hh + (j0 & 3), sb = sa + 1;
                  wb[i] = pkbf((sa <= t) ? GR[sa * GRP + 16 + t] : 0.f, (sb <= t) ? GR[sb * GRP + 16 + t] : 0.f);
                  const int ka = 8 * hh + j0, kb = ka + 1;
                  wk[i] = pkbf((ka <= t) ? GR[(16 + ka) * GRP + 16 + t] : 0.f, (kb <= t) ? GR[(16 + kb) * GRP + 16 + t] : 0.f); }
              *(u32x4*)(out + CB_G1T + slot) = wg; *(u32x4*)(out + CB_ARBT + slot) = wb; *(u32x4*)(out + CB_ARKT + slot) = wk;
          }
          *(float*)(out + CB_WC + lane * 4) = Wc;
          u32x4 bP0, bP1, kP0, kP1, vP0, vP1;
#pragma unroll
          for (int i = 0; i < 2; ++i) {
              bP0[i] = pkbf(Bh[2 * i] * Wc, Bh[2 * i + 1] * Wc); bP0[2 + i] = pkbf(Bh[8 + 2 * i] * Wc, Bh[9 + 2 * i] * Wc);
              bP1[i] = pkbf(Bh[4 + 2 * i] * Wc, Bh[5 + 2 * i] * Wc); bP1[2 + i] = pkbf(Bh[12 + 2 * i] * Wc, Bh[13 + 2 * i] * Wc); }
#pragma unroll
          for (int i = 0; i < 4; ++i) { kP0[i] = pkbf(Kh[2 * i] * Wc, Kh[2 * i + 1] * Wc); kP1[i] = pkbf(Kh[8 + 2 * i] * Wc, Kh[9 + 2 * i] * Wc); vP0[i] = pkbf(Vv[2 * i], Vv[2 * i + 1]); vP1[i] = pkbf(Vv[8 + 2 * i], Vv[9 + 2 * i]); }
          u32x4 f0, f1;
#pragma unroll
          for (int i = 0; i < 4; ++i) { auto rr = __builtin_amdgcn_permlane32_swap(bP0[i], bP1[i], false, false); f0[i] = rr[0]; f1[i] = rr[1]; }
          *(u32x4*)(out + CB_BB + lane * 16) = f0; *(u32x4*)(out + CB_BB + 1024 + lane * 16) = f1;
#pragma unroll
          for (int i = 0; i < 4; ++i) { auto rr = __builtin_amdgcn_permlane32_swap(kP0[i], kP1[i], false, false); f0[i] = rr[0]; f1[i] = rr[1]; }
          *(u32x4*)(out + CB_KB + lane * 16) = f0; *(u32x4*)(out + CB_KB + 1024 + lane * 16) = f1;
#pragma unroll
          for (int i = 0; i < 4; ++i) { auto rr = __builtin_amdgcn_permlane32_swap(vP0[i], vP1[i], false, false); f0[i] = rr[0]; f1[i] = rr[1]; }
          *(u32x4*)(out + CB_VT + lane * 16) = f0; *(u32x4*)(out + CB_VT + 1024 + lane * 16) = f1;
        }
        asm volatile("s_waitcnt lgkmcnt(0)" ::: "memory");
    }
}
constexpr int SC_SLOT = 2 * CB_BYTES, SC_NCH = SEQ / 16;
__device__ __forceinline__ void scan_block(LAS unsigned char* lds, const unsigned char* BLOB, bf16_t* YS, int blk, int wid, int lane) {
    if (wid >= 4) {
        const int lw = wid - 4;
        const unsigned char* gS = BLOB + (size_t)blk * 512 * SC_SLOT + lane * 16;
#define SC_ISSUE(c) do { const int sl_ = ((c) & 3) * SC_SLOT; const unsigned char* s_ = gS + (size_t)(c) * SC_SLOT; \
        _Pragma("unroll") for (int i_ = 0; i_ < 6; ++i_) __builtin_amdgcn_global_load_lds((const unsigned*)(s_ + (lw + 4 * i_) * 1024), (LAS unsigned*)(lds + sl_ + (lw + 4 * i_) * 1024), 16, 0, 0); } while (0)
        SC_ISSUE(0); SC_ISSUE(1); SC_ISSUE(2);
        for (int c = 0; c < SC_NCH; ++c) {
            if (c + 2 < SC_NCH) asm volatile("s_waitcnt vmcnt(12)" ::: "memory"); else asm volatile("s_waitcnt vmcnt(0)" ::: "memory");
            __builtin_amdgcn_s_barrier();
            asm volatile("" ::: "memory");
            if (c + 3 < SC_NCH) SC_ISSUE(c + 3);
        }
#undef SC_ISSUE
    } else {
        typedef attn_body::f32x16 f32x16;
        const int hsel = wid >> 1, vh = wid & 1, bh = blk * 2 + hsel, r32 = lane & 31, hi = lane >> 5, slot16 = ((lane & 15) + 16 * hi) * 16;
        bf16_t* yp = YS + ((size_t)bh * (SEQ / 4) * 64 + vh * 32 + r32) * 4;
        f32x16 Z0 = f32x16{}, Z1 = f32x16{};
        const f32x16 z16 = f32x16{};
#define SC_CVT(dst, src, s_) do { u32x4 w_; _Pragma("unroll") for (int i_ = 0; i_ < 4; ++i_) w_[i_] = pkbf(src[8 * (s_) + 2 * i_], src[8 * (s_) + 2 * i_ + 1]); dst = __builtin_bit_cast(bf16x8, w_); } while (0)
#define SC_M16(off) (*(const LAS bf16x8*)(base + (off) + slot16))
#define SC_M32(off) (*(const LAS bf16x8*)(base + (off) + lane * 16))
#define MF(a_, b_, c_) __builtin_amdgcn_mfma_f32_32x32x16_bf16(a_, b_, c_, 0, 0, 0)
        for (int c = 0; c < SC_NCH; ++c) {
            __builtin_amdgcn_s_barrier();
            asm volatile("" ::: "memory");
            const LAS unsigned char* base = lds + (c & 3) * SC_SLOT + hsel * CB_BYTES;
            bf16x8 zb00, zb01, zb10, zb11, ub;
            SC_CVT(zb00, Z0, 0); SC_CVT(zb01, Z0, 1); SC_CVT(zb10, Z1, 0); SC_CVT(zb11, Z1, 1);
            const bf16x8 vt = SC_M32(CB_VT + vh * 1024);
            f32x16 U = MF(SC_M16(CB_APT + 0), zb00, z16); U = MF(SC_M16(CB_APT + 512), zb01, U); U = MF(SC_M16(CB_APT + 1024), zb10, U); U = MF(SC_M16(CB_APT + 1536), zb11, U);
            U = MF(SC_M16(CB_G1T), vt, U);
            f32x16 Y = MF(SC_M16(CB_RTT + 0), zb00, z16); Y = MF(SC_M16(CB_RTT + 512), zb01, Y); Y = MF(SC_M16(CB_RTT + 1024), zb10, Y); Y = MF(SC_M16(CB_RTT + 1536), zb11, Y);
            Y = MF(SC_M16(CB_ARKT), vt, Y);
            SC_CVT(ub, U, 0);
            Y = MF(SC_M16(CB_ARBT), ub, Y);
            {
                const LAS float* wc = (const LAS float*)(base + CB_WC) + 4 * hi;
#pragma unroll
                for (int g = 0; g < 4; ++g) { const f32x4 w0 = *(const LAS f32x4*)(wc + 8 * g), w1 = *(const LAS f32x4*)(wc + 32 + 8 * g);
#pragma unroll
                    for (int e = 0; e < 4; ++e) { Z0[4 * g + e] *= w0[e]; Z1[4 * g + e] *= w1[e]; } }
            }
            Z0 = MF(SC_M32(CB_BB), ub, Z0); Z1 = MF(SC_M32(CB_BB + 1024), ub, Z1);
            Z0 = MF(SC_M32(CB_KB), vt, Z0); Z1 = MF(SC_M32(CB_KB + 1024), vt, Z1);
            { u32x2 w_; w_.x = pkbf(Y[0], Y[1]); w_.y = pkbf(Y[2], Y[3]); *(u32x2*)(yp + (size_t)(c * 4 + hi) * 256) = w_; }
            { u32x2 w_; w_.x = pkbf(Y[4], Y[5]); w_.y = pkbf(Y[6], Y[7]); *(u32x2*)(yp + (size_t)(c * 4 + 2 + hi) * 256) = w_; }
        }
#undef SC_CVT
#undef SC_M16
#undef SC_M32
#undef MF
    }
    asm volatile("s_waitcnt vmcnt(0) lgkmcnt(0)" ::: "memory"); __builtin_amdgcn_s_barrier();
}
__device__ __forceinline__ void e3_items(const bf16_t* __restrict__ YS, const float* __restrict__ BON, const bf16_t* __restrict__ GB, const bf16_t* __restrict__ UBv0, bf16_t* __restrict__ Y,
                                         const float* __restrict__ lg, const float* __restrict__ lb, const float* __restrict__ muv, int it0, int it1, int lane) {
#pragma unroll 2
    for (int it = it0; it < it1; ++it) {
        const int t0 = (it >> 2) * 4, hq = it & 3, s0 = t0 & (SEQ - 1), b = t0 >> 13;
        const int head = hq * 4 + (lane >> 4), l16 = lane & 15, c = head * 64 + l16 * 4, bh = b * 16 + head;
        const size_t off = (((size_t)bh * (SEQ / 4) + (s0 >> 2)) * 64 + l16 * 4) * 4;
        u32x2 y4[4];
#pragma unroll
        for (int i = 0; i < 4; ++i) y4[i] = *(const u32x2*)(YS + off + i * 4);
        const bf16_t* UBv = UBv0 + c;
        const f32x4 mv4 = *(const f32x4*)(muv + c);
        float pv[4];
        if (s0 > 0) ld4bf(UBv + (size_t)(t0 - 1) * 3072, pv);
        else {
#pragma unroll
            for (int i = 0; i < 4; ++i) pv[i] = 0.f; }
        const f32x4 lg4 = *(const f32x4*)(lg + c), lb4 = *(const f32x4*)(lb + c);
        u32x2 cvw[4], gw_[4]; float bonv[4];
#pragma unroll
        for (int j = 0; j < 4; ++j) { cvw[j] = *(const u32x2*)(UBv + (size_t)(t0 + j) * 3072); gw_[j] = *(const u32x2*)(GB + (size_t)(t0 + j) * W + c); bonv[j] = BON[(size_t)(t0 + j) * 16 + head]; }
#pragma unroll
        for (int j = 0; j < 4; ++j) {
            const int t = t0 + j;
            float y[4], g[4], cv[4], vm[4], sm = 0.f;
            cv[0] = __uint_as_float(cvw[j].x << 16); cv[1] = __uint_as_float(cvw[j].x & 0xffff0000u); cv[2] = __uint_as_float(cvw[j].y << 16); cv[3] = __uint_as_float(cvw[j].y & 0xffff0000u);
            g[0] = __uint_as_float(gw_[j].x << 16); g[1] = __uint_as_float(gw_[j].x & 0xffff0000u); g[2] = __uint_as_float(gw_[j].y << 16); g[3] = __uint_as_float(gw_[j].y & 0xffff0000u);
            const float bon = bonv[j];
#pragma unroll
            for (int i = 0; i < 4; ++i) { const unsigned wv = (j & 2) ? y4[i].y : y4[i].x; y[i] = __builtin_bit_cast(float, (j & 1) ? (wv & 0xffff0000u) : (wv << 16)); sm += y[i];
                vm[i] = cv[i] + (pv[i] - cv[i]) * mv4[i]; pv[i] = cv[i]; }
            const float mean = allred16(sm) * (1.0f / 64.0f);
            float q = 0.f;
#pragma unroll
            for (int i = 0; i < 4; ++i) { y[i] -= mean; q += y[i] * y[i]; }
            const float rstd = rsqrtf(allred16(q) * (1.0f / 64.0f) + 64e-5f);
            float o[4];
#pragma unroll
            for (int i = 0; i < 4; ++i) o[i] = (y[i] * rstd * lg4[i] + lb4[i] + bon * vm[i]) * siluf_(g[i]);
            u32x2 w; w.x = pk2(o[0], o[1]); w.y = pk2(o[2], o[3]);
            *(u32x2*)(Y + (size_t)t * W + c) = w;
        }
    }
}
__device__ __forceinline__ void e3_phase(const Params& p, int l, int it0, int it1, int lane) {
    unsigned char* ws = p.ws;
    e3_items((const bf16_t*)(ws + O_YS), (const float*)(ws + O_VS), (const bf16_t*)(ws + O_GB), (const bf16_t*)(ws + O_UB) + 2048, (bf16_t*)(ws + O_Y) + (size_t)1 * T * W,
             p.in[I_LG] + (size_t)l * W, p.in[I_LB] + (size_t)l * W, p.in[I_MU] + (size_t)l * 3200 + 2048, it0, it1, lane);
}
constexpr int NWAVES = 8;
constexpr int RING_BYTES = 131072;
constexpr int LDSCTL_OFF = RING_BYTES, MISC_OFF = LDSCTL_OFF + 320;
constexpr int LDS_BYTES = 155648;
constexpr int CW_BAR = 1024;
constexpr int CW_QUEUE = 200000;
constexpr int CW_QK = 204800;
constexpr int CW_E3 = 205312;
constexpr int CW_E2A = 205568;
constexpr int CW_GRP = 205824;
constexpr int NPH = 43;
#ifndef MK_PER_PHASE
#define MK_PER_PHASE 0
#endif
static_assert(attn_body::LDS_BYTES <= RING_BYTES && 4 * SC_SLOT <= RING_BYTES && 8 * EL_BYTES <= RING_BYTES && pg8::STAGE_BYTES <= RING_BYTES && 8 * 9216 <= RING_BYTES, "LDS map");
static_assert((CW_BAR + NPH * XCD_BAR_WORDS) <= CW_QUEUE && (CW_QUEUE + 32 * 64) <= CW_QK && (CW_QK + 4 * 64) <= CW_E3 && (CW_E3 + 4 * 64) <= CW_E2A && (CW_E2A + 4 * 64) <= CW_GRP && (CW_GRP + 4 * 3 * 64 * 32) * 4 <= (int)MiB, "barrier regions inside the zeroed control MiB");

__global__ void __launch_bounds__(NWAVES * 64, 2) fwd(Params p) {
    extern __shared__ __attribute__((aligned(16))) unsigned char lds_[];
    LAS unsigned char* lds = (LAS unsigned char*)lds_;
    volatile LAS unsigned* MISC = (volatile LAS unsigned*)(lds + MISC_OFF);
    const int G = gridDim.x; const int wave_k = __builtin_amdgcn_readfirstlane((int)threadIdx.x >> 6);
    for (int u = threadIdx.x; u < (LDS_BYTES - LDSCTL_OFF) / 4; u += NWAVES * 64) ((LAS unsigned*)(lds + LDSCTL_OFF))[u] = 0u;
    __syncthreads();
    unsigned* ctl = (unsigned*)(p.ws + O_CTL);
    XcdBarrier bar = xcd_barrier_post(ctl + CW_BAR + p.li * XCD_BAR_WORDS, MISC + 8);
    const int lo = p.ph_lo, hi = p.ph_hi;
    const int ngw = G * NWAVES; const size_t ngt = (size_t)G * (NWAVES * 64);
#define BX() int bx = blockIdx.x; asm volatile("" : "+s"(bx))
#define WSQ() Params q = p; __attribute__((address_space(1))) unsigned char* wsg_ = (__attribute__((address_space(1))) unsigned char*)p.ws; asm volatile("" : "+s"(wsg_)); q.ws = (unsigned char*)wsg_; unsigned char* ws = q.ws
#define IDS() int wave_o = wave_k, bx_o = blockIdx.x; asm volatile("" : "+s"(wave_o), "+s"(bx_o)); const int lane = lane_opaque(), wave = wave_o, tid_ = wave * 64 + lane, gw = bx_o * NWAVES + wave; \
    const size_t gt = (size_t)bx_o * (NWAVES * 64) + tid_; (void)lane; (void)wave; (void)gw; (void)gt
#define IN(id) (lo <= (id) && (id) < hi)
#define SEAM(id) do { if ((id) + 1 < hi) xcd_barrier(bar, wave_k == 0 && lane_opaque() == 0); } while (0)
    if (IN(1)) { WSQ(); (void)ws; IDS(); p1_weights(q, lds, gw, ngw, wave, lane, gt, ngt); SEAM(1); }
    for (int l = 0; l < DEPTH; ++l) {
        const int pb = 2 + 10 * l;
#define GRP_CTR(seam_) ((unsigned*)(ws + O_CTL) + CW_GRP + ((l * 3 + (seam_)) * 64 + pmg) * 32)
#define GRP_PUB(ptr_) do { asm volatile("s_waitcnt vmcnt(0) lgkmcnt(0)" ::: "memory"); __builtin_amdgcn_s_barrier(); asm volatile("" ::: "memory"); \
            int wv_ = wave_k; asm volatile("" : "+s"(wv_)); if (wv_ == 0 && lane_opaque() == 0) { __builtin_amdgcn_fence(__ATOMIC_RELEASE, "agent"); asm volatile("s_waitcnt vmcnt(0)" ::: "memory"); __hip_atomic_fetch_add((ptr_), 1u, __ATOMIC_RELAXED, __HIP_MEMORY_SCOPE_AGENT); } } while (0)
#define GRP_POLL(ptr_, n_) do { int wv_ = wave_k; asm volatile("" : "+s"(wv_)); if (wv_ == 0) { unsigned polls_ = 0; \
                while ((unsigned)__builtin_amdgcn_readfirstlane(__hip_atomic_load((ptr_), __ATOMIC_RELAXED, __HIP_MEMORY_SCOPE_AGENT)) < (unsigned)(n_)) { if (++polls_ > (1u << 20)) break; __builtin_amdgcn_s_sleep(4); } \
                __builtin_amdgcn_fence(__ATOMIC_ACQUIRE, "agent"); asm volatile("s_waitcnt vmcnt(0)" ::: "memory"); } \
            asm volatile("s_waitcnt vmcnt(0) lgkmcnt(0)" ::: "memory"); __builtin_amdgcn_s_barrier(); asm volatile("" ::: "memory"); } while (0)
        if (IN(pb + 0)) { WSQ(); IDS(); const int pmg = 8 * (bx_o & 7) + ((bx_o >> 3) & 7), r0 = pmg * 256 + (bx_o >> 6) * 64 + wave * 8;
            if (l == 0) e_rmsnorm(q.in[I_X], p.in[I_NG] + (size_t)l * D, (bf16_t*)(ws + O_H), nullptr, r0, 1, lane, r0 + 8, ws + O_HQ);
            else { { const int l_ = l; const int l = l_ - 1; GRP_POLL(GRP_CTR(1), 4); }
                   e_rmsnorm_bf((const bf16_t*)(ws + O_X), p.in[I_NG] + (size_t)l * D, (bf16_t*)(ws + O_H), nullptr, r0, 1, lane, r0 + 8, ws + O_HQ); }
            GRP_PUB(GRP_CTR(2)); }
        if (IN(pb + 1)) { WSQ(); { BX(); const int pmg = 8 * (bx & 7) + ((bx >> 3) & 7); GRP_POLL(GRP_CTR(2), 4); }
            pg8::Gemm g{(const bf16_t*)(ws + O_H), (const bf16_t*)(ws + O_WTIN) + (size_t)l * NP * D, T, PML + 768, D}; pg8::StaticOrder S; BX(); S.init(T, PML + 768, G, bx);
            EpiG1 E{ws};
            pg8::gemm_phase<EpiG1, pg8::StaticOrder, false, true>(lds, g, S, E, wave_k);
            SEAM(pb + 1);
        }
        if (IN(pb + 4)) { WSQ(); IDS();
            {
                const bf16_t* Qp = (const bf16_t*)(ws + O_Q) + lane * 16; const bf16_t* Kp = (const bf16_t*)(ws + O_K) + lane * 16; unsigned* qkm = (unsigned*)(ws + O_CTL) + CW_QK + l * 64;
                volatile LAS float* qs = (volatile LAS float*)(lds + LDSCTL_OFF + 1024);
                for (int bb = 0; bb < BATCH; ++bb) { float mq = 0.f, mk = 0.f;
                    static_assert(SEQ / (256 * NWAVES) == 4, "four tokens per wave and batch");
                    u32x4 qv[4][2], kv[4][2];
#pragma unroll
                    for (int k = 0; k < 4; ++k) { const size_t t = (size_t)(bb * SEQ + gw + k * (256 * NWAVES));
                        qv[k][0] = *(const u32x4*)(Qp + t * W); qv[k][1] = *(const u32x4*)(Qp + t * W + 8); kv[k][0] = *(const u32x4*)(Kp + t * W); kv[k][1] = *(const u32x4*)(Kp + t * W + 8); }
#pragma unroll
                    for (int k = 0; k < 4; ++k) { float sq = 0.f, sk = 0.f;
#pragma unroll
                        for (int j = 0; j < 2; ++j)
#pragma unroll
                            for (int e = 0; e < 4; ++e) { const float q0 = __uint_as_float(qv[k][j][e] << 16), q1 = __uint_as_float(qv[k][j][e] & 0xffff0000u), k0 = __uint_as_float(kv[k][j][e] << 16), k1 = __uint_as_float(kv[k][j][e] & 0xffff0000u);
                                sq += q0 * q0 + q1 * q1; sk += k0 * k0 + k1 * k1; }
                        sq += dppf<0xB1>(sq); sq += dppf<0x4E>(sq); sk += dppf<0xB1>(sk); sk += dppf<0x4E>(sk);
                        mq = fmaxf(mq, sq); mk = fmaxf(mk, sk); }
                    if ((lane & 3) == 0) { qs[(wave * 2 + bb) * 32 + (lane >> 2) * 2] = mq; qs[(wave * 2 + bb) * 32 + (lane >> 2) * 2 + 1] = mk; } }
                asm volatile("s_waitcnt lgkmcnt(0)" ::: "memory"); __builtin_amdgcn_s_barrier(); asm volatile("" ::: "memory");
                if (wave == 0) { float m = 0.f;
#pragma unroll
                    for (int w = 0; w < 8; ++w) m = fmaxf(m, qs[(w * 2 + (lane >> 5)) * 32 + (lane & 31)]);
                    __hip_atomic_fetch_max(qkm + lane, __float_as_uint(m), __ATOMIC_RELAXED, __HIP_MEMORY_SCOPE_AGENT); }
            }
            if (bx_o < 32) e_cumsum_wg(q, l, bx_o, wave, lane, (volatile LAS float*)(lds + LDSCTL_OFF + 4096));
            {
                const float* S = (const float*)(ws + O_S); const float* mu = p.in[I_MU] + (size_t)l * 3200 + 3072;
                const int r = tid_ >> 3, tok = bx_o * 64 + r, s_ = tok & (SEQ - 1);
#pragma unroll
                for (int hf = 0; hf < 2; ++hf) { const int qc = (tid_ & 7) * 2 + hf, j = qc * 8; u32x4 w;
#pragma unroll
                    for (int i2 = 0; i2 < 2; ++i2) {
                        const f32x4 cur = *(const f32x4*)(S + (size_t)tok * 256 + j + 4 * i2), prv = (s_ > 0) ? *(const f32x4*)(S + (size_t)(tok - 1) * 256 + j + 4 * i2) : (f32x4){0.f, 0.f, 0.f, 0.f}, m4 = *(const f32x4*)(mu + j + 4 * i2);
                        float o[4];
#pragma unroll
                        for (int e = 0; e < 4; ++e) { const float xm = cur[e] + (prv[e] - cur[e]) * m4[e]; o[e] = (j < 64) ? (1.0f - 2.0f * __builtin_amdgcn_rcpf(__expf(2.0f * xm) + 1.0f)) : xm; }
                        w[2 * i2] = pk2(o[0], o[1]); w[2 * i2 + 1] = pk2(o[2], o[3]); }
                    *(LAS u32x4*)(lds + LDS_LA + r * 256 + ((qc ^ (r & 15)) * 16)) = w; }
                asm volatile("s_waitcnt lgkmcnt(0)" ::: "memory"); __builtin_amdgcn_s_barrier(); asm volatile("" ::: "memory");
            }
            e2c_phase(q, l, lds, bx_o, wave, lane);
            asm volatile("s_waitcnt vmcnt(0) lgkmcnt(0)" ::: "memory"); __builtin_amdgcn_s_barrier(); asm volatile("" ::: "memory");
            if (wave == 0 && lane == 0) { __builtin_amdgcn_fence(__ATOMIC_RELEASE, "agent"); asm volatile("s_waitcnt vmcnt(0)" ::: "memory");
                __hip_atomic_fetch_add((unsigned*)(ws + O_CTL) + CW_E2A + l * 64, 1u, __ATOMIC_RELAXED, __HIP_MEMORY_SCOPE_AGENT); } }
#define POLL_GE(ptr_, n_) do { if (wave == 0) { unsigned polls_ = 0; \
                while ((unsigned)__builtin_amdgcn_readfirstlane(__hip_atomic_load((ptr_), __ATOMIC_RELAXED, __HIP_MEMORY_SCOPE_AGENT)) < (unsigned)(n_)) { if (++polls_ > (1u << 20)) break; __builtin_amdgcn_s_sleep(8); } \
                __builtin_amdgcn_fence(__ATOMIC_ACQUIRE, "agent"); asm volatile("s_waitcnt vmcnt(0)" ::: "memory"); } \
            asm volatile("s_waitcnt vmcnt(0) lgkmcnt(0)" ::: "memory"); __builtin_amdgcn_s_barrier(); asm volatile("" ::: "memory"); } while (0)
        if (IN(pb + 5)) { WSQ(); { int bx_o = blockIdx.x; asm volatile("" : "+s"(bx_o));
#define X_SIDE() do { IDS();     \
                e1_conv((const bf16_t*)(ws + O_UA), (bf16_t*)(ws + O_Y), p.in[I_CW] + (size_t)l * 3 * W, gt, ngt); \
                e1_pool((const bf16_t*)(ws + O_UD), (bf16_t*)(ws + O_PG), ((size_t)((bx_o & 63) * 16 + (tid_ >> 5)) << 7) | (size_t)((bx_o >> 6) * 32 + (tid_ & 31)), (size_t)1 << 40); \
                asm volatile("s_waitcnt vmcnt(0) lgkmcnt(0)" ::: "memory"); __builtin_amdgcn_s_barrier(); asm volatile("" ::: "memory");     \
                pg8::Gemm g2{(const bf16_t*)(ws + O_PG), (const bf16_t*)(ws + O_WD) + (size_t)l * 4 * 65536, 4 * T, 1024, 256}; PoolOrder S2{G, bx_o}; \
                EpiPool E2{ws, p.in[I_PS] + (size_t)l * W}; \
                pg8::gemm_phase<EpiPool, PoolOrder, true, true>(lds, g2, S2, E2, wave_k); } while (0)
            if (bx_o >= 240) { IDS(); POLL_GE((unsigned*)(ws + O_CTL) + CW_E2A + l * 64, G); scan_block(lds, ws + O_SCN, (bf16_t*)(ws + O_YS), bx_o - 240, wave, lane);
                if (wave == 0 && lane == 0) { __builtin_amdgcn_fence(__ATOMIC_RELEASE, "agent"); asm volatile("s_waitcnt vmcnt(0)" ::: "memory");
                    __hip_atomic_fetch_add((unsigned*)(ws + O_CTL) + CW_E3 + l * 64, 1u, __ATOMIC_RELAXED, __HIP_MEMORY_SCOPE_AGENT); }
                X_SIDE(); }
            else {
                { BX(); pg8::Gemm g{(const bf16_t*)(ws + O_HQ), (const bf16_t*)(ws + O_WQ + (size_t)l * (29 * 256) * D), T, 29 * 256, D / 2};
                  RangeOrder R; R.S.init(T, 29 * 256, 240, bx); R.i0 = 0; R.i1 = (bx >> 3) & 7; EpiML E{ws};
                  pg8::gemm_phase<EpiML, RangeOrder, false, true, true>(lds, g, R, E, wave_k); }
                X_SIDE();
                { BX(); pg8::Gemm g{(const bf16_t*)(ws + O_HQ), (const bf16_t*)(ws + O_WQ + (size_t)l * (29 * 256) * D), T, 29 * 256, D / 2};
                  RangeOrder R; R.S.init(T, 29 * 256, 240, bx); R.i0 = (bx >> 3) & 7; R.i1 = 64; EpiML E{ws};
                  pg8::gemm_phase<EpiML, RangeOrder, false, true, true>(lds, g, R, E, wave_k); }
            }
            }
            { IDS(); POLL_GE((unsigned*)(ws + O_CTL) + CW_E2A + l * 64, G);
                unsigned* qctr = (unsigned*)(ws + O_CTL) + CW_QUEUE + (l * 8) * 64;
                volatile LAS unsigned* qw = MISC + 16;
                int label = bx_o & 7, tries = 0;
                for (;;) {
                    if (wave == 0 && lane == 0) qw[0] = __hip_atomic_fetch_add(qctr + label * 64, 1u, __ATOMIC_RELAXED, __HIP_MEMORY_SCOPE_AGENT);
                    asm volatile("s_waitcnt vmcnt(0) lgkmcnt(0)" ::: "memory"); __builtin_amdgcn_s_barrier(); asm volatile("" ::: "memory");
                    const unsigned idx = qw[0];
                    asm volatile("s_waitcnt lgkmcnt(0)" ::: "memory"); __builtin_amdgcn_s_barrier(); asm volatile("" ::: "memory");
                    if (idx >= 128u) { label = (label + 1) & 7; if (++tries == 8) break; continue; }
                    const int qb = 31 - (int)(idx >> 2), bh = label + 8 * (int)(idx & 3u);
                    attn_body::attn_unit<8>(bh >> 4, bh & 15, qb, (const attn_body::bf16*)(ws + O_Q), (const attn_body::bf16*)(ws + O_K), (const attn_body::bf16*)(ws + O_V), (const float*)(ws + O_CB), (const unsigned*)(ws + O_CTL) + CW_QK + l * 64,
                                            (const attn_body::bf16*)(ws + O_GC), (attn_body::bf16*)(ws + O_Y) + (size_t)2 * T * W, (char*)lds_, wave_k);
                }
                unsigned* e3c = (unsigned*)(ws + O_CTL) + CW_E3 + l * 64;
                if (wave == 0) { unsigned polls = 0;
                    while ((unsigned)__builtin_amdgcn_readfirstlane(__hip_atomic_load(e3c, __ATOMIC_RELAXED, __HIP_MEMORY_SCOPE_AGENT)) < 16u) { if (++polls > (1u << 20)) break; __builtin_amdgcn_s_sleep(8); }
                    __builtin_amdgcn_fence(__ATOMIC_ACQUIRE, "agent"); asm volatile("s_waitcnt vmcnt(0)" ::: "memory"); }
                asm volatile("s_waitcnt vmcnt(0) lgkmcnt(0)" ::: "memory"); __builtin_amdgcn_s_barrier(); asm volatile("" ::: "memory");
                for (;;) {
                    if (wave == 0 && lane == 0) qw[0] = __hip_atomic_fetch_add(e3c + 32, 64u, __ATOMIC_RELAXED, __HIP_MEMORY_SCOPE_AGENT);
                    asm volatile("s_waitcnt vmcnt(0) lgkmcnt(0)" ::: "memory"); __builtin_amdgcn_s_barrier(); asm volatile("" ::: "memory");
                    const unsigned base = qw[0];
                    asm volatile("s_waitcnt lgkmcnt(0)" ::: "memory"); __builtin_amdgcn_s_barrier(); asm volatile("" ::: "memory");
                    if (base >= (unsigned)T) break;
                    e3_phase(q, l, (int)base + wave * 8, (int)base + wave * 8 + 8, lane);
                }
            }
            SEAM(pb + 5);
#undef POLL_GE
#undef X_SIDE
        }
        if (IN(pb + 8)) { WSQ();
            pg8::Gemm g{(const bf16_t*)(ws + O_Y), (const bf16_t*)(ws + O_WTBR) + (size_t)l * 4 * D * W, 4 * T, 4 * D, W}; BranchOrder S; BX(); S.init(G, bx);
            EpiG3Q E{ws, p.in[I_BM] + (size_t)l * NB * D, bx};
            pg8::gemm_phase<EpiG3Q, BranchOrder, true, true>(lds, g, S, E, wave_k);
            { const int pmg = 8 * (bx & 7) + ((bx >> 3) & 7); GRP_PUB(GRP_CTR(0)); }
        }
        if (IN(pb + 9)) { WSQ(); { BX(); const int pmg = 8 * (bx & 7) + ((bx >> 3) & 7); GRP_POLL(GRP_CTR(0), 4); }
            pg8::Gemm g{(const bf16_t*)(ws + O_MG), (const bf16_t*)(ws + O_WTOUT) + (size_t)l * D * D, T, D, D}; pg8::StaticOrder S; BX(); S.init(T, D, G, bx);
            EpiG4 E{(l == 0) ? q.in[I_X] : (const float*)nullptr, (const bf16_t*)(ws + O_X), (bf16_t*)(ws + O_X)};
            pg8::gemm_phase<EpiG4, pg8::StaticOrder, true, true>(lds, g, S, E, wave_k);
            if (l == DEPTH - 1) SEAM(pb + 9); else { const int pmg = 8 * (bx & 7) + ((bx >> 3) & 7); GRP_PUB(GRP_CTR(1)); }
        }
    }
    int lo2 = p.ph_lo, hi2 = p.ph_hi; asm volatile("" : "+s"(lo2), "+s"(hi2));
    if (lo2 <= 42 && 42 < hi2) { WSQ(); IDS(); e_rmsnorm_bf((const bf16_t*)(ws + O_X), p.in[I_FG], nullptr, p.out, gw, ngw, lane); }
#undef IN
#undef SEAM
}

extern "C" void kernel_launch(void* const* d_in, const int* in_sizes, int n_in, void* d_out, int out_size, void* d_ws, size_t ws_size, hipStream_t stream) {
    static int state = 0;
    if (state == 0) {
        if (n_in != 21 || in_sizes[0] != T * D || out_size != T * D || ws_size < WS_END) {
            fprintf(stderr, "kernel_launch: unexpected shapes (n_in %d, in0 %d, out %d, ws %zu < %zu); nothing launched\n", n_in, n_in > 0 ? in_sizes[0] : -1, out_size, ws_size, (size_t)WS_END);
            state = -1; return; }
        int dev = 0, cus = 0, per_cu = 0;
        if (hipGetDevice(&dev) != hipSuccess || hipDeviceGetAttribute(&cus, hipDeviceAttributeMultiprocessorCount, dev) != hipSuccess) { fprintf(stderr, "kernel_launch: device query failed\n"); state = -1; return; }
        if (hipFuncSetAttribute((const void*)fwd, hipFuncAttributeMaxDynamicSharedMemorySize, LDS_BYTES) != hipSuccess) { fprintf(stderr, "kernel_launch: hipFuncSetAttribute failed\n"); state = -1; return; }
        if (hipOccupancyMaxActiveBlocksPerMultiprocessor(&per_cu, (const void*)fwd, NWAVES * 64, LDS_BYTES) != hipSuccess || per_cu < 1)
            fprintf(stderr, "kernel_launch: note: occupancy query reports %d workgroups per CU\n", per_cu);
        (void)hipGetLastError();
        if (cus != 256) fprintf(stderr, "kernel_launch: note: %d CUs reported; this kernel launches 256 workgroups (one per CU of a 256-CU device)\n", cus);
        state = 1;
    }
    if (state < 0) return;
    if (hipMemsetAsync((char*)d_ws + O_CTL, 0, 1 * MiB, stream) != hipSuccess) { fprintf(stderr, "kernel_launch: memset failed\n"); return; }
    Params p{};
    for (int i = 0; i < 21; ++i) p.in[i] = (const float*)d_in[i];
    p.out = (float*)d_out; p.ws = (unsigned char*)d_ws;
#if MK_PER_PHASE
    for (int id = 0; id < NPH; ++id) { p.ph_lo = id; p.ph_hi = id + 1; p.li = id; p.pad = 0; hipLaunchKernelGGL(fwd, dim3(256), dim3(NWAVES * 64), LDS_BYTES, stream, p); }
#else
    p.ph_lo = 0; p.ph_hi = NPH; p.li = 0; p.pad = 0;
    hipLaunchKernelGGL(fwd, dim3(256), dim3(NWAVES * 64), LDS_BYTES, stream, p);
#endif
    const hipError_t le = hipPeekAtLastError();
    if (le != hipSuccess) fprintf(stderr, "kernel_launch: launch failed: %s\n", hipGetErrorName(le));
}
```
